# Optimizing an MI355X kernel written in HIP

```python
import jax, jax.numpy as jnp
from jax import lax
import numpy as np

D_MODEL = 1024
BATCH = 8
SEQ = 2048
DEPTH = 1

D_MIX = D_MODEL
D_CONV = D_MIX // 2
D_ATTN = D_MIX - D_CONV
CONV_WIDTH = 3
ATTN_HEADS = 8
HEAD_DIM = D_ATTN // ATTN_HEADS
MOBA_BLOCK = 256
MOBA_TOPK = 3
Q_CHUNK = 128
D_PROJ = 3 * D_CONV + 3 * D_ATTN
PEER_HEADS = 8
PEER_NKEYS = 128
PEER_N = PEER_NKEYS * PEER_NKEYS
PEER_DKEY = 256
PEER_TOPK = 16
PEER_CHUNK = 128
EPS = 1e-6
NEG = -1e30

kernel_name = "hymba_conv_moba_peer_block"


def rmsnorm(x, g):
    xf = x.astype(jnp.float32)
    y = xf * lax.rsqrt(jnp.mean(xf * xf, axis=-1, keepdims=True) + EPS)
    return (y * g.astype(jnp.float32)).astype(x.dtype)


def short_conv_mixer(b_gate, c_gate, h, conv_w):
    u = c_gate * h
    y = lax.conv_general_dilated(
        u, conv_w[:, None, :].astype(u.dtype), window_strides=(1,),
        padding=[(CONV_WIDTH - 1, 0)], dimension_numbers=("NWC", "WIO", "NWC"),
        feature_group_count=D_CONV)
    return b_gate * y


def moba_attention(q, k, v):
    b_, s_, h_, hd = q.shape
    nb = -(-s_ // MOBA_BLOCK)
    pad = nb * MOBA_BLOCK - s_
    kp = jnp.pad(k, ((0, 0), (0, pad), (0, 0), (0, 0)))
    vp = jnp.pad(v, ((0, 0), (0, pad), (0, 0), (0, 0)))
    kb = kp.reshape(b_, nb, MOBA_BLOCK, h_, hd).transpose(0, 3, 1, 2, 4)
    vb = vp.reshape(b_, nb, MOBA_BLOCK, h_, hd).transpose(0, 3, 1, 2, 4)
    k_mean = jnp.mean(kb.astype(jnp.float32), axis=3)
    qh = q.transpose(0, 2, 1, 3)
    gate = jnp.einsum("bhsd,bhnd->bhsn", qh.astype(jnp.float32), k_mean)
    own = jnp.arange(s_, dtype=jnp.int32) // MOBA_BLOCK
    past = jnp.arange(nb, dtype=jnp.int32)[None, :] < own[:, None]
    gate = jnp.where(past[None, None], gate, NEG)
    k_sel = min(MOBA_TOPK, nb)
    _, sel = lax.top_k(gate, k_sel)
    valid = sel < own[None, None, :, None]

    nc = s_ // Q_CHUNK
    q_c = qh.reshape(b_, h_, nc, Q_CHUNK, hd).transpose(0, 2, 1, 3, 4).reshape(b_ * nc, h_, Q_CHUNK, hd)
    sel_c = sel.reshape(b_, h_, nc, Q_CHUNK, k_sel).transpose(0, 2, 1, 3, 4).reshape(b_ * nc, h_, Q_CHUNK, k_sel)
    val_c = valid.reshape(b_, h_, nc, Q_CHUNK, k_sel).transpose(0, 2, 1, 3, 4).reshape(b_ * nc, h_, Q_CHUNK, k_sel)
    b_idx = jnp.repeat(jnp.arange(b_, dtype=jnp.int32), nc)
    c_idx = jnp.tile(jnp.arange(nc, dtype=jnp.int32), b_)
    scale = 1.0 / math_sqrt(hd)

    def step(args):
        qc, selc, validc, bi, ci = args
        kbb = kb[bi]
        vbb = vb[bi]
        k_g = jax.vmap(lambda kh, sh: kh[sh])(kbb, selc)
        v_g = jax.vmap(lambda vh, sh: vh[sh])(vbb, selc)
        q_pos = ci * Q_CHUNK + jnp.arange(Q_CHUNK, dtype=jnp.int32)
        own_b = (ci * Q_CHUNK) // MOBA_BLOCK
        k_own = lax.dynamic_index_in_dim(kbb, own_b, axis=1, keepdims=False)
        v_own = lax.dynamic_index_in_dim(vbb, own_b, axis=1, keepdims=False)
        s_sel = jnp.einsum("hqd,hqkjd->hqkj", qc, k_g).astype(jnp.float32) * scale
        s_sel = jnp.where(validc[..., None], s_sel, NEG).reshape(h_, Q_CHUNK, k_sel * MOBA_BLOCK)
        s_own = jnp.einsum("hqd,hjd->hqj", qc, k_own).astype(jnp.float32) * scale
        k_pos = own_b * MOBA_BLOCK + jnp.arange(MOBA_BLOCK, dtype=jnp.int32)
        s_own = jnp.where(k_pos[None, None, :] <= q_pos[None, :, None], s_own, NEG)
        p = jax.nn.softmax(jnp.concatenate([s_sel, s_own], axis=-1), axis=-1)
        p_sel = p[..., : k_sel * MOBA_BLOCK].reshape(h_, Q_CHUNK, k_sel, MOBA_BLOCK).astype(v.dtype)
        p_own = p[..., k_sel * MOBA_BLOCK:].astype(v.dtype)
        return (jnp.einsum("hqkj,hqkjd->hqd", p_sel, v_g)
                + jnp.einsum("hqj,hjd->hqd", p_own, v_own))

    o = lax.map(step, (q_c, sel_c, val_c, b_idx, c_idx))
    o = o.reshape(b_, nc, h_, Q_CHUNK, hd).transpose(0, 1, 3, 2, 4)
    return o.reshape(b_, s_, h_ * hd)


def math_sqrt(n):
    return float(np.sqrt(n))


def peer_ffn(x, w_query, sub_keys1, sub_keys2, expert_down, expert_up):
    b_, s_, d_ = x.shape
    t = b_ * s_
    half = PEER_DKEY // 2

    def step(xc):
        qry = (xc @ w_query).reshape(PEER_CHUNK, PEER_HEADS, PEER_DKEY)
        s1 = jnp.einsum("chd,hnd->chn", qry[..., :half], sub_keys1).astype(jnp.float32)
        s2 = jnp.einsum("chd,hnd->chn", qry[..., half:], sub_keys2).astype(jnp.float32)
        v1, i1 = lax.top_k(s1, PEER_TOPK)
        v2, i2 = lax.top_k(s2, PEER_TOPK)
        cand = (v1[..., :, None] + v2[..., None, :]).reshape(PEER_CHUNK, PEER_HEADS, PEER_TOPK * PEER_TOPK)
        cidx = (i1[..., :, None] * PEER_NKEYS + i2[..., None, :]).reshape(PEER_CHUNK, PEER_HEADS, PEER_TOPK * PEER_TOPK)
        top_s, pos = lax.top_k(cand, PEER_TOPK)
        eidx = jnp.take_along_axis(cidx, pos, axis=-1)
        g = jax.nn.softmax(top_s, axis=-1).astype(xc.dtype)
        u = expert_down[eidx]
        act = jax.nn.gelu(jnp.einsum("chkd,cd->chk", u, xc), approximate=False)
        vv = expert_up[eidx]
        return jnp.einsum("chk,chkd->cd", g * act, vv)

    out = lax.map(step, x.reshape(t // PEER_CHUNK, PEER_CHUNK, d_))
    return out.reshape(b_, s_, d_)


def setup_inputs(seed: int = 0) -> dict:
    key = jax.random.key(seed)
    ks = jax.random.split(key, 16)
    f32 = jnp.float32
    nrm = lambda k, shape, sc: jax.random.normal(k, shape, f32) * sc
    gain = lambda k, n: 1.0 + 0.02 * jax.random.normal(k, (DEPTH, n), f32)
    return {
        "x": jax.random.normal(ks[0], (BATCH, SEQ, D_MODEL), f32),
        "norm_mix_g": gain(ks[1], D_MODEL),
        "w_in": nrm(ks[2], (DEPTH, D_MODEL, D_PROJ), D_MODEL ** -0.5),
        "conv_w": nrm(ks[3], (DEPTH, CONV_WIDTH, D_CONV), CONV_WIDTH ** -0.5),
        "norm_conv_out_g": gain(ks[4], D_CONV),
        "norm_attn_out_g": gain(ks[5], D_ATTN),
        "w_out": nrm(ks[6], (DEPTH, D_MIX, D_MODEL), D_MIX ** -0.5),
        "norm_ffn_g": gain(ks[7], D_MODEL),
        "peer_w_query": nrm(ks[8], (DEPTH, D_MODEL, PEER_HEADS * PEER_DKEY), D_MODEL ** -0.5),
        "peer_sub_keys1": nrm(ks[9], (DEPTH, PEER_HEADS, PEER_NKEYS, PEER_DKEY // 2), (PEER_DKEY // 2) ** -0.5),
        "peer_sub_keys2": nrm(ks[10], (DEPTH, PEER_HEADS, PEER_NKEYS, PEER_DKEY // 2), (PEER_DKEY // 2) ** -0.5),
        "peer_down": nrm(ks[11], (DEPTH, PEER_N, D_MODEL), D_MODEL ** -0.5),
        "peer_up": nrm(ks[12], (DEPTH, PEER_N, D_MODEL), 0.5),
        "final_norm_g": 1.0 + 0.02 * jax.random.normal(ks[13], (D_MODEL,), f32),
    }


def reference(x, norm_mix_g, w_in, conv_w, norm_conv_out_g, norm_attn_out_g, w_out,
              norm_ffn_g, peer_w_query, peer_sub_keys1, peer_sub_keys2, peer_down,
              peer_up, final_norm_g):
    b_, s_, _ = x.shape
    for l in range(DEPTH):
        h = rmsnorm(x, norm_mix_g[l])
        proj = h @ w_in[l]
        b_gate, c_gate, h_c, q, k, v = jnp.split(
            proj, [D_CONV, 2 * D_CONV, 3 * D_CONV, 3 * D_CONV + D_ATTN, 3 * D_CONV + 2 * D_ATTN], axis=-1)
        y_conv = short_conv_mixer(b_gate, c_gate, h_c, conv_w[l])
        y_attn = moba_attention(q.reshape(b_, s_, ATTN_HEADS, HEAD_DIM),
                                k.reshape(b_, s_, ATTN_HEADS, HEAD_DIM),
                                v.reshape(b_, s_, ATTN_HEADS, HEAD_DIM))
        mixed = jnp.concatenate([rmsnorm(y_conv, norm_conv_out_g[l]),
                                 rmsnorm(y_attn, norm_attn_out_g[l])], axis=-1)
        x = x + mixed @ w_out[l]
        x = x + peer_ffn(rmsnorm(x, norm_ffn_g[l]), peer_w_query[l], peer_sub_keys1[l],
                         peer_sub_keys2[l], peer_down[l], peer_up[l])
    return rmsnorm(x, final_norm_g)
```

```cpp
#include <hip/hip_runtime.h>
#include <hip/hip_bf16.h>
#include <cstdio>
#include <cstdint>
#include <cmath>

#ifndef MK_N_LAUNCHES
#define MK_N_LAUNCHES 1
#endif

#ifndef PROBE_REP
#define PROBE_REP 0
#endif
#define NREP(k) (((PROBE_REP >> (k)) & 1) + 1)
#define DI __device__ __forceinline__
#define LAS __attribute__((address_space(3)))
#define GAS __attribute__((address_space(1)))

typedef unsigned short bf16_t;
typedef short bf16x8 __attribute__((ext_vector_type(8)));
typedef float f32x4 __attribute__((ext_vector_type(4)));
typedef float f32x16 __attribute__((ext_vector_type(16)));
typedef unsigned u32x4 __attribute__((ext_vector_type(4)));
typedef unsigned u32x2 __attribute__((ext_vector_type(2)));
typedef float f32x2_t __attribute__((ext_vector_type(2)));
typedef __bf16 bf16x2_t __attribute__((ext_vector_type(2)));

constexpr int M_TOK = 16384, DM = 1024, DPROJ = 3072, SEQ = 2048, NBATCH = 8, NH = 8, HD = 64;
constexpr int KOFF = 2048, VOFF = 2560, QOFF = 1536;
constexpr int NEXP = 16384, PEER_H = 8, PEER_TOPK = 16;
constexpr float EPS = 1e-6f;
constexpr float C2 = 0.125f * 1.4426950408889634f;

DI unsigned cvtpk(float lo, float hi) { f32x2_t v = {lo, hi}; bf16x2_t b = __builtin_convertvector(v, bf16x2_t); return __builtin_bit_cast(unsigned, b); }
DI float bflo(unsigned w) { return __uint_as_float(w << 16); }
DI float bfhi(unsigned w) { return __uint_as_float(w & 0xffff0000u); }
DI void st16_wt(void* p, u32x4 v) { asm volatile("global_store_dwordx4 %0, %1, off sc1\n\ts_nop 1" :: "v"(p), "v"(v) : "memory"); }
DI void st4_wt(void* p, unsigned v) { asm volatile("global_store_dword %0, %1, off sc1" :: "v"(p), "v"(v) : "memory"); }
DI void st8_wt(void* p, u32x2 v) { asm volatile("global_store_dwordx2 %0, %1, off sc1" :: "v"(p), "v"(v) : "memory"); }
DI float wave_sum(float v) {
#pragma unroll
    for (int o = 1; o < 64; o <<= 1) v += __shfl_xor(v, o);
    return v;
}

namespace pg8 {
constexpr int BM = 256, BK = 64, HALF = 128, HTB = HALF * BK * 2, STAGE_BYTES = 8 * HTB, NXCD = 8, WGM = 8;
__host__ __device__ __forceinline__ int lds_byte(int r, int c) { const int st = (r >> 4) * 2 + (c >> 5), rr = r & 15, cc = c & 31, ob = rr * 64 + cc * 2; return st * 1024 + (ob ^ (((ob >> 9) & 1) << 5)); }
__host__ __device__ __forceinline__ void stage_rc(int b, int& R, int& C) { const int st = b / 1024, sb = b % 1024, swz = sb ^ (((sb >> 9) & 1) << 5); R = (st >> 1) * 16 + swz / 64; C = (st & 1) * 32 + (swz % 64) / 2; }
__host__ __device__ __forceinline__ int perm32(int rho) { const int n = rho >> 4, i = rho & 15; return 8 * (i >> 2) + 4 * n + (i & 3); }

struct Unit { int pm, pn; };
struct Gemm { const bf16_t* A; const bf16_t* Bt; int M, N, K, lda, ldb; const bf16_t* XA = nullptr; const bf16_t* XBt = nullptr; int nx = 0; };

struct StaticOrder {
    int nM, nN, nwg, G, c;
    __host__ __device__ void init(int M, int N, int G_, int c_) { nM = M / BM; nN = N / BM; nwg = nM * nN; G = G_; c = c_; }
    __host__ __device__ bool next(int i, Unit& u) const {
        const long L = (long)i * G + c; if (L >= nwg) return false;
        int wgid = (int)L; { const int q = nwg / NXCD, r = nwg % NXCD, xcd = wgid % NXCD, off = wgid / NXCD; wgid = (xcd < r ? xcd * (q + 1) : r * (q + 1) + (xcd - r) * q) + off; }
        const int nig = WGM * nN, gid = wgid / nig, fm = gid * WGM, gsz = (nM - fm) < WGM ? (nM - fm) : WGM;
        u.pm = fm + ((wgid % nig) % gsz); u.pn = (wgid % nig) / gsz; return true;
    }
};

struct HeadOrder {
    StaticOrder S; bool head;
    __host__ __device__ void init(int M, int N, int G_, int c_) { S.init(M, N, G_, c_); head = (G_ == 256 && S.nM == 64 && S.nN == 8); }
    __host__ __device__ bool next(int i, Unit& u) const {
        if (!head) return S.next(i, u);
        if (i >= 2) return false;
        const int xcd = S.c % NXCD, off = S.c / NXCD;
        u.pm = 8 * xcd + 4 * i + (off & 3); u.pn = off >> 2; return true;
    }
};

struct EpiBf16 {
    static constexpr bool PERM = true, MID = false;
    bf16_t* O; int ldc;
    DI void mid(f32x4 (&)[2][2][4][2], const Unit&, int, int, LAS unsigned char*, int) const {}
    DI void operator()(const f32x4 (&acc)[2][2][4][2], const Unit& u, int wr, int wc, int fr, int fq, LAS unsigned char*) const {
        const int row0 = u.pm * BM + wr * 64 + fr, col0 = u.pn * BM + wc * 32 + 8 * fq;
#pragma unroll
        for (int ai = 0; ai < 2; ++ai)
#pragma unroll
            for (int m = 0; m < 4; ++m) { bf16_t* rowp = O + (size_t)(row0 + ai * HALF + m * 16) * ldc + col0;
#pragma unroll
                for (int bj = 0; bj < 2; ++bj) { const f32x4 v0 = acc[ai][bj][m][0], v1 = acc[ai][bj][m][1];
                    u32x4 w; w.x = cvtpk(v0[0], v0[1]); w.y = cvtpk(v0[2], v0[3]); w.z = cvtpk(v1[0], v1[1]); w.w = cvtpk(v1[2], v1[3]);
                    *(u32x4*)(rowp + bj * HALF) = w; } }
    }
};
struct EpiProj {
    static constexpr bool PERM = true, MID = false;
    bf16_t* O; float* ksum;
    DI void mid(f32x4 (&)[2][2][4][2], const Unit&, int, int, LAS unsigned char*, int) const {}
    DI void operator()(const f32x4 (&acc)[2][2][4][2], const Unit& u, int wr, int wc, int fr, int fq, LAS unsigned char*) const {
        const int row0 = u.pm * BM + wr * 64 + fr, col0 = u.pn * BM + wc * 32 + 8 * fq;
        const float sc = (u.pn == 6 || u.pn == 7) ? C2 : 1.0f;
#pragma unroll
        for (int ai = 0; ai < 2; ++ai)
#pragma unroll
            for (int m = 0; m < 4; ++m) { bf16_t* rowp = O + (size_t)(row0 + ai * HALF + m * 16) * DPROJ + col0;
#pragma unroll
                for (int bj = 0; bj < 2; ++bj) { const f32x4 v0 = acc[ai][bj][m][0] * sc, v1 = acc[ai][bj][m][1] * sc;
                    u32x4 w; w.x = cvtpk(v0[0], v0[1]); w.y = cvtpk(v0[2], v0[3]); w.z = cvtpk(v1[0], v1[1]); w.w = cvtpk(v1[2], v1[3]);
                    st16_wt(rowp + bj * HALF, w); } }
        if (u.pn == 8 || u.pn == 9) {
            float* kd = ksum + (size_t)u.pm * 512 + (u.pn - 8) * 256 + wc * 32 + 8 * fq;
#pragma unroll
            for (int bj = 0; bj < 2; ++bj)
#pragma unroll
                for (int n = 0; n < 2; ++n)
#pragma unroll
                    for (int j = 0; j < 4; ++j) {
                        float s = 0.f;
#pragma unroll
                        for (int ai = 0; ai < 2; ++ai)
#pragma unroll
                            for (int m = 0; m < 4; ++m) s += acc[ai][bj][m][n][j];
                        s += __shfl_xor(s, 1); s += __shfl_xor(s, 2); s += __shfl_xor(s, 4); s += __shfl_xor(s, 8);
                        if (fr == 0) atomicAdd(kd + bj * HALF + 4 * n + j, s);
                    }
        }
    }
};
struct EpiX1 {
    static constexpr bool PERM = true, MID = true;
    const float* x; float* x1; bf16_t* x1b; float* ssqx; int tab_off; unsigned char* xqh; unsigned char* xql;
    static constexpr int T_MID0 = 4, T_MID1 = 12;
    DI void mid(f32x4 (&acc)[2][2][4][2], const Unit&, int wr, int fr, LAS unsigned char* lds, int which) const {
        const LAS float* tabA = (const LAS float*)(lds + tab_off) + (which ? 0 : 1536);
#pragma unroll
        for (int ai = 0; ai < 2; ++ai)
#pragma unroll
            for (int m = 0; m < 4; ++m) { const float f = tabA[ai * HALF + wr * 64 + m * 16 + fr];
#pragma unroll
                for (int bj = 0; bj < 2; ++bj)
#pragma unroll
                    for (int n = 0; n < 2; ++n) acc[ai][bj][m][n] *= f; }
    }
    DI void operator()(const f32x4 (&acc)[2][2][4][2], const Unit& u, int wr, int wc, int fr, int fq, LAS unsigned char* lds) const {
        int tbo = tab_off; asm volatile("" : "+s"(tbo));
        const LAS float* tabB = (const LAS float*)(lds + tbo) + 256; const LAS float* gtab = (const LAS float*)(lds + tbo) + 512;
        const int col0 = u.pn * BM + wc * 32 + 8 * fq;
#pragma unroll
        for (int ai = 0; ai < 2; ++ai) {
#pragma unroll
            for (int m = 0; m < 4; ++m) { const int r = ai * HALF + wr * 64 + m * 16 + fr; const float rs = tabB[r]; const size_t off = (size_t)(u.pm * BM + r) * DM + col0;
                float ss = 0.f;
#pragma unroll
                for (int bj = 0; bj < 2; ++bj) {
                    const f32x4 v0 = acc[ai][bj][m][0] * rs, v1 = acc[ai][bj][m][1] * rs;
                    u32x4 w; w.x = cvtpk(v0[0], v0[1]); w.y = cvtpk(v0[2], v0[3]); w.z = cvtpk(v1[0], v1[1]); w.w = cvtpk(v1[2], v1[3]);
                    st16_wt(x1b + off + bj * HALF, w);
                    { const f32x4 ga = *(const LAS f32x4*)(gtab + col0 + bj * HALF), gb = *(const LAS f32x4*)(gtab + col0 + bj * HALF + 4);
                      const f32x2_t u01 = (f32x2_t){bflo(w.x) * ga[0], bfhi(w.x) * ga[1]}, u23 = (f32x2_t){bflo(w.y) * ga[2], bfhi(w.y) * ga[3]}, u45 = (f32x2_t){bflo(w.z) * gb[0], bfhi(w.z) * gb[1]}, u67 = (f32x2_t){bflo(w.w) * gb[2], bfhi(w.w) * gb[3]};
                      int h0 = 0, h1 = 0; h0 = __builtin_amdgcn_cvt_pk_fp8_f32(u01.x, u01.y, h0, false); h0 = __builtin_amdgcn_cvt_pk_fp8_f32(u23.x, u23.y, h0, true); h1 = __builtin_amdgcn_cvt_pk_fp8_f32(u45.x, u45.y, h1, false); h1 = __builtin_amdgcn_cvt_pk_fp8_f32(u67.x, u67.y, h1, true);
                      const f32x2_t b01 = __builtin_amdgcn_cvt_pk_f32_fp8(h0, false), b23 = __builtin_amdgcn_cvt_pk_f32_fp8(h0, true), b45 = __builtin_amdgcn_cvt_pk_f32_fp8(h1, false), b67 = __builtin_amdgcn_cvt_pk_f32_fp8(h1, true);
                      int l0 = 0, l1 = 0; l0 = __builtin_amdgcn_cvt_pk_fp8_f32((u01.x - b01.x) * 16.f, (u01.y - b01.y) * 16.f, l0, false); l0 = __builtin_amdgcn_cvt_pk_fp8_f32((u23.x - b23.x) * 16.f, (u23.y - b23.y) * 16.f, l0, true);
                      l1 = __builtin_amdgcn_cvt_pk_fp8_f32((u45.x - b45.x) * 16.f, (u45.y - b45.y) * 16.f, l1, false); l1 = __builtin_amdgcn_cvt_pk_fp8_f32((u67.x - b67.x) * 16.f, (u67.y - b67.y) * 16.f, l1, true);
                      u32x2 qh, ql; qh.x = (unsigned)h0; qh.y = (unsigned)h1; ql.x = (unsigned)l0; ql.y = (unsigned)l1;
                      *(u32x2*)(xqh + off + bj * HALF) = qh; *(u32x2*)(xql + off + bj * HALF) = ql; }
                    ss += ((v0[0] * v0[0] + v0[1] * v0[1]) + (v0[2] * v0[2] + v0[3] * v0[3])) + ((v1[0] * v1[0] + v1[1] * v1[1]) + (v1[2] * v1[2] + v1[3] * v1[3])); }
                ss += __shfl_xor(ss, 16); ss += __shfl_xor(ss, 32);
                if (fq == 0) st4_wt(ssqx + (size_t)(u.pm * BM + r) * 16 + u.pn * 4 + wc, __float_as_uint(ss)); }
        }
    }
};

DI const char* pg8_sgpr_ptr(const char* p) { const unsigned long long v = (unsigned long long)p; const unsigned lo = __builtin_amdgcn_readfirstlane((unsigned)v), hi = __builtin_amdgcn_readfirstlane((unsigned)(v >> 32)); return (const char*)(((unsigned long long)hi << 32) | lo); }
template <class Epi, class Sched, bool ALIGN_EPI>
DI void gemm_phase(LAS unsigned char* lds, const Gemm g, const Sched& S, const Epi& E) {
    const int tid = threadIdx.x, wid = __builtin_amdgcn_readfirstlane(tid >> 6), lane = tid & 63, wr = wid >> 2, wc = wid & 3, fr = lane & 15, fq = lane >> 4;
    const int K = g.K, nx = g.nx, nt = K / BK + nx;
    unsigned voffA[2], voffB[2];
#pragma unroll
    for (int i = 0; i < 2; ++i) { int R, C; stage_rc(tid * 16 + i * 8192, R, C); const int Rb = Epi::PERM ? ((R & ~31) + perm32(R & 31)) : R;
        voffA[i] = (unsigned)(R * g.lda + C) * 2u; voffB[i] = (unsigned)(Rb * g.ldb + C) * 2u; }
    const size_t kstep = (size_t)(BK * 2);
    const size_t hstepA = (size_t)HALF * g.lda * 2, hstepB = (size_t)HALF * g.ldb * 2;
    const size_t tstepA = 2 * hstepA, tstepB = 2 * hstepB;
    const unsigned ldsw = (unsigned)wid * 1024u;
    const int aoff = lds_byte(wr * 64 + fr, fq * 8), boff = lds_byte(wc * 32 + fr, fq * 8);
#define PG8_SA(b, h) (((b) * 2 + (h)) * HTB)
#define PG8_SB(b, h) ((4 + (b) * 2 + (h)) * HTB)
#define PG8_STAGE(bufoff, gbase, voff) do { _Pragma("unroll") for (int _i = 0; _i < 2; ++_i) \
        __builtin_amdgcn_global_load_lds((const unsigned*)((const char*)(gbase) + (voff)[_i]), (LAS unsigned*)(lds + (bufoff) + ldsw + _i * 8192), 16, 0, 0); } while (0)
#define PG8_LDA(dst, b, h) do { _Pragma("unroll") for (int m = 0; m < 4; ++m) _Pragma("unroll") for (int k = 0; k < 2; ++k) dst[m][k] = *(const LAS bf16x8*)(lds + PG8_SA(b, h) + aoff + m * 2048 + k * 1024); } while (0)
#define PG8_LDB(dst, b, h) do { _Pragma("unroll") for (int n = 0; n < 2; ++n) _Pragma("unroll") for (int k = 0; k < 2; ++k) dst[n][k] = *(const LAS bf16x8*)(lds + PG8_SB(b, h) + boff + n * 2048 + k * 1024); } while (0)
#define PG8_MMA(ai, bj, At, Bt) do { __builtin_amdgcn_s_setprio(1); _Pragma("unroll") for (int m = 0; m < 4; ++m) _Pragma("unroll") for (int n = 0; n < 2; ++n) _Pragma("unroll") for (int k = 0; k < 2; ++k) \
        acc[ai][bj][m][n] = __builtin_amdgcn_mfma_f32_16x16x32_bf16(Bt[n][k], At[m][k], acc[ai][bj][m][n], 0, 0, 0); __builtin_amdgcn_s_setprio(0); } while (0)
#define PG8_WAIT_V(n) asm volatile("s_waitcnt vmcnt(" #n ")" ::: "memory")
#define PG8_WAIT_L(n) asm volatile("s_waitcnt lgkmcnt(" #n ")" ::: "memory")
#define PG8_BAR __builtin_amdgcn_s_barrier()
#define PG8_SCHED __builtin_amdgcn_sched_barrier(0)
    Unit cur, nxt; int ui = 0;
    if (!S.next(0, cur)) return;
    f32x4 acc[2][2][4][2];
#pragma unroll
    for (int a = 0; a < 2; ++a)
#pragma unroll
        for (int b = 0; b < 2; ++b)
#pragma unroll
            for (int m = 0; m < 4; ++m)
#pragma unroll
                for (int n = 0; n < 2; ++n) acc[a][b][m][n] = (f32x4){0.f, 0.f, 0.f, 0.f};
    bf16x8 At[4][2], B0[2][2], B1[2][2];
    const char* cA = (const char*)g.A + (size_t)cur.pm * tstepA; const char* cB = (const char*)g.Bt + (size_t)cur.pn * tstepB;
    const char* xB = (const char*)g.XBt;
    const char* xA = (const char*)g.XA + (size_t)cur.pm * tstepA + (size_t)cur.pn * (BM * 2);
#define PG8_SP(p) pg8_sgpr_ptr(p)
#define PG8_TA(t) PG8_SP((t) < nx ? xA + (size_t)(t) * kstep : cA + (size_t)((t) - nx) * kstep)
#define PG8_TB(t) PG8_SP((t) < nx ? xB + (size_t)(t) * kstep : cB + (size_t)((t) - nx) * kstep)
    { const char* a0 = PG8_TA(0); const char* b0 = PG8_TB(0); const char* a1p = PG8_TA(1); const char* b1p = PG8_TB(1);
    PG8_STAGE(PG8_SB(0, 0), b0, voffB); PG8_STAGE(PG8_SB(0, 1), b0 + hstepB, voffB); PG8_STAGE(PG8_SA(0, 0), a0, voffA); PG8_STAGE(PG8_SA(0, 1), a0 + hstepA, voffA);
    if (wr == 1) PG8_BAR;
    PG8_WAIT_V(2); PG8_BAR;
    PG8_STAGE(PG8_SB(1, 0), b1p, voffB); PG8_STAGE(PG8_SA(1, 0), a1p, voffA); PG8_STAGE(PG8_SB(1, 1), b1p + hstepB, voffB); }
    PG8_WAIT_V(6); PG8_BAR;
    for (;;) {
        const bool has_next = S.next(ui + 1, nxt);
        const char* nA = has_next ? (const char*)g.A + (size_t)nxt.pm * tstepA : cA; const char* nB = has_next ? (const char*)g.Bt + (size_t)nxt.pn * tstepB : cB;
        const char* nxA = has_next ? (const char*)g.XA + (size_t)nxt.pm * tstepA + (size_t)nxt.pn * (BM * 2) : xA;
        const char* n0A = nx ? nxA : nA; const char* n0B = nx ? xB : nB;
        for (int t = 0; t < nt; t += 2) {
            const bool last = (t == nt - 2);
            if constexpr (Epi::MID) { if (t == Epi::T_MID0) E.mid(acc, cur, wr, fr, lds, 0); if (t == Epi::T_MID1) E.mid(acc, cur, wr, fr, lds, 1); }
            const char* a1 = PG8_TA(t + 1);
            const char* a2 = PG8_SP(last ? n0A : PG8_TA(t + 2)); const char* b2 = PG8_SP(last ? n0B : PG8_TB(t + 2));
            const char* a3 = PG8_SP(last ? n0A + kstep : PG8_TA(t + 3)); const char* b3 = PG8_SP(last ? n0B + kstep : PG8_TB(t + 3));
            PG8_LDB(B0, 0, 0); PG8_LDB(B1, 0, 1); PG8_SCHED; PG8_LDA(At, 0, 0); PG8_STAGE(PG8_SA(1, 1), a1 + hstepA, voffA);
            PG8_WAIT_V(8); PG8_WAIT_L(0); PG8_BAR; PG8_MMA(0, 0, At, B0); PG8_MMA(0, 1, At, B1); PG8_BAR; PG8_SCHED;
            PG8_LDA(At, 0, 1); PG8_STAGE(PG8_SB(0, 0), b2, voffB); PG8_STAGE(PG8_SB(0, 1), b2 + hstepB, voffB); PG8_STAGE(PG8_SA(0, 0), a2, voffA);
            PG8_WAIT_V(8); PG8_WAIT_L(0); PG8_BAR; PG8_MMA(1, 0, At, B0); PG8_MMA(1, 1, At, B1); PG8_BAR; PG8_SCHED;
            PG8_LDB(B0, 1, 0); PG8_LDB(B1, 1, 1); PG8_SCHED; PG8_LDA(At, 1, 0); PG8_STAGE(PG8_SA(0, 1), a2 + hstepA, voffA);
            PG8_WAIT_V(8); PG8_WAIT_L(0); PG8_BAR; PG8_MMA(0, 0, At, B0); PG8_MMA(0, 1, At, B1); PG8_BAR; PG8_SCHED;
            PG8_LDA(At, 1, 1); PG8_STAGE(PG8_SB(1, 0), b3, voffB); PG8_STAGE(PG8_SB(1, 1), b3 + hstepB, voffB); PG8_STAGE(PG8_SA(1, 0), a3, voffA);
            PG8_WAIT_V(8); PG8_WAIT_L(0); PG8_BAR; PG8_MMA(1, 0, At, B0); PG8_MMA(1, 1, At, B1); PG8_BAR; PG8_SCHED;
        }
        if constexpr (ALIGN_EPI) { if (wr == 0) PG8_BAR; }
        E(acc, cur, wr, wc, fr, fq, lds);
        if (!has_next) break;
#pragma unroll
        for (int a = 0; a < 2; ++a)
#pragma unroll
            for (int b = 0; b < 2; ++b)
#pragma unroll
                for (int m = 0; m < 4; ++m)
#pragma unroll
                    for (int n = 0; n < 2; ++n) acc[a][b][m][n] = (f32x4){0.f, 0.f, 0.f, 0.f};
        cur = nxt; cA = nA; cB = nB; xA = nxA; ++ui;
        if constexpr (ALIGN_EPI) { if (wr == 1) PG8_BAR; }
    }
    PG8_WAIT_V(0);
    if constexpr (!ALIGN_EPI) { if (wr == 0) PG8_BAR; }
    PG8_BAR;
#undef PG8_SA
#undef PG8_SB
#undef PG8_STAGE
#undef PG8_LDA
#undef PG8_LDB
#undef PG8_MMA
#undef PG8_WAIT_V
#undef PG8_WAIT_L
#undef PG8_BAR
#undef PG8_SCHED
}
}

constexpr size_t MiB = 1u << 20;
constexpr size_t WS_CTL = 0, CTL_ZERO_BYTES = 1 * MiB;
constexpr size_t WS_KSUM = 512 * 1024;
constexpr size_t WS_RMS0 = 768 * 1024;
constexpr size_t WS_IDM = 15 * MiB;
constexpr size_t WS_K1 = 1 * MiB, WS_K2 = WS_K1 + 256 * 1024;
constexpr size_t WS_SSQA = WS_K1 + 512 * 1024;
constexpr size_t WS_WIN = 2 * MiB, WS_WOUT = 8 * MiB, WS_WQ = 10 * MiB;
constexpr size_t WS_SSQX = 14 * MiB;
constexpr size_t WS_XN = 16 * MiB;
constexpr size_t WS_PROJ = 48 * MiB;
constexpr size_t WS_QRY = 48 * MiB;
constexpr size_t WS_EIDX = 112 * MiB, WS_GATE = 120 * MiB;
constexpr size_t WS_Y = 144 * MiB;
constexpr size_t WS_XQH = 128 * MiB, WS_XQL = 240 * MiB;
constexpr size_t WS_CQ = 48 * MiB;
constexpr size_t WS_DELTA = 144 * MiB;
constexpr size_t WS_ED = 176 * MiB, WS_EU = 208 * MiB, WS_END = 256 * MiB;
constexpr int CW_BAR = 4096;

constexpr int SCR_BYTES = 151552;
constexpr int TAB_OFF = 131072;
constexpr int MISC_OFF = SCR_BYTES;
constexpr int LDS_BYTES = 155648;
constexpr int NWAVES = 8;

#define XB_TMO      128
#define XB_XCNT(j)  (256  + 64 * (j))
#define XB_XSUB(j)  (1280 + 64 * (j))
#define XB_XGEN(j)  (2304 + 64 * (j))
#define XB_TOP      3328
#define XB_TOPGEN   3392
#define XCD_BAR_WORDS 3456
#define XB_SPIN_CAP (1u << 18)
DI unsigned xb_ld(unsigned* p)              { return __hip_atomic_load(p, __ATOMIC_RELAXED, __HIP_MEMORY_SCOPE_AGENT); }
DI unsigned xb_add(unsigned* p, unsigned v) { return __hip_atomic_fetch_add(p, v, __ATOMIC_RELAXED, __HIP_MEMORY_SCOPE_AGENT); }
DI unsigned xb_xcc_id() { return (unsigned)__builtin_amdgcn_s_getreg((3 << 11) | 20) & 0xFu; }
#define XB_SPIN(cond, bar) do { unsigned _sp = 0; while (cond) { __builtin_amdgcn_s_sleep(1); \
    if ((++_sp & 255u) == 0u) { if (xb_ld(&(bar)[XB_TMO])) break; if (_sp > XB_SPIN_CAP) { atomicAdd(&(bar)[XB_TMO], 1u); break; } } } } while (0)
struct XcdBarrier { unsigned* bar; unsigned x; volatile LAS unsigned* st; };
DI XcdBarrier xcd_barrier_post(unsigned* bar, volatile LAS unsigned* st) {
    XcdBarrier b; b.bar = bar; b.x = xb_xcc_id(); b.st = st;
    if (threadIdx.x == 0) st[3] = xb_add(&bar[XB_XCNT(b.x)], 1u);
    return b;
}
DI void xcd_barrier_complete(unsigned* bar, unsigned x, unsigned& nloc, unsigned& nx, unsigned& ord) {
    const unsigned G = gridDim.x * gridDim.y * gridDim.z;
    unsigned sum, cnt, mine, below, sp = 0u;
    for (;;) {
        sum = 0u; cnt = 0u; mine = 0u; below = 0u;
#pragma unroll
        for (unsigned j = 0; j < 16; ++j) { const unsigned c = xb_ld(&bar[XB_XCNT(j)]); sum += c; cnt += (c > 0u) ? 1u : 0u; mine = (j == x) ? c : mine; below += (c > 0u && j < x) ? 1u : 0u; }
        if (sum == G) break;
        __builtin_amdgcn_s_sleep(1);
        if ((++sp & 255u) == 0u) { if (xb_ld(&bar[XB_TMO])) break; if (sp > XB_SPIN_CAP) { atomicAdd(&bar[XB_TMO], 1u); break; } }
    }
    nloc = mine > 0u ? mine : 1u; nx = cnt > 0u ? cnt : 1u; ord = below;
}
template <bool RELEASE = true> DI void xcd_barrier(const XcdBarrier& b) {
    asm volatile("s_waitcnt vmcnt(0)" ::: "memory");
    __syncthreads();
    if (threadIdx.x == 0) {
        unsigned* bar = b.bar;
        __builtin_amdgcn_s_waitcnt(0);
        unsigned nloc = b.st[0], nx = b.st[1];
        if (nloc == 0u) { unsigned ord; xcd_barrier_complete(bar, b.x, nloc, nx, ord); b.st[0] = nloc; b.st[1] = nx; b.st[2] = ord; }
        const unsigned old = xb_add(&bar[XB_XSUB(b.x)], 1u);
        const unsigned gen = old / nloc;
        if (old + 1u == (gen + 1u) * nloc) {
            if (RELEASE) __builtin_amdgcn_fence(__ATOMIC_RELEASE, "agent");
            asm volatile("s_waitcnt vmcnt(0)" ::: "memory");
            const unsigned og = xb_add(&bar[XB_TOP], 1u);
            const unsigned tg = og / nx;
            if (og + 1u == (tg + 1u) * nx) xb_add(&bar[XB_TOPGEN], 1u);
            else XB_SPIN(xb_ld(&bar[XB_TOPGEN]) == tg, bar);
            __builtin_amdgcn_fence(__ATOMIC_ACQUIRE, "agent");
            xb_add(&bar[XB_XGEN(b.x)], 1u);
            asm volatile("s_waitcnt vmcnt(0)" ::: "memory");
        } else {
            XB_SPIN(xb_ld(&bar[XB_XGEN(b.x)]) == gen, bar);
            __builtin_amdgcn_fence(__ATOMIC_ACQUIRE, "agent");
            asm volatile("s_waitcnt vmcnt(0)" ::: "memory");
        }
    }
    __syncthreads();
}

struct Frame {
    LAS unsigned char* lds;
    int tid, lane, wave, vcu, G;
};
struct Args { const float* in[14]; float* out; unsigned char* ws; int ph_lo, ph_hi, li, pad; };

DI void p0_transpose_item(const float* W, int K, int N, bf16_t* WT, const float* sc_lo, const float* sc_hi, int split, LAS float* scr, int item, int lane) {
    const int nblk = N / 32, kb = item / nblk, nb = item % nblk, k0 = 64 * kb, n0 = 32 * nb;
#pragma unroll 16
    for (int i = 0; i < 32; ++i) { const int kk = 2 * i + (lane >> 5); const int k = k0 + kk;
        float s = 1.0f; if (sc_lo) s = (k < split) ? sc_lo[k] : sc_hi[k - split];
        scr[kk * 33 + (lane & 31)] = W[(size_t)k * N + n0 + (lane & 31)] * s; }
    asm volatile("s_waitcnt lgkmcnt(0)" ::: "memory");
    const int c = lane & 7;
#pragma unroll
    for (int j = 0; j < 4; ++j) { const int n = (lane >> 3) + 8 * j; const LAS float* s = scr + (8 * c) * 33 + n;
        u32x4 o; o.x = cvtpk(s[0 * 33], s[1 * 33]); o.y = cvtpk(s[2 * 33], s[3 * 33]); o.z = cvtpk(s[4 * 33], s[5 * 33]); o.w = cvtpk(s[6 * 33], s[7 * 33]);
        st16_wt(WT + (size_t)(n0 + n) * K + k0 + 8 * c, o); }
    asm volatile("s_waitcnt lgkmcnt(0)" ::: "memory");
}
DI void p0_cvt_item(const float* src, bf16_t* dst, size_t item, int lane) {
    const f32x4* s = (const f32x4*)(src + item * 512) + 2 * lane;
    const f32x4 a = s[0], b = s[1];
    u32x4 o; o.x = cvtpk(a[0], a[1]); o.y = cvtpk(a[2], a[3]); o.z = cvtpk(b[0], b[1]); o.w = cvtpk(b[2], b[3]);
    *((u32x4*)(dst + item * 512) + lane) = o;
}
DI void p0_cvt8_item(const float* src, unsigned char* dst, size_t item, int lane, float sc) {
    const f32x4* s = (const f32x4*)(src + item * 512) + 2 * lane;
    const f32x4 a = s[0] * sc, b = s[1] * sc;
    int w0 = 0, w1 = 0;
    w0 = __builtin_amdgcn_cvt_pk_fp8_f32(a[0], a[1], w0, false); w0 = __builtin_amdgcn_cvt_pk_fp8_f32(a[2], a[3], w0, true);
    w1 = __builtin_amdgcn_cvt_pk_fp8_f32(b[0], b[1], w1, false); w1 = __builtin_amdgcn_cvt_pk_fp8_f32(b[2], b[3], w1, true);
    u32x2 o; o.x = (unsigned)w0; o.y = (unsigned)w1;
    *((u32x2*)(dst + item * 512) + lane) = o;
}
template <int U> struct CvtRegs { f32x4 a[U][2]; };
template <int U> DI void cvt8_load(CvtRegs<U>& r, const float* src, size_t item0, int lane) {
#pragma unroll
    for (int u = 0; u < U; ++u) { const f32x4* s = (const f32x4*)(src + (item0 + u) * 512) + 2 * lane; r.a[u][0] = __builtin_nontemporal_load(s); r.a[u][1] = __builtin_nontemporal_load(s + 1); }
}
template <int U> DI void cvt8_store(const CvtRegs<U>& r, unsigned char* dst, size_t item0, int lane, float sc, const float* colg) {
#pragma unroll
    for (int u = 0; u < U; ++u) { const size_t it = item0 + u; const int e = (int)(it >> 1), hh = (int)(it & 1), col = 512 * hh + 8 * lane;
        f32x4 x = r.a[u][0] * sc, y = r.a[u][1] * sc;
        if (colg) { x = x * *(const f32x4*)(colg + col); y = y * *(const f32x4*)(colg + col + 4); }
        int w0 = 0, w1 = 0;
        w0 = __builtin_amdgcn_cvt_pk_fp8_f32(x[0], x[1], w0, false); w0 = __builtin_amdgcn_cvt_pk_fp8_f32(x[2], x[3], w0, true);
        w1 = __builtin_amdgcn_cvt_pk_fp8_f32(y[0], y[1], w1, false); w1 = __builtin_amdgcn_cvt_pk_fp8_f32(y[2], y[3], w1, true);
        u32x2 o; o.x = (unsigned)w0; o.y = (unsigned)w1;
        *(u32x2*)(dst + (size_t)(col >> 7) * ((size_t)NEXP * 128) + (size_t)e * 128 + (col & 127)) = o; }
}
template <int U> DI void p0_xn_rows(const float* x, const float* g, bf16_t* xn, float* rms0, int row0, int lane) {
    f32x4 v[U][4];
#pragma unroll
    for (int u = 0; u < U; ++u)
#pragma unroll
        for (int j = 0; j < 4; ++j) v[u][j] = __builtin_nontemporal_load((const f32x4*)(x + (size_t)(row0 + u) * DM) + lane + 64 * j);
    f32x4 gg[4];
#pragma unroll
    for (int j = 0; j < 4; ++j) gg[j] = *((const f32x4*)g + lane + 64 * j);
#pragma unroll
    for (int u = 0; u < U; ++u) { float s = 0.f;
#pragma unroll
        for (int j = 0; j < 4; ++j) s += (v[u][j][0] * v[u][j][0] + v[u][j][1] * v[u][j][1]) + (v[u][j][2] * v[u][j][2] + v[u][j][3] * v[u][j][3]);
        const float rstd = 1.0f / sqrtf(wave_sum(s) * (1.f / DM) + EPS);
        u32x2* o8 = (u32x2*)(xn + (size_t)(row0 + u) * DM) + lane;
#pragma unroll
        for (int j = 0; j < 4; ++j) { u32x2 w; w.x = cvtpk(v[u][j][0] * rstd, v[u][j][1] * rstd); w.y = cvtpk(v[u][j][2] * rstd, v[u][j][3] * rstd); st8_wt(o8 + 64 * j, w); }
        if (lane == 0) st4_wt(rms0 + row0 + u, __float_as_uint(1.0f / rstd)); }
}
DI void p0_xn_row(const float* xrow, const float* g, bf16_t* orow, int lane) {
    const f32x4* xr = (const f32x4*)xrow + lane; const f32x4* gr = (const f32x4*)g + lane;
    f32x4 v[4]; float s = 0.f;
#pragma unroll
    for (int j = 0; j < 4; ++j) { v[j] = xr[64 * j]; s += (v[j][0] * v[j][0] + v[j][1] * v[j][1]) + (v[j][2] * v[j][2] + v[j][3] * v[j][3]); }
    const float rstd = 1.0f / sqrtf(wave_sum(s) * (1.f / DM) + EPS);
    u32x2* o8 = (u32x2*)orow + lane;
#pragma unroll
    for (int j = 0; j < 4; ++j) { const f32x4 gg = gr[64 * j]; u32x2 w; w.x = cvtpk(v[j][0] * rstd * gg[0], v[j][1] * rstd * gg[1]); w.y = cvtpk(v[j][2] * rstd * gg[2], v[j][3] * rstd * gg[3]); o8[64 * j] = w; }
}

namespace att {
DI void conv_rows4(const bf16_t* proj, const float* cw, bf16_t* Y, int r0, int lane) {
    const int ch = 8 * lane; const bool head = (r0 & (SEQ - 1)) == 0;
    const bf16_t* pr = proj + (size_t)r0 * DPROJ + ch;
    u32x4 bg[4], cg[6], hc[6];
#pragma unroll
    for (int i = 0; i < 4; ++i) bg[i] = *(const u32x4*)(pr + (size_t)i * DPROJ);
#pragma unroll
    for (int q = 0; q < 6; ++q) { cg[q] = (u32x4){0u, 0u, 0u, 0u}; hc[q] = (u32x4){0u, 0u, 0u, 0u};
        if (q >= 2 || !head) { cg[q] = *(const u32x4*)(pr + ((ptrdiff_t)q - 2) * DPROJ + 512); hc[q] = *(const u32x4*)(pr + ((ptrdiff_t)q - 2) * DPROJ + 1024); } }
    f32x4 w[3][2];
#pragma unroll
    for (int k = 0; k < 3; ++k) { w[k][0] = *(const f32x4*)(cw + k * 512 + ch); w[k][1] = *(const f32x4*)(cw + k * 512 + ch + 4); }
    float u[6][8];
#pragma unroll
    for (int q = 0; q < 6; ++q)
#pragma unroll
        for (int j = 0; j < 4; ++j) { u[q][2 * j] = bflo(cg[q][j]) * bflo(hc[q][j]); u[q][2 * j + 1] = bfhi(cg[q][j]) * bfhi(hc[q][j]); }
#pragma unroll
    for (int i = 0; i < 4; ++i) {
        float acc[8]; float ss = 0.f;
#pragma unroll
        for (int e = 0; e < 8; ++e) { float a = 0.f;
#pragma unroll
            for (int k = 0; k < 3; ++k) a += w[k][e >> 2][e & 3] * u[i + k][e];
            const float b = (e & 1) ? bfhi(bg[i][e >> 1]) : bflo(bg[i][e >> 1]);
            acc[e] = a * b; ss += acc[e] * acc[e]; }
        const float rstd = 1.0f / sqrtf(wave_sum(ss) * (1.f / 512.f) + EPS);
        u32x4 o; o.x = cvtpk(acc[0] * rstd, acc[1] * rstd); o.y = cvtpk(acc[2] * rstd, acc[3] * rstd); o.z = cvtpk(acc[4] * rstd, acc[5] * rstd); o.w = cvtpk(acc[6] * rstd, acc[7] * rstd);
        st16_wt(Y + (size_t)(r0 + i) * DM + ch, o);
    }
}
DI void conv_rows8(const bf16_t* proj, const float* cw, bf16_t* Y, int r0, int lane_) {
    int lane; asm volatile("v_mbcnt_lo_u32_b32 %0, -1, 0\n\tv_mbcnt_hi_u32_b32 %0, -1, %0" : "=v"(lane)); (void)lane_;
    const int ch = 8 * lane; const bool head = (r0 & (SEQ - 1)) == 0;
    const bf16_t* pr = proj + (size_t)r0 * DPROJ + ch;
    u32x4 bg[8], cg[10], hc[10];
#pragma unroll
    for (int i = 0; i < 8; ++i) bg[i] = *(const u32x4*)(pr + (size_t)i * DPROJ);
#pragma unroll
    for (int q = 0; q < 10; ++q) { cg[q] = (u32x4){0u, 0u, 0u, 0u}; hc[q] = (u32x4){0u, 0u, 0u, 0u};
        if (q >= 2 || !head) { cg[q] = *(const u32x4*)(pr + ((ptrdiff_t)q - 2) * DPROJ + 512); hc[q] = *(const u32x4*)(pr + ((ptrdiff_t)q - 2) * DPROJ + 1024); } }
    f32x4 w[3][2];
#pragma unroll
    for (int k = 0; k < 3; ++k) { w[k][0] = *(const f32x4*)(cw + k * 512 + ch); w[k][1] = *(const f32x4*)(cw + k * 512 + ch + 4); }
#pragma unroll
    for (int i = 0; i < 8; ++i) {
        float acc[8]; float ss = 0.f;
#pragma unroll
        for (int e = 0; e < 8; ++e) { float a = 0.f;
#pragma unroll
            for (int k = 0; k < 3; ++k) { const unsigned cw_ = cg[i + k][e >> 1], hw_ = hc[i + k][e >> 1]; const float uu = (e & 1) ? bfhi(cw_) * bfhi(hw_) : bflo(cw_) * bflo(hw_); a += w[k][e >> 2][e & 3] * uu; }
            const float b = (e & 1) ? bfhi(bg[i][e >> 1]) : bflo(bg[i][e >> 1]);
            acc[e] = a * b; ss += acc[e] * acc[e]; }
        const float rstd = 1.0f / sqrtf(wave_sum(ss) * (1.f / 512.f) + EPS);
        u32x4 o; o.x = cvtpk(acc[0] * rstd, acc[1] * rstd); o.y = cvtpk(acc[2] * rstd, acc[3] * rstd); o.z = cvtpk(acc[4] * rstd, acc[5] * rstd); o.w = cvtpk(acc[6] * rstd, acc[7] * rstd);
        st16_wt(Y + (size_t)(r0 + i) * DM + ch, o);
        __builtin_amdgcn_sched_barrier(0);
    }
}
}

namespace att2 {
using bf16=__hip_bfloat16;
using bf16x8=__attribute__((ext_vector_type(8)))short;
using s16x4=__attribute__((ext_vector_type(4)))short;
using f32x16=__attribute__((ext_vector_type(16)))float;
using u32x4=__attribute__((ext_vector_type(4)))unsigned;
constexpr int BATCH=8,NHEAD=8,SEQ=2048,D=64,PQ=3072,PO=1024;
constexpr int NW=8,QBLK=32,QB=QBLK*NW,KVBLK=64,NQB=SEQ/QB;
__device__ __forceinline__ int crow(int r,int hi){return (r&3)+8*(r>>2)+4*hi;}
#define SBAR() __builtin_amdgcn_sched_barrier(0)
__device__ __forceinline__ void cmask(f32x16&p0,f32x16&p1,int jb,int qrel,int hi){
  const float NEG=-INFINITY; int kb=64*jb+4*hi;
  #pragma unroll
  for(int r=0;r<16;++r){int kv=kb+(r&3)+8*(r>>2); if(kv>qrel)p0[r]=NEG; if(kv+32>qrel)p1[r]=NEG;}
}

constexpr int NSLOT=3, SLOTB=8192;
constexpr int LDS_K=0, LDS_V=NSLOT*SLOTB, LDS_WS=2*NSLOT*SLOTB, LDS_OST=LDS_WS+NW*64*4, LDS_KM=LDS_OST+NW*4096, LDS_BYTES=LDS_KM+2048;
constexpr float C2=0.125f*1.4426950408889634f;
__device__ __forceinline__ void glds16(const void*gsrc,unsigned lds_dst){unsigned keep;
  asm volatile("s_mov_b32 %0, m0\n\ts_mov_b32 m0, %2\n\ts_nop 0\n\tglobal_load_lds_dwordx4 %1, off\n\ts_mov_b32 m0, %0":"=&s"(keep):"v"(gsrc),"s"(lds_dst):"memory");}
__device__ __forceinline__ float max3f(float a,float b,float c){float r;asm("v_max3_f32 %0, %1, %2, %3":"=v"(r):"v"(a),"v"(b),"v"(c));return r;}
__device__ __forceinline__ float max2f(float a,float b){float r;asm("v_max_f32_e32 %0, %1, %2":"=v"(r):"v"(a),"v"(b));return r;}
__device__ __forceinline__ float fadd_s(float a,float b){float r;asm("v_add_f32_e32 %0, %1, %2":"=v"(r):"v"(a),"v"(b));return r;}
__device__ __forceinline__ float fsub_s(float a,float b){float r;asm("v_sub_f32_e32 %0, %1, %2":"=v"(r):"v"(a),"v"(b));return r;}
typedef float f32x2_t __attribute__((ext_vector_type(2))); typedef __bf16 bf16x2_t __attribute__((ext_vector_type(2)));
__device__ __forceinline__ unsigned cvtpk_s(float lo,float hi){f32x2_t v={lo,hi};bf16x2_t b=__builtin_convertvector(v,bf16x2_t);return __builtin_bit_cast(unsigned,b);}
#define WAIT_BAR(N) asm volatile("s_waitcnt vmcnt(" #N ") lgkmcnt(0)\n\ts_barrier":::"memory")

__device__ __forceinline__ void qkt(f32x16&p0,f32x16&p1,const char*Kslot,const bf16x8*qr,const f32x16&negm,int r32,int hi){
  const char*kb=Kslot+hi*1024+r32*16;
  #pragma unroll
  for(int d0=0;d0<4;++d0){
    const bf16x8 b0=*reinterpret_cast<const bf16x8*>(kb+d0*2048);
    const bf16x8 b1=*reinterpret_cast<const bf16x8*>(kb+d0*2048+512);
    if(d0==0){p0=__builtin_amdgcn_mfma_f32_32x32x16_bf16(b0,qr[0],negm,0,0,0);p1=__builtin_amdgcn_mfma_f32_32x32x16_bf16(b1,qr[0],negm,0,0,0);}
    else{p0=__builtin_amdgcn_mfma_f32_32x32x16_bf16(b0,qr[d0],p0,0,0,0);p1=__builtin_amdgcn_mfma_f32_32x32x16_bf16(b1,qr[d0],p1,0,0,0);}}
}
typedef __attribute__((address_space(3))) const char* lds_cptr;
typedef short v4i16_t __attribute__((ext_vector_type(4)));
__device__ __forceinline__ void kload8(bf16x8*kf,lds_cptr kp){
  kf[0]=*(const __attribute__((address_space(3))) bf16x8*)(kp);      kf[1]=*(const __attribute__((address_space(3))) bf16x8*)(kp+512);
  kf[2]=*(const __attribute__((address_space(3))) bf16x8*)(kp+2048); kf[3]=*(const __attribute__((address_space(3))) bf16x8*)(kp+2560);
  kf[4]=*(const __attribute__((address_space(3))) bf16x8*)(kp+4096); kf[5]=*(const __attribute__((address_space(3))) bf16x8*)(kp+4608);
  kf[6]=*(const __attribute__((address_space(3))) bf16x8*)(kp+6144); kf[7]=*(const __attribute__((address_space(3))) bf16x8*)(kp+6656);
}
__device__ __forceinline__ void kload2(bf16x8*kf,lds_cptr kp,int j){ kf[2*j]=*(const __attribute__((address_space(3))) bf16x8*)(kp+j*2048); kf[2*j+1]=*(const __attribute__((address_space(3))) bf16x8*)(kp+j*2048+512); }
__device__ __forceinline__ s16x4 vtr(lds_cptr p){ return __builtin_bit_cast(s16x4,__builtin_amdgcn_ds_read_tr16_b64_v4i16((__attribute__((address_space(3))) v4i16_t*)p)); }
__device__ __forceinline__ float rowmax(const f32x16&p0,const f32x16&p1){
  float a=max3f(p0[0],p0[1],p1[0]),b=max3f(p0[2],p0[3],p1[1]);a=max3f(a,p1[2],p1[3]);
  #pragma unroll
  for(int r=4;r<16;r+=4){a=max3f(a,p0[r],p0[r+1]);b=max3f(b,p0[r+2],p0[r+3]);a=max3f(a,p1[r],p1[r+1]);b=max3f(b,p1[r+2],p1[r+3]);}
  const float m=max2f(a,b);
  auto rr=__builtin_amdgcn_permlane32_swap(__float_as_uint(m),__float_as_uint(m),false,false);
  return max2f(__uint_as_float(rr[0]),__uint_as_float(rr[1]));
}
__device__ __forceinline__ void pv(f32x16*o,int vb,bf16x8 pa0,bf16x8 pa1,bf16x8 pa2,bf16x8 pa3){
  #pragma unroll
  for(int d0=0;d0<2;++d0){s16x4 lo[4],hi[4];
    #pragma unroll
    for(int ks=0;ks<4;++ks){
      asm volatile("ds_read_b64_tr_b16 %0,%1 offset:%c2":"=&v"(lo[ks]):"v"(vb),"i"(d0*4096+ks*1024):"memory");
      asm volatile("ds_read_b64_tr_b16 %0,%1 offset:%c2":"=&v"(hi[ks]):"v"(vb),"i"(d0*4096+ks*1024+512):"memory");}
    asm volatile("s_waitcnt lgkmcnt(0)":::"memory");SBAR();
    #define PK(k) (bf16x8){lo[k][0],lo[k][1],lo[k][2],lo[k][3],hi[k][0],hi[k][1],hi[k][2],hi[k][3]}
    o[d0]=__builtin_amdgcn_mfma_f32_32x32x16_bf16(pa0,PK(0),o[d0],0,0,0);
    o[d0]=__builtin_amdgcn_mfma_f32_32x32x16_bf16(pa1,PK(1),o[d0],0,0,0);
    o[d0]=__builtin_amdgcn_mfma_f32_32x32x16_bf16(pa2,PK(2),o[d0],0,0,0);
    o[d0]=__builtin_amdgcn_mfma_f32_32x32x16_bf16(pa3,PK(3),o[d0],0,0,0);
    #undef PK
  }
}

#ifndef ATTN_STORE16
#define ATTN_STORE16(p,v) st16_wt((void*)(p),(v))
#endif
template<int THRL> __device__ __forceinline__ void attn_unit(int b,int h,int qb,const bf16*Q,const bf16*__restrict__ K,const bf16*__restrict__ V,bf16*O,const float*ksum,float*ssqa,char*shm){
  int lane; asm volatile("v_mbcnt_lo_u32_b32 %0, -1, 0\n\tv_mbcnt_hi_u32_b32 %0, -1, %0":"=v"(lane));     const int tid=threadIdx.x,r32=lane&31,hi=lane>>5; const int wid=__builtin_amdgcn_readfirstlane(tid>>6);
  const long rowbase=(long)b*SEQ; const int q0=qb*QB;
  const bf16*Qw=Q+(rowbase+q0+wid*QBLK)*PQ+h*D;
  const bf16*Kh=K+rowbase*PQ+h*D,*Vh=V+rowbase*PQ+h*D;
  const unsigned lds0=(unsigned)(uintptr_t)shm;
  float*wsf=(float*)(shm+LDS_WS)+wid*64;
  const bf16*ksrc=Kh+(long)lane*PQ+wid*8;
  const bf16*vsrc=Vh+(long)(16*(wid&3)+(lane>>2))*PQ+(wid>>2)*32+(lane&3)*8;
  const unsigned kdst=lds0+LDS_K+wid*1024, vdst=lds0+LDS_V+wid*1024;
  #define DMA_K(t,slot) glds16(ksrc+(long)(t)*KVBLK*PQ,(unsigned)__builtin_amdgcn_readfirstlane(kdst+(slot)))
  #define DMA_V(t,slot) glds16(vsrc+(long)(t)*KVBLK*PQ,(unsigned)__builtin_amdgcn_readfirstlane(vdst+(slot)))
  const int vb0=(int)(lds0+LDS_V)+((lane>>4)&1)*32+(lane&3)*8+(4*hi+((lane&15)>>2))*64;
  const char*Kbase=shm+LDS_K; bf16x8 kf[8];
  const lds_cptr shm3=(lds_cptr)shm; const lds_cptr kp0=shm3+LDS_K+hi*1024+r32*16; const lds_cptr vp0=shm3+LDS_V+((lane>>4)&1)*32+(lane&3)*8+(4*hi+((lane&15)>>2))*64;
  const int NT=(q0+QB)/KVBLK;
  DMA_K(0,0);DMA_V(0,0);DMA_K(1,SLOTB);
  bf16x8 qr[4];
  #pragma unroll
  for(int d0=0;d0<4;++d0)qr[d0]=*reinterpret_cast<const bf16x8*>(&Qw[(long)r32*PQ+d0*16+hi*8]);
  unsigned selmask=(1u<<qb)-1u;
  { __attribute__((address_space(3))) float*km=(__attribute__((address_space(3))) float*)(shm+LDS_KM);
    if(tid<64*qb)km[tid]=ksum[(long)(b*8+(tid>>6))*512+h*64+(tid&63)];
    __syncthreads();
    if(qb>3){ float gt[7];
      #pragma unroll
      for(int n=0;n<7;++n){ float a=-3.0e38f;
        if(n<qb){ a=0.f;
          #pragma unroll
          for(int s=0;s<4;++s)
            #pragma unroll
            for(int j=0;j<8;++j)a+=__uint_as_float(((unsigned)(unsigned short)qr[s][j])<<16)*km[n*64+16*s+8*hi+j];
          a+=__shfl_xor(a,32); }
        gt[n]=a; }
      selmask=0u;
      #pragma unroll
      for(int n=0;n<7;++n){ int cnt=0;
        #pragma unroll
        for(int m2=0;m2<7;++m2)if(m2!=n)cnt+=(gt[m2]>gt[n]||(gt[m2]==gt[n]&&m2<n))?1:0;
        if(cnt<3&&n<qb)selmask|=1u<<n; } }
    __syncthreads(); }
  #define MMASK(P0,P1,t) do{ const int blk_=(t)>>2; if(blk_<qb&&!((selmask>>blk_)&1u)){ _Pragma("unroll") for(int r=0;r<16;++r){P0[r]=-1.0e30f;P1[r]=-1.0e30f;} } }while(0)
  float mhat=0.f,l_reg=0.f;f32x16 o[2];o[0]=f32x16{};o[1]=f32x16{};const f32x16 negm=f32x16{};
  const int qrel=wid*QBLK+r32;
  #define CMASK(P0,P1,t) do{int jb_=(t)-(NT-4); if(jb_>=0)cmask(P0,P1,jb_,qrel,hi);}while(0)
  bool resc=false;
  #define START(P0,P1) do{ const float rm=max2f(rowmax(P0,P1),-1000.0f); resc=false; \
    { const float dl=rm; mhat=fadd_s(mhat,dl); \
      _Pragma("unroll") for(int r=0;r<16;++r){P0[r]=fsub_s(P0[r],dl);P1[r]=fsub_s(P1[r],dl);} \
      } \
    _Pragma("unroll") for(int r=0;r<16;++r)P0[r]=__builtin_amdgcn_exp2f(P0[r]); }while(0)
  #define RESC() do{ if(resc){ asm volatile("s_waitcnt lgkmcnt(0)":::"memory"); \
      _Pragma("unroll") for(int d_=0;d_<2;++d_) _Pragma("unroll") for(int r=0;r<16;++r)o[d_][r]*=wsf[crow(r,hi)]; } }while(0)
  f32x16 pA0,pA1,pB0,pB1;
  int sl_prev=0,sl_cur=0,sl_next=SLOTB;
  #define ROT() do{sl_prev=sl_cur;sl_cur=sl_next;sl_next=(sl_next==(NSLOT-1)*SLOTB)?0:sl_next+SLOTB;}while(0)
  DMA_K(2,2*SLOTB);
  WAIT_BAR(3);
  qkt(pA0,pA1,Kbase,qr,negm,r32,hi);asm volatile("s_nop 15\n\ts_nop 7":"+v"(pA0),"+v"(pA1));CMASK(pA0,pA1,0);MMASK(pA0,pA1,0);
  START(pA0,pA1);
  _Pragma("unroll") for(int r=0;r<16;++r)pA1[r]=__builtin_amdgcn_exp2f(pA1[r]);
  WAIT_BAR(0);
  DMA_K(3,0);DMA_V(1,SLOTB);
  ROT();
  kload8(kf,kp0+sl_cur);
  WAIT_BAR(2);
  s16x4 vlo[8],vhi[8]; u32x4 pw0,pw1,pw2,pw3;
  #define PKW(P,B) cvtpk_s(P[B],P[B+1])
  #define PAF(k) __builtin_bit_cast(bf16x8,pw##k)
  #define VFR(i) (bf16x8){vlo[i][0],vlo[i][1],vlo[i][2],vlo[i][3],vhi[i][0],vhi[i][1],vhi[i][2],vhi[i][3]}
  #define PIN(x) asm volatile("":"+v"(x))
  #define MX3(a,b,c) __builtin_fmaxf(__builtin_fmaxf((a),(b)),(c))
  #define GAPA(MF,A0,A1,A2,A3,W0,W1,PW) do{ MF; sacc+=A0; sacc+=A1; sacc+=A2; sacc+=A3; PIN(sacc); W0; W1; PIN(PW); SBAR(); }while(0)
  #define EX(v) __builtin_amdgcn_exp2f(v)
  #define GAPB(MF,X,B) do{ MF; X[B]=EX(X[B]); X[B+1]=EX(X[B+1]); X[B+2]=EX(X[B+2]); X[B+3]=EX(X[B+3]); PIN(X); SBAR(); }while(0)
  #define VRD(i) do{ vlo[i]=vtr(vp_+(((i)>>2)*4096+((i)&3)*1024)); vhi[i]=vtr(vp_+(((i)>>2)*4096+((i)&3)*1024+512)); }while(0)
  #define KRD(G,j) do{ if(G){ kload2(kf,kp0+sl_next,j); SBAR(); } }while(0)
  #define STEP(C0,C1,P0,P1,t,GK,GV,GL) do{ SBAR(); \
    const lds_cptr vp_=vp0+sl_prev; \
    VRD(0); SBAR(); float sacc=(P0[0]+P0[1]); \
    GAPA(C0=__builtin_amdgcn_mfma_f32_32x32x16_bf16(kf[0],qr[0],negm,0,0,0), P0[2],P0[3],P0[4],P0[5],     pw0[0]=PKW(P0,0), pw0[1]=PKW(P0,2), pw0); \
    VRD(4); SBAR(); GAPA(C1=__builtin_amdgcn_mfma_f32_32x32x16_bf16(kf[1],qr[0],negm,0,0,0), P0[6],P0[7],P0[8],P0[9],     pw0[2]=PKW(P0,4), pw0[3]=PKW(P0,6), pw0); \
    VRD(1); SBAR(); GAPA(C0=__builtin_amdgcn_mfma_f32_32x32x16_bf16(kf[2],qr[1],C0,0,0,0),   P0[10],P0[11],P0[12],P0[13], pw1[0]=PKW(P0,8), pw1[1]=PKW(P0,10), pw1); \
    VRD(5); SBAR(); GAPA(C1=__builtin_amdgcn_mfma_f32_32x32x16_bf16(kf[3],qr[1],C1,0,0,0),   P0[14],P0[15],P1[0],P1[1],   pw1[2]=PKW(P0,12),pw1[3]=PKW(P0,14), pw1); \
    VRD(2); SBAR(); GAPA(C0=__builtin_amdgcn_mfma_f32_32x32x16_bf16(kf[4],qr[2],C0,0,0,0),   P1[2],P1[3],P1[4],P1[5],     pw2[0]=PKW(P1,0), pw2[1]=PKW(P1,2), pw2); \
    VRD(6); SBAR(); GAPA(C1=__builtin_amdgcn_mfma_f32_32x32x16_bf16(kf[5],qr[2],C1,0,0,0),   P1[6],P1[7],P1[8],P1[9],     pw2[2]=PKW(P1,4), pw2[3]=PKW(P1,6), pw2); \
    VRD(3); SBAR(); GAPA(C0=__builtin_amdgcn_mfma_f32_32x32x16_bf16(kf[6],qr[3],C0,0,0,0),   P1[10],P1[11],P1[12],P1[13], pw3[0]=PKW(P1,8), pw3[1]=PKW(P1,10), pw3); \
    VRD(7); SBAR(); GAPA(C1=__builtin_amdgcn_mfma_f32_32x32x16_bf16(kf[7],qr[3],C1,0,0,0),   P1[14],P1[15],0.f,0.f,       pw3[2]=PKW(P1,12),pw3[3]=PKW(P1,14), pw3); \
    l_reg+=sacc; \
    if(GK){DMA_K((t)+3,sl_cur);} if(GV){DMA_V((t)+1,sl_next);} \
    { const int blk_=(t)>>2; const float ms_=(blk_<qb&&!((selmask>>blk_)&1u))?1.0e30f:mhat;     \
      _Pragma("unroll") for(int r=0;r<16;++r){C0[r]-=ms_;C1[r]-=ms_;} } \
    CMASK(C0,C1,t); \
    { float a=MX3(C0[0],C0[1],C1[0]),b=MX3(C0[2],C0[3],C1[1]); a=MX3(a,C1[2],C1[3]); \
      _Pragma("unroll") for(int r=4;r<16;r+=4){a=MX3(a,C0[r],C0[r+1]);b=MX3(b,C0[r+2],C0[r+3]);a=MX3(a,C1[r],C1[r+1]);b=MX3(b,C1[r+2],C1[r+3]);} \
      float rm=__builtin_fmaxf(a,b); { auto rr=__builtin_amdgcn_permlane32_swap(__float_as_uint(rm),__float_as_uint(rm),false,false); rm=__builtin_fmaxf(__uint_as_float(rr[0]),__uint_as_float(rr[1])); } \
      resc=false; \
      if(__builtin_expect(__any(rm>(float)THRL),0)){ const float dl=__builtin_fmaxf(rm,0.f); mhat+=dl; \
        _Pragma("unroll") for(int r=0;r<16;++r){C0[r]-=dl;C1[r]-=dl;} \
        \
        const float f=__builtin_amdgcn_exp2f(-dl); l_reg*=f; if(hi==0)wsf[r32]=f; resc=true; } } \
    SBAR(); \
    GAPB(o[0]=__builtin_amdgcn_mfma_f32_32x32x16_bf16(PAF(0),VFR(0),o[0],0,0,0), C0,0); \
    GAPB(o[1]=__builtin_amdgcn_mfma_f32_32x32x16_bf16(PAF(0),VFR(4),o[1],0,0,0), C0,4); \
    KRD(GL,0); GAPB(o[0]=__builtin_amdgcn_mfma_f32_32x32x16_bf16(PAF(1),VFR(1),o[0],0,0,0), C0,8); \
    KRD(GL,1); GAPB(o[1]=__builtin_amdgcn_mfma_f32_32x32x16_bf16(PAF(1),VFR(5),o[1],0,0,0), C0,12); \
    KRD(GL,2); GAPB(o[0]=__builtin_amdgcn_mfma_f32_32x32x16_bf16(PAF(2),VFR(2),o[0],0,0,0), C1,0); \
    KRD(GL,3); GAPB(o[1]=__builtin_amdgcn_mfma_f32_32x32x16_bf16(PAF(2),VFR(6),o[1],0,0,0), C1,4); \
    GAPB(o[0]=__builtin_amdgcn_mfma_f32_32x32x16_bf16(PAF(3),VFR(3),o[0],0,0,0), C1,8); \
    GAPB(o[1]=__builtin_amdgcn_mfma_f32_32x32x16_bf16(PAF(3),VFR(7),o[1],0,0,0), C1,12); \
    }while(0)
  int t=1;
  #undef CMASK
  #define CMASK(P0,P1,t) do{}while(0)
  for(;t+5<NT;t+=2){
    STEP(pB0,pB1,pA0,pA1,t,true,true,true);     WAIT_BAR(2); RESC(); ROT();
    STEP(pA0,pA1,pB0,pB1,t+1,true,true,true);   WAIT_BAR(2); RESC(); ROT();
  }
  #undef CMASK
  #define CMASK(P0,P1,t) do{int jb_=(t)-(NT-4); if(jb_>=0)cmask(P0,P1,jb_,qrel,hi);}while(0)
  #define ENDW(tt) do{ if((tt)+3<NT){WAIT_BAR(2);} else if((tt)+2<NT){WAIT_BAR(1);} else {WAIT_BAR(0);} }while(0)
  for(;t+1<NT;t+=2){
    STEP(pB0,pB1,pA0,pA1,t,(t+3<NT),(t+1<NT),(t+1<NT));       ENDW(t);   RESC(); ROT();
    STEP(pA0,pA1,pB0,pB1,t+1,(t+4<NT),(t+2<NT),(t+2<NT));     ENDW(t+1); RESC(); ROT();
  }
  STEP(pB0,pB1,pA0,pA1,NT-1,false,false,false); RESC();
  { float sacc=pB0[0]+pB0[1]; _Pragma("unroll") for(int r=2;r<16;++r)sacc+=pB0[r]; _Pragma("unroll") for(int r=0;r<16;++r)sacc+=pB1[r]; l_reg+=sacc;
    pw0=(u32x4){PKW(pB0,0),PKW(pB0,2),PKW(pB0,4),PKW(pB0,6)};pw1=(u32x4){PKW(pB0,8),PKW(pB0,10),PKW(pB0,12),PKW(pB0,14)};pw2=(u32x4){PKW(pB1,0),PKW(pB1,2),PKW(pB1,4),PKW(pB1,6)};pw3=(u32x4){PKW(pB1,8),PKW(pB1,10),PKW(pB1,12),PKW(pB1,14)};
    SBAR(); pv(o,vb0+sl_cur,PAF(0),PAF(1),PAF(2),PAF(3)); }
  #undef PKW
  #undef PAF
  #undef VFR
  #undef PIN
  #undef MX3
  #undef GAPA
  #undef GAPB
  #undef EX
  #undef VRD
  #undef KRD
  #undef STEP
  #undef ENDW
  {auto rr=__builtin_amdgcn_permlane32_swap(__float_as_uint(l_reg),__float_as_uint(l_reg),false,false);l_reg=__uint_as_float(rr[0])+__uint_as_float(rr[1]);}
  if(hi==0)wsf[32+r32]=l_reg;asm volatile("s_waitcnt lgkmcnt(0)":::"memory");
  float rli[16];
  #pragma unroll
  for(int r=0;r<16;++r)rli[r]=__builtin_amdgcn_rcpf(wsf[32+crow(r,hi)]);
  bf16*Ow=O+(rowbase+q0+wid*QBLK)*PO+h*D;
  { bf16*stg=(bf16*)(shm+LDS_OST)+wid*2048;
    #pragma unroll
    for(int r=0;r<16;++r){const int orow=crow(r,hi);
      #pragma unroll
      for(int d0=0;d0<2;++d0)stg[orow*64+d0*32+r32]=__float2bfloat16(o[d0][r]*rli[r]);}
    asm volatile("s_waitcnt lgkmcnt(0)":::"memory");
    int l2; asm volatile("v_mbcnt_lo_u32_b32 %0, -1, 0\n\tv_mbcnt_hi_u32_b32 %0, -1, %0":"=v"(l2));
    #pragma unroll
    for(int i=0;i<4;++i){const int row=i*8+(l2>>3),ch=l2&7; const u32x4 v=*(const u32x4*)(stg+row*64+ch*8); ATTN_STORE16(Ow+(long)row*PO+ch*8,v);
      float ss=0.f;
      #pragma unroll
      for(int j=0;j<4;++j){const float a=__uint_as_float(v[j]<<16),c=__uint_as_float(v[j]&0xffff0000u);ss+=a*a+c*c;}
      ss+=__shfl_xor(ss,1);ss+=__shfl_xor(ss,2);ss+=__shfl_xor(ss,4);
      if(ch==0)ssqa[(rowbase+q0+wid*QBLK+row)*8+h]=ss;} }
  asm volatile("s_waitcnt lgkmcnt(0)\n\ts_barrier":::"memory");
  #undef DMA_K
  #undef DMA_V
  #undef MMASK
  #undef CMASK
  #undef START
  #undef RESC
  #undef ROT
}
constexpr int ATTN_LDS_BYTES=LDS_BYTES;
#undef SBAR
#undef WAIT_BAR
}


namespace p5 {
constexpr int KLD = 136, SLD = 264;
constexpr int OFF_KL = 0, OFF_S = 2 * 128 * KLD * 2, OFF_REC = OFF_S + 64 * SLD * 4, LDS_NEED = OFF_REC + 64 * 2 * 16 * 4;
static_assert(LDS_NEED <= SCR_BYTES && OFF_S % 16 == 0, "P5 LDS map");

DI unsigned mkkey(float s, unsigned low, unsigned lowmask) { unsigned u = __float_as_uint(s); u ^= (unsigned)((int)u >> 31) | 0x80000000u; return (u & ~lowmask) | low; }
DI float keyval(unsigned key, unsigned lowmask) { unsigned u = (key & ~lowmask) | ((lowmask + 1u) >> 1); return (u & 0x80000000u) ? __uint_as_float(u & 0x7fffffffu) : __uint_as_float(~u); }
DI unsigned umax(unsigned a, unsigned b) { return a > b ? a : b; }
DI unsigned umin(unsigned a, unsigned b) { return a < b ? a : b; }
template <int N> DI void sort_desc(unsigned (&a)[N]) {
#pragma unroll
    for (int k = 2; k <= N; k <<= 1)
#pragma unroll
        for (int j = k >> 1; j > 0; j >>= 1)
#pragma unroll
            for (int i = 0; i < N; ++i) { const int l = i ^ j; if (l > i) { const unsigned x = a[i], y = a[l], mx = umax(x, y), mn = umin(x, y); const bool desc = ((i & k) == 0); a[i] = desc ? mx : mn; a[l] = desc ? mn : mx; } }
}
template <int N> DI void merge_desc(unsigned (&a)[N]) {
#pragma unroll
    for (int j = N >> 1; j > 0; j >>= 1)
#pragma unroll
        for (int i = 0; i < N; ++i) { const int l = i ^ j; if (l > i) { const unsigned x = a[i], y = a[l]; a[i] = umax(x, y); a[l] = umin(x, y); } }
}
template <int XR> DI unsigned dppx(unsigned v) { return (unsigned)__builtin_amdgcn_update_dpp(0, (int)v, XR == 1 ? 0xB1 : XR == 2 ? 0x4E : 0x141, 0xF, 0xF, false); }
template <int XR> DI void xmerge16(unsigned (&a)[16]) {
    unsigned p[16];
#pragma unroll
    for (int i = 0; i < 16; ++i) p[i] = dppx<XR>(a[i]);
#pragma unroll
    for (int i = 0; i < 16; ++i) a[i] = umax(a[i], p[15 - i]);
    merge_desc<16>(a);
}

constexpr int SLD2 = 260;
constexpr int OFF_S2 = 0, OFF_REC2 = 128 * SLD2 * 4, LDS_NEED2 = OFF_REC2 + 128 * 2 * 16 * 4;
static_assert(LDS_NEED2 <= SCR_BYTES && OFF_REC2 % 16 == 0, "P5 LDS map (128-row chunks)");
DI int spos(int c) { return (c >> 7) * 130 + ((c >> 6) & 1) * 65 + (c & 63); }
struct KeyFrags { bf16x8 b[4][2]; };
DI void load_keys(KeyFrags& kf, const bf16_t* K1b, const bf16_t* K2b, int h, int lane, int w) {
    const bf16_t* base = ((w >> 2) ? K2b : K1b) + (size_t)(h * 128 + 32 * (w & 3) + (lane & 15)) * 128 + 8 * (lane >> 4);
#pragma unroll
    for (int ks = 0; ks < 4; ++ks)
#pragma unroll
        for (int nt = 0; nt < 2; ++nt) kf.b[ks][nt] = *(const bf16x8*)(base + (size_t)(16 * nt) * 128 + 32 * ks);
}
DI void top16(unsigned (&a)[16], const unsigned (&b)[16]) {
#pragma unroll
    for (int i = 0; i < 16; ++i) a[i] = umax(a[i], b[15 - i]);
    merge_desc<16>(a);
}
#define P5_LBAR() do { asm volatile("s_waitcnt lgkmcnt(0)" ::: "memory"); __builtin_amdgcn_s_barrier(); asm volatile("" ::: "memory"); } while (0)
DI void chunk128(const Frame& F, int r0, int h, const bf16_t* qry, const float* ssqx, int* eidt, float* gate, const KeyFrags& kf, const float* csrc, unsigned char* cdst, size_t citem0, float csc, const float* ccolg) {
    int tid; asm volatile("v_mov_b32 %0, %1" : "=v"(tid) : "v"(F.tid));
    const int lane = F.lane, w = F.wave;
    LAS float* S = (LAS float*)(F.lds + OFF_S2); LAS unsigned* REC = (LAS unsigned*)(F.lds + OFF_REC2);
    {
        const int half = w >> 2, n0 = 32 * (w & 3), fr = lane & 15, fq = lane >> 4;
#pragma unroll
        for (int mh = 0; mh < 2; ++mh) {
            f32x4 acc[4][2];
#pragma unroll
            for (int m = 0; m < 4; ++m) { acc[m][0] = (f32x4){0.f, 0.f, 0.f, 0.f}; acc[m][1] = (f32x4){0.f, 0.f, 0.f, 0.f}; }
            const bf16_t* qp = qry + (size_t)(r0 + 64 * mh + fr) * 2048 + h * 256 + half * 128 + 8 * fq;
#pragma unroll
            for (int ks = 0; ks < 4; ++ks)
#pragma unroll
                for (int m = 0; m < 4; ++m) { const bf16x8 a = *(const bf16x8*)(qp + (size_t)(16 * m) * 2048 + 32 * ks);
#pragma unroll
                    for (int nt = 0; nt < 2; ++nt) acc[m][nt] = __builtin_amdgcn_mfma_f32_16x16x32_bf16(a, kf.b[ks][nt], acc[m][nt], 0, 0, 0); }
#pragma unroll
            for (int m = 0; m < 4; ++m)
#pragma unroll
                for (int nt = 0; nt < 2; ++nt) { const int pos = spos(half * 128 + n0 + 16 * nt + fr);
#pragma unroll
                    for (int r = 0; r < 4; ++r) S[(64 * mh + 16 * m + 4 * fq + r) * SLD2 + pos] = acc[m][nt][r]; }
        }
    }
    P5_LBAR();
    CvtRegs<4> cvr; cvt8_load<4>(cvr, csrc, citem0, lane);
    const int row = tid >> 2, half = (tid >> 1) & 1, q2 = tid & 1, j4 = tid & 3;
    f32x4 sq0, sq1, sq2, sq3; { const f32x4* sp = (const f32x4*)(ssqx + (size_t)(r0 + row) * 16); sq0 = sp[0]; sq1 = sp[1]; sq2 = sp[2]; sq3 = sp[3]; }
    unsigned a[16];
    {
        unsigned b[16], c[16], d[16];
        const LAS float* sp = S + row * SLD2 + half * 130 + q2 * 65;
#pragma unroll
        for (int i = 0; i < 16; ++i) { a[i] = mkkey(sp[i], 127u - (unsigned)(64 * q2 + i), 127u); b[i] = mkkey(sp[16 + i], 127u - (unsigned)(64 * q2 + 16 + i), 127u);
            c[i] = mkkey(sp[32 + i], 127u - (unsigned)(64 * q2 + 32 + i), 127u); d[i] = mkkey(sp[48 + i], 127u - (unsigned)(64 * q2 + 48 + i), 127u); }
        sort_desc<16>(a); sort_desc<16>(b); top16(a, b);
        sort_desc<16>(c); sort_desc<16>(d); top16(c, d);
        top16(a, c);
    }
    xmerge16<1>(a);
    if (q2 == 0) {
#pragma unroll
        for (int i = 0; i < 16; ++i) REC[(row * 2 + half) * 16 + i] = a[i];
    }
    cvt8_store<4>(cvr, cdst, citem0, lane, csc, ccolg);
    cvt8_load<4>(cvr, csrc, citem0 + 4, lane);
    asm volatile("s_waitcnt lgkmcnt(0)" ::: "memory");
    unsigned t16[16];
#pragma unroll
    for (int e = 0; e < 16; ++e) {
        const int c = 16 * j4 + e; int ci = 0, st = 0;
        if (c >= 16) { ci = 1; st = 16; } if (c >= 24) { ci = 2; st = 24; } if (c >= 29) { ci = 3; st = 29; } if (c >= 33) { ci = 4; st = 33; }
        if (c >= 36) { ci = 5; st = 36; } if (c >= 38) { ci = 6; st = 38; } if (c >= 40) { ci = 7; st = 40; } if (c >= 42) { ci = 8 + (c - 42); st = c; }
        const int cj = c - st;
        unsigned key = 0u;
        if (c < 50) { const float v = keyval(REC[(row * 2) * 16 + ci], 127u) + keyval(REC[(row * 2 + 1) * 16 + cj], 127u); key = mkkey(v, (unsigned)((ci << 4) | cj), 255u); }
        t16[e] = key;
    }
    sort_desc<16>(t16);
    xmerge16<1>(t16); xmerge16<2>(t16);
    unsigned kk[4];
#pragma unroll
    for (int e = 0; e < 4; ++e) kk[e] = (j4 == 0) ? t16[e] : (j4 == 1) ? t16[4 + e] : (j4 == 2) ? t16[8 + e] : t16[12 + e];
    const float ssq = ((sq0[0] + sq0[1]) + (sq0[2] + sq0[3])) + ((sq1[0] + sq1[1]) + (sq1[2] + sq1[3])) + ((sq2[0] + sq2[1]) + (sq2[2] + sq2[3])) + ((sq3[0] + sq3[1]) + (sq3[2] + sq3[3]));
    const float rstd = 1.0f / sqrtf(ssq * (1.f / DM) + EPS);
    const float vmax = keyval(t16[0], 255u);
    float ev[4]; float es = 0.f;
#pragma unroll
    for (int e = 0; e < 4; ++e) { ev[e] = __expf(rstd * (keyval(kk[e], 255u) - vmax)); es += ev[e]; }
    es += __uint_as_float(dppx<1>(__float_as_uint(es))); es += __uint_as_float(dppx<2>(__float_as_uint(es)));
    const float inv = 1.0f / es;
    int* et = eidt + (size_t)(r0 + row) * 128 + (4 * (j4 & 1)) * 16 + 2 * h + (j4 >> 1);
#pragma unroll
    for (int e = 0; e < 4; ++e) { const unsigned cd = kk[e] & 255u;
        et[16 * e] = (int)(127u - (REC[(row * 2) * 16 + (cd >> 4)] & 127u)) * 128 + (int)(127u - (REC[(row * 2 + 1) * 16 + (cd & 15u)] & 127u)); }
    *(f32x4*)(gate + (size_t)(r0 + row) * 128 + h * 16 + 4 * j4) = (f32x4){ev[0] * inv, ev[1] * inv, ev[2] * inv, ev[3] * inv};
    cvt8_store<4>(cvr, cdst, citem0 + 4, lane, csc, ccolg);
    P5_LBAR();
}
}

namespace p5w {
using p5::mkkey; using p5::keyval; using p5::umax; using p5::umin; using p5::sort_desc; using p5::merge_desc; using p5::top16;
constexpr int KPITCH = 272, KHALF = 128 * KPITCH, OFF_REC = 2 * KHALF, REC_WAVE = 32 * 33 * 4;
static_assert(OFF_REC + NWAVES * REC_WAVE <= SCR_BYTES && KHALF % 16 == 0, "P5 (wave-owned rows) LDS map");
DI void keys_to_lds(LAS unsigned char* lds, const bf16_t* K1b, const bf16_t* K2b, int h, int tid_) {
    int tid; asm volatile("v_mov_b32 %0, %1" : "=v"(tid) : "v"(tid_));
    u32x4 v[8];
#pragma unroll
    for (int i = 0; i < 8; ++i) { const int id = tid + 512 * (i & 3); const int row = id >> 4, c = id & 15;
        v[i] = *(const u32x4*)(((i >> 2) ? K2b : K1b) + (size_t)(h * 128 + row) * 128 + 8 * c); }
#pragma unroll
    for (int i = 0; i < 8; ++i) { const int id = tid + 512 * (i & 3); const int row = id >> 4, c = id & 15;
        *(LAS u32x4*)(lds + (i >> 2) * KHALF + row * KPITCH + 16 * c) = v[i]; }
}
DI void sort16_desc(unsigned (&a)[16]) {
#define P5W_CE(i, j) do { const unsigned x_ = a[i], y_ = a[j]; a[i] = umax(x_, y_); a[j] = umin(x_, y_); } while (0)
    P5W_CE(0, 13); P5W_CE(1, 12); P5W_CE(2, 15); P5W_CE(3, 14); P5W_CE(4, 8); P5W_CE(5, 6); P5W_CE(7, 11); P5W_CE(9, 10);
    P5W_CE(0, 5); P5W_CE(1, 7); P5W_CE(2, 9); P5W_CE(3, 4); P5W_CE(6, 13); P5W_CE(8, 14); P5W_CE(10, 15); P5W_CE(11, 12);
    P5W_CE(0, 1); P5W_CE(2, 3); P5W_CE(4, 5); P5W_CE(6, 8); P5W_CE(7, 9); P5W_CE(10, 11); P5W_CE(12, 13); P5W_CE(14, 15);
    P5W_CE(0, 2); P5W_CE(1, 3); P5W_CE(4, 10); P5W_CE(5, 11); P5W_CE(6, 7); P5W_CE(8, 9); P5W_CE(12, 14); P5W_CE(13, 15);
    P5W_CE(1, 2); P5W_CE(3, 12); P5W_CE(4, 6); P5W_CE(5, 7); P5W_CE(8, 10); P5W_CE(9, 11); P5W_CE(13, 14);
    P5W_CE(1, 4); P5W_CE(2, 6); P5W_CE(5, 8); P5W_CE(7, 10); P5W_CE(9, 13); P5W_CE(11, 14);
    P5W_CE(2, 4); P5W_CE(3, 6); P5W_CE(9, 12); P5W_CE(11, 13);
    P5W_CE(3, 5); P5W_CE(6, 8); P5W_CE(7, 9); P5W_CE(10, 12);
    P5W_CE(3, 4); P5W_CE(5, 6); P5W_CE(7, 8); P5W_CE(9, 10); P5W_CE(11, 12);
    P5W_CE(6, 7); P5W_CE(8, 9);
#undef P5W_CE
}
DI void sort10_desc(unsigned (&a)[16]) {
#define P5W_CE(i, j) do { const unsigned x_ = a[i], y_ = a[j]; a[i] = umax(x_, y_); a[j] = umin(x_, y_); } while (0)
    P5W_CE(0, 8); P5W_CE(1, 9); P5W_CE(2, 7); P5W_CE(3, 5); P5W_CE(4, 6);
    P5W_CE(0, 2); P5W_CE(1, 4); P5W_CE(5, 8); P5W_CE(7, 9);
    P5W_CE(0, 3); P5W_CE(2, 4); P5W_CE(5, 7); P5W_CE(6, 9);
    P5W_CE(0, 1); P5W_CE(3, 6); P5W_CE(8, 9);
    P5W_CE(1, 5); P5W_CE(2, 3); P5W_CE(4, 8); P5W_CE(6, 7);
    P5W_CE(1, 2); P5W_CE(3, 5); P5W_CE(4, 6); P5W_CE(7, 8);
    P5W_CE(2, 3); P5W_CE(4, 5); P5W_CE(6, 7);
    P5W_CE(3, 4); P5W_CE(5, 6);
#undef P5W_CE
}
DI unsigned bperm(int addr, unsigned v) { return (unsigned)__builtin_amdgcn_ds_bpermute(addr, (int)v); }
DI void xmerge32(unsigned (&a)[16], int paddr) {
    unsigned p[16];
#pragma unroll
    for (int i = 0; i < 16; ++i) p[i] = bperm(paddr, a[i]);
#pragma unroll
    for (int i = 0; i < 16; ++i) a[i] = umax(a[i], p[15 - i]);
    merge_desc<16>(a);
}
template <class Hook> DI void half_a(unsigned (&k0)[16], unsigned (&k2)[16], unsigned (&k3)[16], const bf16x8 (&bq)[8], const LAS unsigned char* kl, int p4, const Hook& after_first_step) {
    f32x16 acc[4];
#pragma unroll
    for (int mt = 0; mt < 4; ++mt)
#pragma unroll
        for (int r = 0; r < 16; ++r) acc[mt][r] = 0.f;
    bf16x8 ka[2][4];
#pragma unroll
    for (int mt = 0; mt < 4; ++mt) ka[0][mt] = *(const LAS bf16x8*)(kl + (32 * mt) * KPITCH);
#pragma unroll
    for (int ks = 0; ks < 8; ++ks) {
        if (ks < 7) {
#pragma unroll
            for (int mt = 0; mt < 4; ++mt) ka[(ks + 1) & 1][mt] = *(const LAS bf16x8*)(kl + (32 * mt) * KPITCH + 32 * (ks + 1));
        }
#pragma unroll
        for (int mt = 0; mt < 4; ++mt) acc[mt] = __builtin_amdgcn_mfma_f32_32x32x16_bf16(ka[ks & 1][mt], bq[ks], acc[mt], 0, 0, 0);
        __builtin_amdgcn_sched_barrier(0);
        if (ks == 0) { after_first_step(); __builtin_amdgcn_sched_barrier(0); }
    }
    unsigned k1[16];
    unsigned pb; asm volatile("v_xor_b32 %0, 4, %1" : "=v"(pb) : "v"(p4));
#pragma unroll
    for (int r = 0; r < 16; ++r) { const unsigned c = (unsigned)(123 - ((r & 3) + 8 * (r >> 2)));
        k0[r] = mkkey(acc[0][r], pb, 127u) | c; k1[r] = mkkey(acc[1][r], pb, 127u) | (c - 32u); k2[r] = mkkey(acc[2][r], pb, 127u) | (c - 64u); k3[r] = mkkey(acc[3][r], pb, 127u) | (c - 96u); }
    sort16_desc(k0); sort16_desc(k1); top16(k0, k1);
}
DI void half_b(unsigned (&k0)[16], unsigned (&k2)[16], unsigned (&k3)[16], int paddr) {
    sort16_desc(k2); sort16_desc(k3); top16(k2, k3);
    top16(k0, k2);
    xmerge32(k0, paddr);
}
#define P5W_SEG() do { asm volatile("" ::: "memory"); __builtin_amdgcn_sched_barrier(0); } while (0)
DI void unit_rows32(LAS unsigned char* lds, int lane_, int wave, int r0, int h, const bf16_t* qry, const float* ssqx, int* eidt, float* gate,
                    const float* csrc, unsigned char* cdst, size_t citem0, float csc, const float* ccolg) {
    int lane; asm volatile("v_mbcnt_lo_u32_b32 %0, -1, 0\n\tv_mbcnt_hi_u32_b32 %0, -1, %0" : "=v"(lane)); (void)lane_;
    const int qrow = lane & 31, p = lane >> 5, paddr = (lane ^ 32) << 2;
    const bool hi = p != 0;
    const int row = r0 + qrow;
    float rstd;
    { const f32x4* sp = (const f32x4*)(ssqx + (size_t)row * 16); const f32x4 sq0 = sp[0], sq1 = sp[1], sq2 = sp[2], sq3 = sp[3];
      const float ssq = ((sq0[0] + sq0[1]) + (sq0[2] + sq0[3])) + ((sq1[0] + sq1[1]) + (sq1[2] + sq1[3])) + ((sq2[0] + sq2[1]) + (sq2[2] + sq2[3])) + ((sq3[0] + sq3[1]) + (sq3[2] + sq3[3]));
      rstd = 1.0f / sqrtf(ssq * (1.f / DM) + EPS); }
    const bf16_t* qp = qry + (size_t)row * 2048 + h * 256 + 8 * p;
    const LAS unsigned char* kl = lds + qrow * KPITCH + 16 * p;
    unsigned a0[16], a1[16];
    CvtRegs<3> cv3;
    {
        bf16x8 bq[8];
#pragma unroll
        for (int ks = 0; ks < 8; ++ks) bq[ks] = *(const bf16x8*)(qp + 16 * ks);
        unsigned k2[16], k3[16];
        half_a(a0, k2, k3, bq, kl, 4 * p, [&]() { cvt8_load<3>(cv3, csrc, citem0, lane); });
        P5W_SEG();
        cvt8_store<3>(cv3, cdst, citem0, lane, csc, ccolg);
#pragma unroll
        for (int ks = 0; ks < 8; ++ks) bq[ks] = *(const bf16x8*)(qp + 128 + 16 * ks);
        cvt8_load<3>(cv3, csrc, citem0 + 3, lane);
        P5W_SEG();
        half_b(a0, k2, k3, paddr);
        P5W_SEG();
        cvt8_store<3>(cv3, cdst, citem0 + 3, lane, csc, ccolg);
        P5W_SEG();
        half_a(a1, k2, k3, bq, kl + KHALF, 4 * p, [&]() { cvt8_load<3>(cv3, csrc, citem0 + 6, lane); });
        P5W_SEG();
        cvt8_store<3>(cv3, cdst, citem0 + 6, lane, csc, ccolg);
        cvt8_load<3>(cv3, csrc, citem0 + 9, lane);
        P5W_SEG();
        half_b(a1, k2, k3, paddr);
        P5W_SEG();
        cvt8_store<3>(cv3, cdst, citem0 + 9, lane, csc, ccolg);
    }
    CvtRegs<4> cv4; cvt8_load<4>(cv4, csrc, citem0 + 12, lane);
    P5W_SEG();
    LAS unsigned* REC = (LAS unsigned*)(lds + OFF_REC + wave * REC_WAVE) + qrow * 33;
    if (!hi) {
#pragma unroll
        for (int i = 0; i < 16; ++i) REC[i] = a0[i];
    } else {
#pragma unroll
        for (int i = 0; i < 16; ++i) REC[16 + i] = a1[i];
    }
    float f0[16], f1[16];
#pragma unroll
    for (int i = 0; i < 16; ++i) { f0[i] = keyval(a0[i], 127u); f1[i] = keyval(a1[i], 127u); }
    float g1[8]; unsigned cp[8];
#pragma unroll
    for (int k = 0; k < 8; ++k) { g1[k] = hi ? f1[2 * k + 1] : f1[2 * k]; cp[k] = (unsigned)(2 * k) | (unsigned)p; }
    unsigned t[16], u[16];
#pragma unroll
    for (int k = 0; k < 8; ++k) t[k] = mkkey(f0[0] + g1[k], cp[k], 255u);
#pragma unroll
    for (int k = 0; k < 4; ++k) t[8 + k] = mkkey(f0[1] + g1[k], 16u | cp[k], 255u);
    t[12] = mkkey(f0[2] + g1[0], 32u | cp[0], 255u); t[13] = mkkey(f0[2] + g1[1], 32u | cp[1], 255u);
    { const unsigned kx = mkkey(f0[2] + f1[4], 32u | 4u, 255u); t[14] = hi ? 0u : kx; }
    t[15] = mkkey(f0[3] + g1[0], 48u | cp[0], 255u); u[0] = mkkey(f0[3] + g1[1], 48u | cp[1], 255u);
    u[1] = mkkey(f0[4] + g1[0], 64u | cp[0], 255u);
    { const unsigned kx = mkkey(f0[4] + f1[2], 64u | 2u, 255u); u[2] = hi ? 0u : kx; }
    u[3] = mkkey(f0[5] + g1[0], 80u | cp[0], 255u); u[4] = mkkey(f0[6] + g1[0], 96u | cp[0], 255u); u[5] = mkkey(f0[7] + g1[0], 112u | cp[0], 255u);
#pragma unroll
    for (int k = 0; k < 4; ++k) { const float fv = hi ? f0[12 + k] : f0[8 + k]; u[6 + k] = mkkey(fv + f1[0], ((unsigned)(8 + k + 4 * p) << 4), 255u); }
    sort16_desc(t); sort10_desc(u);
#pragma unroll
    for (int k = 10; k < 16; ++k) u[k] = 0u;
    top16(t, u);
    xmerge32(t, paddr);
    P5W_SEG();
    cvt8_store<4>(cv4, cdst, citem0 + 12, lane, csc, ccolg);
    unsigned kk[8];
#pragma unroll
    for (int e = 0; e < 8; ++e) kk[e] = hi ? t[8 + e] : t[e];
    const float vmax = keyval(t[0], 255u);
    float ev[8]; float es = 0.f;
#pragma unroll
    for (int e = 0; e < 8; ++e) { ev[e] = __expf(rstd * (keyval(kk[e], 255u) - vmax)); es += ev[e]; }
    es += __uint_as_float(bperm(paddr, __float_as_uint(es)));
    const float inv = 1.0f / es;
    asm volatile("s_waitcnt lgkmcnt(0)" ::: "memory");
    int* et = eidt + (size_t)row * 128 + 2 * h + p;
#pragma unroll
    for (int e = 0; e < 8; ++e) { const unsigned cd = kk[e] & 255u;
        et[16 * e] = (int)(127u - (REC[cd >> 4] & 127u)) * 128 + (int)(127u - (REC[16 + (cd & 15u)] & 127u)); }
    float* gp = gate + (size_t)row * 128 + h * 16 + 8 * p;
    *(f32x4*)gp = (f32x4){ev[0] * inv, ev[1] * inv, ev[2] * inv, ev[3] * inv};
    *(f32x4*)(gp + 4) = (f32x4){ev[4] * inv, ev[5] * inv, ev[6] * inv, ev[7] * inv};
}
}

namespace p6 {
constexpr float SC_DOWN = 64.0f, SC_UP = 4.0f;
constexpr size_t SLICE = (size_t)NEXP * 128;
DI float gelu_erf(float v) { return 0.5f * v * (1.0f + erff(v * 0.70710678118654752f)); }
DI f32x2_t up8(unsigned w, bool hi) { return hi ? __builtin_amdgcn_cvt_pk_f32_fp8(w, true) : __builtin_amdgcn_cvt_pk_f32_fp8(w, false); }
DI float dot16(const u32x4 v, const f32x2_t (&x)[8]) {
    f32x2_t a = up8(v.x, false) * x[0];
    a = up8(v.x, true) * x[1] + a; a = up8(v.y, false) * x[2] + a; a = up8(v.y, true) * x[3] + a;
    a = up8(v.z, false) * x[4] + a; a = up8(v.z, true) * x[5] + a; a = up8(v.w, false) * x[6] + a; a = up8(v.w, true) * x[7] + a;
    return a.x + a.y;
}
DI void axpy16(f32x2_t (&o)[8], const u32x4 v, float c) {
    o[0] = up8(v.x, false) * c + o[0]; o[1] = up8(v.x, true) * c + o[1]; o[2] = up8(v.y, false) * c + o[2]; o[3] = up8(v.y, true) * c + o[3];
    o[4] = up8(v.z, false) * c + o[4]; o[5] = up8(v.z, true) * c + o[5]; o[6] = up8(v.w, false) * c + o[6]; o[7] = up8(v.w, true) * c + o[7];
}
template <int CTRL> DI float dppf(float v) { return __int_as_float(__builtin_amdgcn_update_dpp(0, __float_as_int(v), CTRL, 0xF, 0xF, false)); }
DI float grp8_sum(float v) { v += dppf<0xB1>(v); v += dppf<0x4E>(v); v += dppf<0x141>(v); return v; }
template <int S> DI int bcast8(int v) { return __builtin_amdgcn_ds_swizzle(v, (S << 5) | 0x18); }
template <int S> DI float bcast8f(float v) { return __int_as_float(__builtin_amdgcn_ds_swizzle(__float_as_int(v), (S << 5) | 0x18)); }
DI float row_rstd(const float* ssqx, int t) {
    const f32x4* sp = (const f32x4*)(ssqx + (size_t)t * 16); const f32x4 s0 = sp[0], s1 = sp[1], s2 = sp[2], s3 = sp[3];
    const float ssq = ((s0[0] + s0[1]) + (s0[2] + s0[3])) + ((s1[0] + s1[1]) + (s1[2] + s1[3])) + ((s2[0] + s2[1]) + (s2[2] + s2[3])) + ((s3[0] + s3[1]) + (s3[2] + s3[3]));
    return 1.0f / sqrtf(ssq * (1.f / DM) + EPS);
}

typedef int v2i_t __attribute__((ext_vector_type(2)));
DI long mk64(unsigned lo, unsigned hi) { return (long)(((unsigned long long)hi << 32) | (unsigned long long)lo); }
typedef int i32x4 __attribute__((ext_vector_type(4)));
struct Ids { i32x4 e0, e1, e2, e3; };
DI Ids ids_lds(const LAS unsigned char* slot, int lane) { Ids d; const LAS i32x4* ep = (const LAS i32x4*)(slot + (lane >> 3) * 64); d.e0 = ep[0]; d.e1 = ep[1]; d.e2 = ep[2]; d.e3 = ep[3]; return d; }
template <int I> DI int id_of(const Ids& d) { return I == 0 ? d.e0.x : I == 1 ? d.e0.y : I == 2 ? d.e0.z : I == 3 ? d.e0.w : I == 4 ? d.e1.x : I == 5 ? d.e1.y : I == 6 ? d.e1.z : I == 7 ? d.e1.w :
                                                   I == 8 ? d.e2.x : I == 9 ? d.e2.y : I == 10 ? d.e2.z : I == 11 ? d.e2.w : I == 12 ? d.e3.x : I == 13 ? d.e3.y : I == 14 ? d.e3.z : d.e3.w; }
template <int I> DI void dma1(LAS unsigned char* img, const unsigned char* slice, const Ids& d, int lane) {
    __builtin_amdgcn_global_load_lds((const unsigned*)(slice + (size_t)id_of<I>(d) * 128 + 16 * ((lane & 7) ^ (lane >> 3))), (LAS unsigned*)(img + I * 1024), 16, 0, 0);
}
DI void dma_all(LAS unsigned char* img, const unsigned char* slice, const Ids& d, int lane) {
    dma1<0>(img, slice, d, lane); dma1<1>(img, slice, d, lane); dma1<2>(img, slice, d, lane); dma1<3>(img, slice, d, lane); dma1<4>(img, slice, d, lane); dma1<5>(img, slice, d, lane); dma1<6>(img, slice, d, lane); dma1<7>(img, slice, d, lane);
    dma1<8>(img, slice, d, lane); dma1<9>(img, slice, d, lane); dma1<10>(img, slice, d, lane); dma1<11>(img, slice, d, lane); dma1<12>(img, slice, d, lane); dma1<13>(img, slice, d, lane); dma1<14>(img, slice, d, lane); dma1<15>(img, slice, d, lane);
}
DI void smalls_dma(LAS unsigned char* slot, const int* eidt, int t, const unsigned char* ahi, const unsigned char* alo, int lane_) {
    int lane; asm volatile("v_mov_b32 %0, %1" : "=v"(lane) : "v"(lane_));
    const unsigned char* src = (lane < 32) ? (const unsigned char*)(eidt + (size_t)t * 128) + 16 * lane : (lane < 40) ? ahi + 16 * (lane - 32) : (lane < 48) ? alo + 16 * (lane - 40) : ahi + 16 * (lane & 7);
    __builtin_amdgcn_global_load_lds((const unsigned*)src, (LAS unsigned*)slot, 16, 0, 0);
}
DI void split8(float v0, float v1, float v2, float v3, unsigned& hi, unsigned& lo) {
    int h = 0; h = __builtin_amdgcn_cvt_pk_fp8_f32(v0, v1, h, false); h = __builtin_amdgcn_cvt_pk_fp8_f32(v2, v3, h, true);
    const f32x2_t b01 = __builtin_amdgcn_cvt_pk_f32_fp8(h, false), b23 = __builtin_amdgcn_cvt_pk_f32_fp8(h, true);
    int l = 0; l = __builtin_amdgcn_cvt_pk_fp8_f32((v0 - b01.x) * 16.0f, (v1 - b01.y) * 16.0f, l, false); l = __builtin_amdgcn_cvt_pk_fp8_f32((v2 - b23.x) * 16.0f, (v3 - b23.y) * 16.0f, l, true);
    hi = (unsigned)h; lo = (unsigned)l;
}
#define P6_WAITV(N) asm volatile("s_waitcnt vmcnt(" #N ")" ::: "memory")
#define P6_WAITL() asm volatile("s_waitcnt lgkmcnt(0)" ::: "memory")
DI void xq_token(int t, int lane, const bf16_t* x1b, unsigned char* xqh, unsigned char* xql) {
    const u32x4* xp = (const u32x4*)(x1b + (size_t)t * DM + 16 * lane); const u32x4 w0 = xp[0], w1 = xp[1];
    unsigned h0, h1, h2, h3, l0, l1, l2, l3;
    split8(bflo(w0.x), bfhi(w0.x), bflo(w0.y), bfhi(w0.y), h0, l0); split8(bflo(w0.z), bfhi(w0.z), bflo(w0.w), bfhi(w0.w), h1, l1);
    split8(bflo(w1.x), bfhi(w1.x), bflo(w1.y), bfhi(w1.y), h2, l2); split8(bflo(w1.z), bfhi(w1.z), bflo(w1.w), bfhi(w1.w), h3, l3);
    const u32x4 h = (u32x4){h0, h1, h2, h3}, l = (u32x4){l0, l1, l2, l3};
    st16_wt(xqh + (size_t)t * DM + 16 * lane, h); st16_wt(xql + (size_t)t * DM + 16 * lane, l);
}
DI void down_run(int j, int lw, int nlw, int lane, LAS unsigned char* img, LAS unsigned char* sm, LAS unsigned char* rs, const int* eidt, const unsigned char* xqh, const unsigned char* xql, const unsigned char* EDs, bf16_t* part) {
    if (lw >= M_TOK) return;
    const int n = lane & 15, kq = lane >> 4, key = n & 7;
    const int cnt = (M_TOK - 1 - lw) / nlw + 1, tl = lw + (cnt - 1) * nlw;
#define P6_TOK(i) ((lw + (i) * nlw <= tl) ? lw + (i) * nlw : tl)
#define P6_SM(t, slot) smalls_dma(slot, eidt, (t), xqh + (size_t)(t) * DM + 128 * j, xql + (size_t)(t) * DM + 128 * j, lane)
    P6_SM(P6_TOK(0), sm); P6_SM(P6_TOK(1), sm + 1024);
    P6_WAITV(0);
    Ids idn = ids_lds(sm, lane);
    P6_WAITL();
    dma_all(img, EDs, idn, lane);
    for (int i = 0; i < cnt; ++i) {
        const int t = lw + i * nlw;
        LAS unsigned char* cur = sm + (i & 1) * 1024; LAS unsigned char* nxs = sm + ((i + 1) & 1) * 1024;
        long a[4];
        { u32x4 a01 = (u32x4){0u, 0u, 0u, 0u}, a23 = (u32x4){0u, 0u, 0u, 0u};
          if (n < 2) { a01 = *(const LAS u32x4*)(cur + 512 + 128 * n + 32 * kq); a23 = *(const LAS u32x4*)(cur + 512 + 128 * n + 32 * kq + 16); }
          P6_WAITL();
          a[0] = mk64(a01.x, a01.y); a[1] = mk64(a01.z, a01.w); a[2] = mk64(a23.x, a23.y); a[3] = mk64(a23.z, a23.w); }
        { const int t2 = P6_TOK(i + 2); P6_SM(t2, cur); }
        float r[8];
#define P6_GRP(GI) { P6_WAITV(14); \
            const LAS unsigned char* row = img + (16 * (GI) + n) * 128; \
            const u32x4 b01 = *(const LAS u32x4*)(row + 16 * ((2 * kq) ^ key)), b23 = *(const LAS u32x4*)(row + 16 * ((2 * kq + 1) ^ key)); \
            if ((GI) == 0) idn = ids_lds(nxs, lane); \
            P6_WAITL(); \
            dma1<2 * (GI)>(img, EDs, idn, lane); dma1<2 * (GI) + 1>(img, EDs, idn, lane);     \
            f32x4 acc = (f32x4){0.f, 0.f, 0.f, 0.f}; \
            acc = __builtin_amdgcn_mfma_f32_16x16x32_fp8_fp8(a[0], mk64(b01.x, b01.y), acc, 0, 0, 0); \
            acc = __builtin_amdgcn_mfma_f32_16x16x32_fp8_fp8(a[1], mk64(b01.z, b01.w), acc, 0, 0, 0); \
            acc = __builtin_amdgcn_mfma_f32_16x16x32_fp8_fp8(a[2], mk64(b23.x, b23.y), acc, 0, 0, 0); \
            acc = __builtin_amdgcn_mfma_f32_16x16x32_fp8_fp8(a[3], mk64(b23.z, b23.w), acc, 0, 0, 0); \
            r[GI] = acc[0] + acc[1] * (1.0f / 16.0f); }
        P6_GRP(0) P6_GRP(1) P6_GRP(2) P6_GRP(3) P6_GRP(4) P6_GRP(5) P6_GRP(6) P6_GRP(7)
#undef P6_GRP
        if (lane < 16) {
#pragma unroll
            for (int gi = 0; gi < 8; ++gi) *(LAS unsigned short*)(rs + 2 * (16 * gi + n)) = (unsigned short)(cvtpk(r[gi], 0.f) & 0xffffu);
        }
        P6_WAITL();
        const unsigned w = *(const LAS unsigned*)(rs + 4 * lane);
        P6_WAITL();
        *(unsigned*)(part + ((size_t)j * M_TOK + t) * 128 + 2 * lane) = w;
    }
    P6_WAITV(0); P6_WAITL();
#undef P6_SM
}
DI void c_token(int t, int lane, const float* ssqx, const float* gate, const bf16_t* part, unsigned char* cq) {
    const float rstd = row_rstd(ssqx, t);
    const float2 G = *(const float2*)(gate + (size_t)t * 128 + 2 * lane);
    float a0 = 0.f, a1 = 0.f;
#pragma unroll
    for (int jj = 0; jj < 8; ++jj) { const unsigned w = *(const unsigned*)(part + ((size_t)jj * M_TOK + t) * 128 + 2 * lane); a0 += bflo(w); a1 += bfhi(w); }
    const float c0 = G.x * gelu_erf(a0 * rstd * (1.0f / SC_DOWN)) * (128.0f / SC_UP), c1 = G.y * gelu_erf(a1 * rstd * (1.0f / SC_DOWN)) * (128.0f / SC_UP);
    unsigned hi, lo; split8(c0, c1, 0.f, 0.f, hi, lo);
    *(unsigned short*)(cq + (size_t)t * 256 + 2 * lane) = (unsigned short)(hi & 0xffffu); *(unsigned short*)(cq + (size_t)t * 256 + 128 + 2 * lane) = (unsigned short)(lo & 0xffffu);
}
DI void up_run(int j, int lw, int nlw, int lane, LAS unsigned char* img, LAS unsigned char* sm, LAS unsigned char* rs, const int* eidt, const unsigned char* cq, const unsigned char* EUs, bf16_t* delta) {
    if (lw >= M_TOK) return;
    const int n = lane & 15, kq = lane >> 4, r = n >> 1, ch = n & 1;
    const int cnt = (M_TOK - 1 - lw) / nlw + 1, tl = lw + (cnt - 1) * nlw;
#define P6_SM(t, slot) smalls_dma(slot, eidt, (t), cq + (size_t)(t) * 256, cq + (size_t)(t) * 256 + 128, lane)
    P6_SM(P6_TOK(0), sm); P6_SM(P6_TOK(1), sm + 1024);
    P6_WAITV(0);
    Ids idn = ids_lds(sm, lane);
    P6_WAITL();
    dma_all(img, EUs, idn, lane);
    for (int i = 0; i < cnt; ++i) {
        const int t = lw + i * nlw;
        LAS unsigned char* cur = sm + (i & 1) * 1024; LAS unsigned char* nxs = sm + ((i + 1) & 1) * 1024;
        long a[4];
        { u32x2 w[4];
#pragma unroll
          for (int sx = 0; sx < 4; ++sx) { w[sx] = (u32x2){0u, 0u}; if (n < 2) w[sx] = *(const LAS u32x2*)(cur + 512 + 128 * n + 32 * sx + 8 * kq); }
          P6_WAITL();
#pragma unroll
          for (int sx = 0; sx < 4; ++sx) a[sx] = mk64(w[sx].x, w[sx].y); }
        { const int t2 = P6_TOK(i + 2); P6_SM(t2, cur); }
        f32x4 acc[8];
#pragma unroll
        for (int cb = 0; cb < 8; ++cb) acc[cb] = (f32x4){0.f, 0.f, 0.f, 0.f};
#define P6_KS(SX) { P6_WAITV(12); \
            v2i_t b[8]; \
            _Pragma("unroll") for (int cb = 0; cb < 8; ++cb) b[cb] = __builtin_amdgcn_ds_read_tr8_b64_v2i32((LAS v2i_t*)(img + (32 * (SX) + 8 * kq + r) * 128 + 16 * (cb ^ r) + 8 * ch)); \
            if ((SX) == 0) idn = ids_lds(nxs, lane); \
            P6_WAITL(); \
            dma1<4 * (SX)>(img, EUs, idn, lane); dma1<4 * (SX) + 1>(img, EUs, idn, lane); dma1<4 * (SX) + 2>(img, EUs, idn, lane); dma1<4 * (SX) + 3>(img, EUs, idn, lane); \
            _Pragma("unroll") for (int cb = 0; cb < 8; ++cb) acc[cb] = __builtin_amdgcn_mfma_f32_16x16x32_fp8_fp8(a[SX], mk64((unsigned)b[cb].x, (unsigned)b[cb].y), acc[cb], 0, 0, 0); }
        P6_KS(0) P6_KS(1) P6_KS(2) P6_KS(3)
#undef P6_KS
        if (lane < 16) {
#pragma unroll
            for (int cb = 0; cb < 8; ++cb) *(LAS unsigned short*)(rs + 2 * (16 * cb + n)) = (unsigned short)(cvtpk((acc[cb][0] + acc[cb][1] * (1.0f / 16.0f)) * (1.0f / 128.0f), 0.f) & 0xffffu);
        }
        P6_WAITL();
        const unsigned w = *(const LAS unsigned*)(rs + 4 * lane);
        P6_WAITL();
        *(unsigned*)(delta + (size_t)t * DM + 128 * j + 2 * lane) = w;
    }
    P6_WAITV(0); P6_WAITL();
#undef P6_SM
#undef P6_TOK
}
DI int opaque_lane() { int l; asm volatile("v_mbcnt_lo_u32_b32 %0, -1, 0\n\tv_mbcnt_hi_u32_b32 %0, -1, %0" : "=v"(l)); return l; }
#define P6I_T(i) (t0 + (((i) < 64 ? (i) : 63) & 7))
#define P6I_S(i) (((i) < 64 ? (i) : 63) >> 3)
DI void own_down(int t0, LAS unsigned char* img, LAS unsigned char* sm, const int* eidt, const unsigned char* xqh, const unsigned char* xql, const unsigned char* ED, float (&pacc)[8][8]) {
    const int lane = opaque_lane();
    const int n = lane & 15, kq = lane >> 4, key = n & 7;
#define P6I_SM(i, slot) smalls_dma(slot, eidt, P6I_T(i), xqh + (size_t)P6I_T(i) * DM + 128 * P6I_S(i), xql + (size_t)P6I_T(i) * DM + 128 * P6I_S(i), lane)
    P6I_SM(0, sm); P6I_SM(1, sm + 1024);
    P6_WAITV(0);
    Ids idn = ids_lds(sm, lane);
    P6_WAITL();
    dma_all(img, ED, idn, lane);
    for (int s = 0; s < 8; ++s) {
#define P6I_GRP(GI, TOK) { P6_WAITV(14); \
            const LAS unsigned char* row = img + (16 * (GI) + n) * 128; \
            const u32x4 b01 = *(const LAS u32x4*)(row + 16 * ((2 * kq) ^ key)), b23 = *(const LAS u32x4*)(row + 16 * ((2 * kq + 1) ^ key)); \
            if ((GI) == 0) idn = ids_lds(nxs, lane); \
            P6_WAITL(); \
            dma1<2 * (GI)>(img, nsl, idn, lane); dma1<2 * (GI) + 1>(img, nsl, idn, lane); \
            f32x4 acc = (f32x4){0.f, 0.f, 0.f, 0.f}; \
            acc = __builtin_amdgcn_mfma_f32_16x16x32_fp8_fp8(a[0], mk64(b01.x, b01.y), acc, 0, 0, 0); \
            acc = __builtin_amdgcn_mfma_f32_16x16x32_fp8_fp8(a[1], mk64(b01.z, b01.w), acc, 0, 0, 0); \
            acc = __builtin_amdgcn_mfma_f32_16x16x32_fp8_fp8(a[2], mk64(b23.x, b23.y), acc, 0, 0, 0); \
            acc = __builtin_amdgcn_mfma_f32_16x16x32_fp8_fp8(a[3], mk64(b23.z, b23.w), acc, 0, 0, 0); \
            pacc[TOK][GI] += acc[0] + acc[1] * (1.0f / 16.0f); }
#define P6I_ITEM(TOK) { const int i = 8 * s + (TOK); \
            LAS unsigned char* cur = sm + ((TOK) & 1) * 1024; LAS unsigned char* nxs = sm + (((TOK) + 1) & 1) * 1024; \
            long a[4]; \
            { u32x4 a01 = (u32x4){0u, 0u, 0u, 0u}, a23 = (u32x4){0u, 0u, 0u, 0u}; \
              if (n < 2) { a01 = *(const LAS u32x4*)(cur + 512 + 128 * n + 32 * kq); a23 = *(const LAS u32x4*)(cur + 512 + 128 * n + 32 * kq + 16); } \
              P6_WAITL(); \
              a[0] = mk64(a01.x, a01.y); a[1] = mk64(a01.z, a01.w); a[2] = mk64(a23.x, a23.y); a[3] = mk64(a23.z, a23.w); } \
            P6I_SM(i + 2, cur); \
            const unsigned char* nsl = ED + (size_t)P6I_S(i + 1) * SLICE;                   \
            P6I_GRP(0, TOK) P6I_GRP(1, TOK) P6I_GRP(2, TOK) P6I_GRP(3, TOK) P6I_GRP(4, TOK) P6I_GRP(5, TOK) P6I_GRP(6, TOK) P6I_GRP(7, TOK) }
        P6I_ITEM(0) P6I_ITEM(1) P6I_ITEM(2) P6I_ITEM(3) P6I_ITEM(4) P6I_ITEM(5) P6I_ITEM(6) P6I_ITEM(7)
#undef P6I_ITEM
#undef P6I_GRP
    }
    P6_WAITV(0); P6_WAITL();
#undef P6I_SM
}
DI void own_c(int t0, LAS unsigned char* img, const float (&pacc)[8][8], const float* ssqx, const float* gate, unsigned char* cq) {
    const int lane = opaque_lane();
    LAS float* pf = (LAS float*)img;
    if (lane < 16) {
#pragma unroll
        for (int tok = 0; tok < 8; ++tok)
#pragma unroll
            for (int gi = 0; gi < 8; ++gi) pf[tok * 128 + 16 * gi + lane] = pacc[tok][gi];
    }
    const float rl = row_rstd(ssqx, t0 + (lane & 7));
    float2 G[8];
#pragma unroll
    for (int tok = 0; tok < 8; ++tok) G[tok] = *(const float2*)(gate + (size_t)(t0 + tok) * 128 + 2 * lane);
    P6_WAITL();
#pragma unroll
    for (int tok = 0; tok < 8; ++tok) {
        const float rstd = __int_as_float(__builtin_amdgcn_readlane(__float_as_int(rl), tok));
        const f32x2_t d = *(const LAS f32x2_t*)(pf + tok * 128 + 2 * lane);
        const float c0 = G[tok].x * gelu_erf(d.x * rstd * (1.0f / SC_DOWN)) * (128.0f / SC_UP), c1 = G[tok].y * gelu_erf(d.y * rstd * (1.0f / SC_DOWN)) * (128.0f / SC_UP);
        unsigned hi, lo; split8(c0, c1, 0.f, 0.f, hi, lo);
        *(unsigned short*)(cq + (size_t)(t0 + tok) * 256 + 2 * lane) = (unsigned short)(hi & 0xffffu); *(unsigned short*)(cq + (size_t)(t0 + tok) * 256 + 128 + 2 * lane) = (unsigned short)(lo & 0xffffu);
    }
    asm volatile("s_waitcnt vmcnt(0) lgkmcnt(0)" ::: "memory");
}
DI void own_c2(int t0, LAS unsigned char* img, const float (&pacc)[8][8], const float* ssqx, const float* gate, unsigned char* cq, const int* eidt, const unsigned char* EU) {
    const int lane = opaque_lane();
    LAS float* pf = (LAS float*)img;
    if (lane < 16) {
#pragma unroll
        for (int tok = 0; tok < 8; ++tok)
#pragma unroll
            for (int gi = 0; gi < 8; ++gi) pf[tok * 128 + 16 * gi + lane] = pacc[tok][gi];
    }
    Ids idn; { const i32x4* ep = (const i32x4*)(eidt + (size_t)t0 * 128 + (lane >> 3) * 16); idn.e0 = ep[0]; idn.e1 = ep[1]; idn.e2 = ep[2]; idn.e3 = ep[3]; }
    const float rl = row_rstd(ssqx, t0 + (lane & 7));
    float2 G[8];
#pragma unroll
    for (int tok = 0; tok < 8; ++tok) G[tok] = *(const float2*)(gate + (size_t)(t0 + tok) * 128 + 2 * lane);
    P6_WAITL();
    f32x2_t d[8];
#pragma unroll
    for (int tok = 0; tok < 8; ++tok) d[tok] = *(const LAS f32x2_t*)(pf + tok * 128 + 2 * lane);
    P6_WAITL();
    dma_all(img, EU, idn, lane);
#pragma unroll
    for (int tok = 0; tok < 8; ++tok) {
        const float rstd = __int_as_float(__builtin_amdgcn_readlane(__float_as_int(rl), tok));
        const float c0 = G[tok].x * gelu_erf(d[tok].x * rstd * (1.0f / SC_DOWN)) * (128.0f / SC_UP), c1 = G[tok].y * gelu_erf(d[tok].y * rstd * (1.0f / SC_DOWN)) * (128.0f / SC_UP);
        unsigned hi, lo; split8(c0, c1, 0.f, 0.f, hi, lo);
        *(unsigned short*)(cq + (size_t)(t0 + tok) * 256 + 2 * lane) = (unsigned short)(hi & 0xffffu); *(unsigned short*)(cq + (size_t)(t0 + tok) * 256 + 128 + 2 * lane) = (unsigned short)(lo & 0xffffu);
    }
    asm volatile("s_waitcnt vmcnt(0) lgkmcnt(0)" ::: "memory");
}
template <bool PREFILLED> DI void own_up(int t0, LAS unsigned char* img, LAS unsigned char* sm, LAS unsigned char* rs, const int* eidt, const unsigned char* cq, const unsigned char* EU, bf16_t* delta) {
    const int lane = opaque_lane();
    const int n = lane & 15, kq = lane >> 4, r = n >> 1, ch = n & 1;
#define P6I_SM(i, slot) smalls_dma(slot, eidt, P6I_T(i), cq + (size_t)P6I_T(i) * 256, cq + (size_t)P6I_T(i) * 256 + 128, lane)
    P6I_SM(0, sm); P6I_SM(1, sm + 1024);
    P6_WAITV(0);
    Ids idn = ids_lds(sm, lane);
    P6_WAITL();
    if (!PREFILLED) dma_all(img, EU, idn, lane);
    for (int i = 0; i < 64; ++i) {
        const int t = t0 + (i & 7), sl = i >> 3;
        LAS unsigned char* cur = sm + (i & 1) * 1024; LAS unsigned char* nxs = sm + ((i + 1) & 1) * 1024;
        long a[4];
        { u32x2 w[4];
#pragma unroll
          for (int sx = 0; sx < 4; ++sx) { w[sx] = (u32x2){0u, 0u}; if (n < 2) w[sx] = *(const LAS u32x2*)(cur + 512 + 128 * n + 32 * sx + 8 * kq); }
          P6_WAITL();
#pragma unroll
          for (int sx = 0; sx < 4; ++sx) a[sx] = mk64(w[sx].x, w[sx].y); }
        P6I_SM(i + 2, cur);
        const unsigned char* nsl = EU + (size_t)P6I_S(i + 1) * SLICE;
        f32x4 acc[8];
#pragma unroll
        for (int cb = 0; cb < 8; ++cb) acc[cb] = (f32x4){0.f, 0.f, 0.f, 0.f};
#define P6I_KS(SX) { P6_WAITV(12); \
            v2i_t b[8]; \
            _Pragma("unroll") for (int cb = 0; cb < 8; ++cb) b[cb] = __builtin_amdgcn_ds_read_tr8_b64_v2i32((LAS v2i_t*)(img + (32 * (SX) + 8 * kq + r) * 128 + 16 * (cb ^ r) + 8 * ch)); \
            if ((SX) == 0) idn = ids_lds(nxs, lane); \
            P6_WAITL(); \
            dma1<4 * (SX)>(img, nsl, idn, lane); dma1<4 * (SX) + 1>(img, nsl, idn, lane); dma1<4 * (SX) + 2>(img, nsl, idn, lane); dma1<4 * (SX) + 3>(img, nsl, idn, lane); \
            _Pragma("unroll") for (int cb = 0; cb < 8; ++cb) acc[cb] = __builtin_amdgcn_mfma_f32_16x16x32_fp8_fp8(a[SX], mk64((unsigned)b[cb].x, (unsigned)b[cb].y), acc[cb], 0, 0, 0); }
        P6I_KS(0) P6I_KS(1) P6I_KS(2) P6I_KS(3)
#undef P6I_KS
        if (lane < 16) {
#pragma unroll
            for (int cb = 0; cb < 8; ++cb) *(LAS unsigned short*)(rs + 2 * (16 * cb + n)) = (unsigned short)(cvtpk((acc[cb][0] + acc[cb][1] * (1.0f / 16.0f)) * (1.0f / 128.0f), 0.f) & 0xffffu);
        }
        P6_WAITL();
        const unsigned w = *(const LAS unsigned*)(rs + 4 * lane);
        P6_WAITL();
        *(unsigned*)(delta + (size_t)t * DM + 128 * sl + 2 * lane) = w;
    }
    P6_WAITV(0); P6_WAITL();
#undef P6I_SM
}
#undef P6I_T
#undef P6I_S
DI void final_token(int t, int lane, float* outp, const bf16_t* x1b, const bf16_t* delta, const float* g_fin) {
    f32x4* orow = (f32x4*)(outp + (size_t)t * DM) + lane; const u32x2* xr = (const u32x2*)(x1b + (size_t)t * DM) + lane; const u32x2* dr = (const u32x2*)(delta + (size_t)t * DM) + lane; const f32x4* gr = (const f32x4*)g_fin + lane;
    f32x4 v[4]; float ss = 0.f;
#pragma unroll
    for (int i = 0; i < 4; ++i) { const u32x2 d = dr[64 * i], x = xr[64 * i]; v[i][0] = bflo(x.x) + bflo(d.x); v[i][1] = bfhi(x.x) + bfhi(d.x); v[i][2] = bflo(x.y) + bflo(d.y); v[i][3] = bfhi(x.y) + bfhi(d.y);
        ss += (v[i][0] * v[i][0] + v[i][1] * v[i][1]) + (v[i][2] * v[i][2] + v[i][3] * v[i][3]); }
    const float r2 = 1.0f / sqrtf(wave_sum(ss) * (1.f / DM) + EPS);
#pragma unroll
    for (int i = 0; i < 4; ++i) orow[64 * i] = v[i] * r2 * gr[64 * i];
}
template <int U> DI void final_tokens(int tb, int lane, float* outp, const bf16_t* x1b, const bf16_t* delta, const float* g_fin) {
    u32x2 xr[U][4], dr[U][4];
#pragma unroll
    for (int u = 0; u < U; ++u) { const u32x2* xp = (const u32x2*)(x1b + (size_t)(tb + u) * DM) + lane; const u32x2* dp = (const u32x2*)(delta + (size_t)(tb + u) * DM) + lane;
#pragma unroll
        for (int i = 0; i < 4; ++i) { xr[u][i] = xp[64 * i]; dr[u][i] = dp[64 * i]; } }
    f32x4 g[4];
#pragma unroll
    for (int i = 0; i < 4; ++i) g[i] = *((const f32x4*)g_fin + lane + 64 * i);
#pragma unroll
    for (int u = 0; u < U; ++u) { f32x4 v[4]; float ss = 0.f;
#pragma unroll
        for (int i = 0; i < 4; ++i) { const u32x2 d = dr[u][i], x = xr[u][i]; v[i][0] = bflo(x.x) + bflo(d.x); v[i][1] = bfhi(x.x) + bfhi(d.x); v[i][2] = bflo(x.y) + bflo(d.y); v[i][3] = bfhi(x.y) + bfhi(d.y);
            ss += (v[i][0] * v[i][0] + v[i][1] * v[i][1]) + (v[i][2] * v[i][2] + v[i][3] * v[i][3]); }
        const float r2 = 1.0f / sqrtf(wave_sum(ss) * (1.f / DM) + EPS);
        f32x4* orow = (f32x4*)(outp + (size_t)(tb + u) * DM) + lane;
#pragma unroll
        for (int i = 0; i < 4; ++i) __builtin_nontemporal_store(v[i] * r2 * g[i], orow + 64 * i); }
}
}

constexpr int N_LAUNCHES = MK_N_LAUNCHES;
constexpr int N_PHASES = 7;

__global__ void __launch_bounds__(NWAVES * 64, 2) hymba_fwd(Args args) {
    extern __shared__ __attribute__((aligned(16))) unsigned char lds_raw[];
    Frame F;
    F.lds = (LAS unsigned char*)lds_raw;
    volatile LAS unsigned* MISC = (volatile LAS unsigned*)(F.lds + MISC_OFF);
    F.tid = threadIdx.x; F.lane = F.tid & 63; F.wave = __builtin_amdgcn_readfirstlane(F.tid >> 6);
    F.G = gridDim.x; { const int bx = blockIdx.x; F.vcu = (F.G % 8 == 0) ? (bx % 8) * (F.G / 8) + bx / 8 : bx; }
    unsigned char* ws = args.ws;
    unsigned* ctl = (unsigned*)(ws + WS_CTL);
    const float* x = args.in[0]; const float* g_mix = args.in[1]; const float* w_in = args.in[2]; const float* conv_w = args.in[3];
    const float* g_conv = args.in[4]; const float* g_attn = args.in[5]; const float* w_out = args.in[6]; const float* g_ffn = args.in[7];
    const float* w_q = args.in[8]; const float* sk1 = args.in[9]; const float* sk2 = args.in[10]; const float* e_down = args.in[11]; const float* e_up = args.in[12];
    const float* g_fin = args.in[13];
    float* out = args.out;
    bf16_t* WinT = (bf16_t*)(ws + WS_WIN); bf16_t* WoutT = (bf16_t*)(ws + WS_WOUT); bf16_t* WqT = (bf16_t*)(ws + WS_WQ);
    bf16_t* K1b = (bf16_t*)(ws + WS_K1); bf16_t* K2b = (bf16_t*)(ws + WS_K2);
    bf16_t* XN = (bf16_t*)(ws + WS_XN); bf16_t* PROJ = (bf16_t*)(ws + WS_PROJ); bf16_t* QRY = (bf16_t*)(ws + WS_QRY); bf16_t* Yb = (bf16_t*)(ws + WS_Y);
    unsigned char* ED8 = ws + WS_ED; unsigned char* EU8 = ws + WS_EU;
    float* KSUM = (float*)(ws + WS_KSUM); float* SSQA = (float*)(ws + WS_SSQA); float* SSQX = (float*)(ws + WS_SSQX);
    float* RMS0 = (float*)(ws + WS_RMS0); bf16_t* IDM = (bf16_t*)(ws + WS_IDM);
    int* EIDX = (int*)(ws + WS_EIDX); float* GATE = (float*)(ws + WS_GATE);

    if (F.tid < 64) MISC[F.tid] = 0u;
    __syncthreads();
    XcdBarrier bar; bar.bar = ctl + CW_BAR; bar.x = 0; bar.st = nullptr;
    if (N_LAUNCHES == 1) bar = xcd_barrier_post(ctl + CW_BAR, MISC + 8);
#define GRID_BAR() do { if (N_LAUNCHES == 1) xcd_barrier(bar); } while (0)
    const int lo = args.ph_lo, hi = args.ph_hi;
#define IN(k) (lo <= (k) && (k) < hi)
#define BOTH(k) (IN(k) && IN((k) + 1))
    const int gw = F.vcu * NWAVES + F.wave, NGW = F.G * NWAVES;

    if (IN(0)) for (int rep = 0; rep < NREP(0); ++rep) {
        LAS float* scr = (LAS float*)(F.lds + F.wave * 16384);
        constexpr int I_IN = (DM / 64) * (DPROJ / 32), I_OUT = (DM / 64) * (DM / 32), I_Q = (DM / 64) * (2048 / 32);
        constexpr int I_SK = 131072 / 512, I_EX = (NEXP * DM) / 512;
        for (int r0 = gw * 4; r0 < M_TOK; r0 += NGW * 4) p0_xn_rows<4>(x, g_mix, XN, RMS0, r0, F.lane);
        for (int n = gw; n < 256; n += NGW) {
            u32x4 z0 = (u32x4){0u, 0u, 0u, 0u}, z1 = z0; const int kk = n - 16 * F.lane;
            if (kk >= 0 && kk < 16) { const unsigned one = (kk & 1) ? 0x3F800000u : 0x00003F80u; const int wi = kk >> 1;
                if (wi < 4) { if (wi == 0) z0.x = one; else if (wi == 1) z0.y = one; else if (wi == 2) z0.z = one; else z0.w = one; }
                else { if (wi == 4) z1.x = one; else if (wi == 5) z1.y = one; else if (wi == 6) z1.z = one; else z1.w = one; } }
            st16_wt(IDM + (size_t)n * DM + 16 * F.lane, z0); st16_wt(IDM + (size_t)n * DM + 16 * F.lane + 8, z1);
        }
        constexpr int NITEMS = I_IN + I_OUT + I_Q + 2 * I_SK;
        const int p0_items = (NGW == NITEMS - I_IN) ? I_IN : NITEMS;
        for (int it = gw; it < p0_items; it += NGW) {
            int r = it;
            if (r < I_IN) { p0_transpose_item(w_in, DM, DPROJ, WinT, g_mix, g_mix, DM, scr, r, F.lane); continue; } r -= I_IN;
            if (r < I_OUT) { p0_transpose_item(w_out, DM, DM, WoutT, g_conv, g_attn, 512, scr, r, F.lane); continue; } r -= I_OUT;
            if (r < I_Q) { p0_transpose_item(w_q, DM, 2048, WqT, g_ffn, g_ffn, DM, scr, r, F.lane); continue; } r -= I_Q;
            if (r < I_SK) { p0_cvt_item(sk1, K1b, (size_t)r, F.lane); continue; } r -= I_SK;
            p0_cvt_item(sk2, K2b, (size_t)r, F.lane);
        }
        if (BOTH(0)) GRID_BAR();
    }
    if (IN(1)) for (int rep = 0; rep < NREP(1); ++rep) {
        pg8::Gemm g{XN, WinT, M_TOK, DPROJ, DM, DM, DM}; pg8::StaticOrder S; S.init(M_TOK, DPROJ, F.G, (int)blockIdx.x);
        pg8::EpiProj E{PROJ, KSUM};
        pg8::gemm_phase<pg8::EpiProj, pg8::StaticOrder, true>(F.lds, g, S, E);
        if (BOTH(1)) GRID_BAR();
    }
    if (IN(2)) for (int rep = 0; rep < NREP(2); ++rep) {
        bool conv_done = false;
        for (int v = F.vcu; v < 256; v += F.G) {
            const int bh = v >> 2, s = v & 3;
            att2::attn_unit<8>(bh >> 3, bh & 7, s, (const att2::bf16*)(PROJ + QOFF), (const att2::bf16*)(PROJ + KOFF), (const att2::bf16*)(PROJ + VOFF), (att2::bf16*)(Yb + 512), KSUM, SSQA, (char*)lds_raw);
            if (!conv_done) { conv_done = true;
                if (NGW * 8 == M_TOK) att::conv_rows8(PROJ, conv_w, Yb, gw * 8, F.lane);
                else for (int r0 = gw * 4; r0 < M_TOK; r0 += NGW * 4) att::conv_rows4(PROJ, conv_w, Yb, r0, F.lane); }
            att2::attn_unit<8>(bh >> 3, bh & 7, 7 - s, (const att2::bf16*)(PROJ + QOFF), (const att2::bf16*)(PROJ + KOFF), (const att2::bf16*)(PROJ + VOFF), (att2::bf16*)(Yb + 512), KSUM, SSQA, (char*)lds_raw);
        }
        if (!conv_done) for (int r0 = gw * 4; r0 < M_TOK; r0 += NGW * 4) att::conv_rows4(PROJ, conv_w, Yb, r0, F.lane);
        __syncthreads();
        { constexpr int J_OUT = (DM / 64) * (DM / 32), J_Q = (DM / 64) * (2048 / 32), J_SK = 131072 / 512;
          if (NGW == J_OUT + J_Q + 2 * J_SK) {
              LAS float* scr2 = (LAS float*)(F.lds + F.wave * 16384); const int r = gw;
              if (r < J_OUT) p0_transpose_item(w_out, DM, DM, WoutT, g_conv, g_attn, 512, scr2, r, F.lane);
              else if (r < J_OUT + J_Q) p0_transpose_item(w_q, DM, 2048, WqT, g_ffn, g_ffn, DM, scr2, r - J_OUT, F.lane);
              else { const int q = r - J_OUT - J_Q; if (q < J_SK) p0_cvt_item(sk1, K1b, (size_t)q, F.lane); else p0_cvt_item(sk2, K2b, (size_t)(q - J_SK), F.lane); }
              __syncthreads(); } }
        if (BOTH(2)) GRID_BAR();
    }
    if (IN(3)) for (int rep = 0; rep < NREP(3); ++rep) {
        pg8::StaticOrder S; S.init(M_TOK, DM, F.G, (int)blockIdx.x);
        pg8::Unit u0;
        if (S.next(0, u0)) {
            if (F.tid < 256) { const f32x4* sp = (const f32x4*)(SSQA + (size_t)(u0.pm * 256 + F.tid) * 8); const f32x4 a = sp[0], b = sp[1];
                const float ms = (((a[0] + a[1]) + (a[2] + a[3])) + ((b[0] + b[1]) + (b[2] + b[3]))) * (1.f / 512.f) + EPS; const float rms = sqrtf(ms);
                LAS float* tab = (LAS float*)(F.lds + TAB_OFF); tab[F.tid] = rms; tab[256 + F.tid] = 1.0f / rms; tab[1536 + F.tid] = RMS0[u0.pm * 256 + F.tid]; }
            else ((LAS f32x4*)(F.lds + TAB_OFF + 2048))[F.tid - 256] = ((const f32x4*)g_ffn)[F.tid - 256];
        }
        __syncthreads();
        pg8::Gemm g{Yb, WoutT, M_TOK, DM, DM, DM, DM, XN, IDM, 4};
        pg8::EpiX1 E{x, out, XN, SSQX, TAB_OFF, ws + WS_XQH, ws + WS_XQL};
        pg8::gemm_phase<pg8::EpiX1, pg8::StaticOrder, false>(F.lds, g, S, E);
        if (BOTH(3)) { if (N_LAUNCHES == 1) xcd_barrier<false>(bar); }
    }
    if (IN(4)) for (int rep = 0; rep < NREP(4); ++rep) {
        pg8::Gemm g{XN, WqT, M_TOK, 2048, DM, DM, DM}; pg8::HeadOrder S; S.init(M_TOK, 2048, F.G, (int)blockIdx.x);
        pg8::EpiBf16 E{QRY, 2048};
        pg8::gemm_phase<pg8::EpiBf16, pg8::HeadOrder, true>(F.lds, g, S, E);
        asm volatile("s_waitcnt vmcnt(0)" ::: "memory");
        __syncthreads();
    }
    if (IN(5)) for (int rep = 0; rep < NREP(5); ++rep) {
        if (!IN(4)) { }
        pg8::HeadOrder S; S.init(M_TOK, 2048, F.G, (int)blockIdx.x);
        pg8::Unit u5; int cur_h = -1;
        for (int ui = 0; S.next(ui, u5); ++ui) {
            const int h = u5.pn; const int L = ui * F.G + (int)blockIdx.x;
            if (h != cur_h) {
                __syncthreads();
                p5w::keys_to_lds(F.lds, K1b, K2b, h, F.tid);
                __syncthreads();
                cur_h = h;
                if (F.wave >= 4) __builtin_amdgcn_s_sleep(24);
            }
            const int it0 = (L * NWAVES + F.wave) * 16; const bool dn = it0 < (NEXP * DM) / 512;
            p5w::unit_rows32(F.lds, F.lane, F.wave, u5.pm * 256 + 32 * F.wave, h, QRY, SSQX, EIDX, GATE, dn ? e_down : e_up, dn ? ED8 : EU8, (size_t)(dn ? it0 : it0 - (NEXP * DM) / 512), dn ? p6::SC_DOWN : p6::SC_UP, nullptr);
        }
        __syncthreads();
        if (BOTH(5)) GRID_BAR();
    }
    if (IN(6)) {
        bf16_t* DELTA = (bf16_t*)(ws + WS_DELTA); unsigned char* CQ = ws + WS_CQ; const bf16_t* X1S = XN;
        LAS unsigned char* img = F.lds + F.wave * 16384; LAS unsigned char* sm = F.lds + 131072 + F.wave * 2048; LAS unsigned char* rs = F.lds + 147456 + F.wave * 256;
        for (int g = gw; g < M_TOK / 8; g += NGW) {
            const int t0 = 8 * g;
            float pacc[8][8];
#pragma unroll
            for (int a = 0; a < 8; ++a)
#pragma unroll
                for (int b = 0; b < 8; ++b) pacc[a][b] = 0.f;
            p6::own_down(t0, img, sm, EIDX, ws + WS_XQH, ws + WS_XQL, ED8, pacc);
            p6::own_c2(t0, img, pacc, SSQX, GATE, CQ, EIDX, EU8);
            p6::own_up<true>(t0, img, sm, rs, EIDX, CQ, EU8, DELTA);
            asm volatile("s_waitcnt vmcnt(0)" ::: "memory");
            p6::final_tokens<4>(t0, p6::opaque_lane(), out, X1S, DELTA, g_fin);
            p6::final_tokens<4>(t0 + 4, p6::opaque_lane(), out, X1S, DELTA, g_fin);
        }
    }
#undef IN
#undef BOTH
#undef GRID_BAR
}

extern "C" void kernel_launch(void* const* d_in, const int* in_sizes, int n_in, void* d_out, int out_size, void* d_ws, size_t ws_size, hipStream_t stream) {
    static int grid = 0;
    if (grid == 0) {
        if (n_in != 14 || in_sizes[0] != M_TOK * DM || out_size != M_TOK * DM || ws_size < WS_END) { fprintf(stderr, "kernel_launch: unexpected problem shape (n_in %d, in0 %d, out %d, ws %zu)\n", n_in, n_in > 0 ? in_sizes[0] : -1, out_size, ws_size); grid = -1; return; }
        int dev = 0, cus = 0;
        if (hipGetDevice(&dev) != hipSuccess || hipDeviceGetAttribute(&cus, hipDeviceAttributeMultiprocessorCount, dev) != hipSuccess) { grid = -1; return; }
        if (hipFuncSetAttribute((const void*)hymba_fwd, hipFuncAttributeMaxDynamicSharedMemorySize, LDS_BYTES) != hipSuccess) { fprintf(stderr, "kernel_launch: hipFuncSetAttribute failed\n"); grid = -1; return; }
        (void)hipGetLastError();
        grid = cus;
        if (grid != 256) fprintf(stderr, "kernel_launch: %d CUs (built for 256)\n", grid);
    }
    if (grid < 0) return;
    if (hipMemsetAsync((char*)d_ws + WS_CTL, 0, CTL_ZERO_BYTES, stream) != hipSuccess) return;
    Args a{};
    for (int i = 0; i < 14; ++i) a.in[i] = (const float*)d_in[i];
    a.out = (float*)d_out; a.ws = (unsigned char*)d_ws;
    if (N_LAUNCHES == 1) {
        a.ph_lo = 0; a.ph_hi = N_PHASES; a.li = 0;
        hipLaunchKernelGGL(hymba_fwd, dim3(grid), dim3(NWAVES * 64), LDS_BYTES, stream, a);
    } else {
        for (int li = 0; li < N_PHASES; ++li) { a.ph_lo = li; a.ph_hi = li + 1; a.li = li; hipLaunchKernelGGL(hymba_fwd, dim3(grid), dim3(NWAVES * 64), LDS_BYTES, stream, a); }
    }
}
```

```cpp
#include <hip/hip_runtime.h>
#include <hip/hip_bf16.h>
#include <cstdio>
#include <cstdint>
#include <cmath>

#ifndef MK_N_LAUNCHES
#define MK_N_LAUNCHES 1
#endif

#ifndef PROBE_REP
#define PROBE_REP 0
#endif
#define NREP(k) (((PROBE_REP >> (k)) & 1) + 1)
#define DI __device__ __forceinline__
#define LAS __attribute__((address_space(3)))
#define GAS __attribute__((address_space(1)))

typedef unsigned short bf16_t;
typedef short bf16x8 __attribute__((ext_vector_type(8)));
typedef float f32x4 __attribute__((ext_vector_type(4)));
typedef float f32x16 __attribute__((ext_vector_type(16)));
typedef unsigned u32x4 __attribute__((ext_vector_type(4)));
typedef unsigned u32x2 __attribute__((ext_vector_type(2)));
typedef float f32x2_t __attribute__((ext_vector_type(2)));
typedef __bf16 bf16x2_t __attribute__((ext_vector_type(2)));

constexpr int M_TOK = 16384, DM = 1024, DPROJ = 3072, SEQ = 2048, NBATCH = 8, NH = 8, HD = 64;
constexpr int KOFF = 2048, VOFF = 2560, QOFF = 1536;
constexpr int NEXP = 16384, PEER_H = 8, PEER_TOPK = 16;
constexpr float EPS = 1e-6f;
constexpr float C2 = 0.125f * 1.4426950408889634f;

DI unsigned cvtpk(float lo, float hi) { f32x2_t v = {lo, hi}; bf16x2_t b = __builtin_convertvector(v, bf16x2_t); return __builtin_bit_cast(unsigned, b); }
DI float bflo(unsigned w) { return __uint_as_float(w << 16); }
DI float bfhi(unsigned w) { return __uint_as_float(w & 0xffff0000u); }
DI void st16_wt(void* p, u32x4 v) { asm volatile("global_store_dwordx4 %0, %1, off sc1\n\ts_nop 1" :: "v"(p), "v"(v) : "memory"); }
DI void st4_wt(void* p, unsigned v) { asm volatile("global_store_dword %0, %1, off sc1" :: "v"(p), "v"(v) : "memory"); }
DI void st8_wt(void* p, u32x2 v) { asm volatile("global_store_dwordx2 %0, %1, off sc1" :: "v"(p), "v"(v) : "memory"); }
DI float wave_sum(float v) {
#pragma unroll
    for (int o = 1; o < 64; o <<= 1) v += __shfl_xor(v, o);
    return v;
}

namespace pg8 {
constexpr int BM = 256, BK = 64, HALF = 128, HTB = HALF * BK * 2, STAGE_BYTES = 8 * HTB, NXCD = 8, WGM = 8;
__host__ __device__ __forceinline__ int lds_byte(int r, int c) { const int st = (r >> 4) * 2 + (c >> 5), rr = r & 15, cc = c & 31, ob = rr * 64 + cc * 2; return st * 1024 + (ob ^ (((ob >> 9) & 1) << 5)); }
__host__ __device__ __forceinline__ void stage_rc(int b, int& R, int& C) { const int st = b / 1024, sb = b % 1024, swz = sb ^ (((sb >> 9) & 1) << 5); R = (st >> 1) * 16 + swz / 64; C = (st & 1) * 32 + (swz % 64) / 2; }
__host__ __device__ __forceinline__ int perm32(int rho) { const int n = rho >> 4, i = rho & 15; return 8 * (i >> 2) + 4 * n + (i & 3); }

struct Unit { int pm, pn; };
struct Gemm { const bf16_t* A; const bf16_t* Bt; int M, N, K, lda, ldb; const bf16_t* XA = nullptr; const bf16_t* XBt = nullptr; int nx = 0; };

struct StaticOrder {
    int nM, nN, nwg, G, c;
    __host__ __device__ void init(int M, int N, int G_, int c_) { nM = M / BM; nN = N / BM; nwg = nM * nN; G = G_; c = c_; }
    __host__ __device__ bool next(int i, Unit& u) const {
        const long L = (long)i * G + c; if (L >= nwg) return false;
        int wgid = (int)L; { const int q = nwg / NXCD, r = nwg % NXCD, xcd = wgid % NXCD, off = wgid / NXCD; wgid = (xcd < r ? xcd * (q + 1) : r * (q + 1) + (xcd - r) * q) + off; }
        const int nig = WGM * nN, gid = wgid / nig, fm = gid * WGM, gsz = (nM - fm) < WGM ? (nM - fm) : WGM;
        u.pm = fm + ((wgid % nig) % gsz); u.pn = (wgid % nig) / gsz; return true;
    }
};

struct HeadOrder {
    StaticOrder S; bool head;
    __host__ __device__ void init(int M, int N, int G_, int c_) { S.init(M, N, G_, c_); head = (G_ == 256 && S.nM == 64 && S.nN == 8); }
    __host__ __device__ bool next(int i, Unit& u) const {
        if (!head) return S.next(i, u);
        if (i >= 2) return false;
        const int xcd = S.c % NXCD, off = S.c / NXCD;
        u.pm = 8 * xcd + 4 * i + (off & 3); u.pn = off >> 2; return true;
    }
};

struct EpiBf16 {
    static constexpr bool PERM = true, MID = false;
    bf16_t* O; int ldc;
    DI void mid(f32x4 (&)[2][2][4][2], const Unit&, int, int, LAS unsigned char*, int) const {}
    DI void operator()(const f32x4 (&acc)[2][2][4][2], const Unit& u, int wr, int wc, int fr, int fq, LAS unsigned char*) const {
        const int row0 = u.pm * BM + wr * 64 + fr, col0 = u.pn * BM + wc * 32 + 8 * fq;
#pragma unroll
        for (int ai = 0; ai < 2; ++ai)
#pragma unroll
            for (int m = 0; m < 4; ++m) { bf16_t* rowp = O + (size_t)(row0 + ai * HALF + m * 16) * ldc + col0;
#pragma unroll
                for (int bj = 0; bj < 2; ++bj) { const f32x4 v0 = acc[ai][bj][m][0], v1 = acc[ai][bj][m][1];
                    u32x4 w; w.x = cvtpk(v0[0], v0[1]); w.y = cvtpk(v0[2], v0[3]); w.z = cvtpk(v1[0], v1[1]); w.w = cvtpk(v1[2], v1[3]);
                    *(u32x4*)(rowp + bj * HALF) = w; } }
    }
};
struct EpiProj {
    static constexpr bool PERM = true, MID = false;
    bf16_t* O; float* ksum;
    DI void mid(f32x4 (&)[2][2][4][2], const Unit&, int, int, LAS unsigned char*, int) const {}
    DI void operator()(const f32x4 (&acc)[2][2][4][2], const Unit& u, int wr, int wc, int fr, int fq, LAS unsigned char*) const {
        const int row0 = u.pm * BM + wr * 64 + fr, col0 = u.pn * BM + wc * 32 + 8 * fq;
        const float sc = (u.pn == 6 || u.pn == 7) ? C2 : 1.0f;
#pragma unroll
        for (int ai = 0; ai < 2; ++ai)
#pragma unroll
            for (int m = 0; m < 4; ++m) { bf16_t* rowp = O + (size_t)(row0 + ai * HALF + m * 16) * DPROJ + col0;
#pragma unroll
                for (int bj = 0; bj < 2; ++bj) { const f32x4 v0 = acc[ai][bj][m][0] * sc, v1 = acc[ai][bj][m][1] * sc;
                    u32x4 w; w.x = cvtpk(v0[0], v0[1]); w.y = cvtpk(v0[2], v0[3]); w.z = cvtpk(v1[0], v1[1]); w.w = cvtpk(v1[2], v1[3]);
                    st16_wt(rowp + bj * HALF, w); } }
        if (u.pn == 8 || u.pn == 9) {
            float* kd = ksum + (size_t)u.pm * 512 + (u.pn - 8) * 256 + wc * 32 + 8 * fq;
#pragma unroll
            for (int bj = 0; bj < 2; ++bj)
#pragma unroll
                for (int n = 0; n < 2; ++n)
#pragma unroll
                    for (int j = 0; j < 4; ++j) {
                        float s = 0.f;
#pragma unroll
                        for (int ai = 0; ai < 2; ++ai)
#pragma unroll
                            for (int m = 0; m < 4; ++m) s += acc[ai][bj][m][n][j];
                        s += __shfl_xor(s, 1); s += __shfl_xor(s, 2); s += __shfl_xor(s, 4); s += __shfl_xor(s, 8);
                        if (fr == 0) atomicAdd(kd + bj * HALF + 4 * n + j, s);
                    }
        }
    }
};
struct EpiX1 {
    static constexpr bool PERM = true, MID = true;
    const float* x; float* x1; bf16_t* x1b; float* ssqx; int tab_off; unsigned char* xqh; unsigned char* xql;
    static constexpr int T_MID0 = 4, T_MID1 = 12;
    DI void mid(f32x4 (&acc)[2][2][4][2], const Unit&, int wr, int fr, LAS unsigned char* lds, int which) const {
        const LAS float* tabA = (const LAS float*)(lds + tab_off) + (which ? 0 : 1536);
#pragma unroll
        for (int ai = 0; ai < 2; ++ai)
#pragma unroll
            for (int m = 0; m < 4; ++m) { const float f = tabA[ai * HALF + wr * 64 + m * 16 + fr];
#pragma unroll
                for (int bj = 0; bj < 2; ++bj)
#pragma unroll
                    for (int n = 0; n < 2; ++n) acc[ai][bj][m][n] *= f; }
    }
    DI void operator()(const f32x4 (&acc)[2][2][4][2], const Unit& u, int wr, int wc, int fr, int fq, LAS unsigned char* lds) const {
        int tbo = tab_off; asm volatile("" : "+s"(tbo));
        const LAS float* tabB = (const LAS float*)(lds + tbo) + 256; const LAS float* gtab = (const LAS float*)(lds + tbo) + 512;
        const int col0 = u.pn * BM + wc * 32 + 8 * fq;
#pragma unroll
        for (int ai = 0; ai < 2; ++ai) {
#pragma unroll
            for (int m = 0; m < 4; ++m) { const int r = ai * HALF + wr * 64 + m * 16 + fr; const float rs = tabB[r]; const size_t off = (size_t)(u.pm * BM + r) * DM + col0;
                float ss = 0.f;
#pragma unroll
                for (int bj = 0; bj < 2; ++bj) {
                    const f32x4 v0 = acc[ai][bj][m][0] * rs, v1 = acc[ai][bj][m][1] * rs;
                    u32x4 w; w.x = cvtpk(v0[0], v0[1]); w.y = cvtpk(v0[2], v0[3]); w.z = cvtpk(v1[0], v1[1]); w.w = cvtpk(v1[2], v1[3]);
                    st16_wt(x1b + off + bj * HALF, w);
                    { const f32x4 ga = *(const LAS f32x4*)(gtab + col0 + bj * HALF), gb = *(const LAS f32x4*)(gtab + col0 + bj * HALF + 4);
                      const f32x2_t u01 = (f32x2_t){bflo(w.x) * ga[0], bfhi(w.x) * ga[1]}, u23 = (f32x2_t){bflo(w.y) * ga[2], bfhi(w.y) * ga[3]}, u45 = (f32x2_t){bflo(w.z) * gb[0], bfhi(w.z) * gb[1]}, u67 = (f32x2_t){bflo(w.w) * gb[2], bfhi(w.w) * gb[3]};
                      int h0 = 0, h1 = 0; h0 = __builtin_amdgcn_cvt_pk_fp8_f32(u01.x, u01.y, h0, false); h0 = __builtin_amdgcn_cvt_pk_fp8_f32(u23.x, u23.y, h0, true); h1 = __builtin_amdgcn_cvt_pk_fp8_f32(u45.x, u45.y, h1, false); h1 = __builtin_amdgcn_cvt_pk_fp8_f32(u67.x, u67.y, h1, true);
                      const f32x2_t b01 = __builtin_amdgcn_cvt_pk_f32_fp8(h0, false), b23 = __builtin_amdgcn_cvt_pk_f32_fp8(h0, true), b45 = __builtin_amdgcn_cvt_pk_f32_fp8(h1, false), b67 = __builtin_amdgcn_cvt_pk_f32_fp8(h1, true);
                      int l0 = 0, l1 = 0; l0 = __builtin_amdgcn_cvt_pk_fp8_f32((u01.x - b01.x) * 16.f, (u01.y - b01.y) * 16.f, l0, false); l0 = __builtin_amdgcn_cvt_pk_fp8_f32((u23.x - b23.x) * 16.f, (u23.y - b23.y) * 16.f, l0, true);
                      l1 = __builtin_amdgcn_cvt_pk_fp8_f32((u45.x - b45.x) * 16.f, (u45.y - b45.y) * 16.f, l1, false); l1 = __builtin_amdgcn_cvt_pk_fp8_f32((u67.x - b67.x) * 16.f, (u67.y - b67.y) * 16.f, l1, true);
                      u32x2 qh, ql; qh.x = (unsigned)h0; qh.y = (unsigned)h1; ql.x = (unsigned)l0; ql.y = (unsigned)l1;
                      *(u32x2*)(xqh + off + bj * HALF) = qh; *(u32x2*)(xql + off + bj * HALF) = ql; }
                    ss += ((v0[0] * v0[0] + v0[1] * v0[1]) + (v0[2] * v0[2] + v0[3] * v0[3])) + ((v1[0] * v1[0] + v1[1] * v1[1]) + (v1[2] * v1[2] + v1[3] * v1[3])); }
                ss += __shfl_xor(ss, 16); ss += __shfl_xor(ss, 32);
                if (fq == 0) ssqx[(size_t)(u.pm * BM + r) * 16 + u.pn * 4 + wc] = ss; }
        }
    }
};

DI const char* pg8_sgpr_ptr(const char* p) { const unsigned long long v = (unsigned long long)p; const unsigned lo = __builtin_amdgcn_readfirstlane((unsigned)v), hi = __builtin_amdgcn_readfirstlane((unsigned)(v >> 32)); return (const char*)(((unsigned long long)hi << 32) | lo); }
template <class Epi, class Sched, bool ALIGN_EPI>
DI void gemm_phase(LAS unsigned char* lds, const Gemm g, const Sched& S, const Epi& E) {
    const int tid = threadIdx.x, wid = __builtin_amdgcn_readfirstlane(tid >> 6), lane = tid & 63, wr = wid >> 2, wc = wid & 3, fr = lane & 15, fq = lane >> 4;
    const int K = g.K, nx = g.nx, nt = K / BK + nx;
    unsigned voffA[2], voffB[2];
#pragma unroll
    for (int i = 0; i < 2; ++i) { int R, C; stage_rc(tid * 16 + i * 8192, R, C); const int Rb = Epi::PERM ? ((R & ~31) + perm32(R & 31)) : R;
        voffA[i] = (unsigned)(R * g.lda + C) * 2u; voffB[i] = (unsigned)(Rb * g.ldb + C) * 2u; }
    const size_t kstep = (size_t)(BK * 2);
    const size_t hstepA = (size_t)HALF * g.lda * 2, hstepB = (size_t)HALF * g.ldb * 2;
    const size_t tstepA = 2 * hstepA, tstepB = 2 * hstepB;
    const unsigned ldsw = (unsigned)wid * 1024u;
    const int aoff = lds_byte(wr * 64 + fr, fq * 8), boff = lds_byte(wc * 32 + fr, fq * 8);
#define PG8_SA(b, h) (((b) * 2 + (h)) * HTB)
#define PG8_SB(b, h) ((4 + (b) * 2 + (h)) * HTB)
#define PG8_STAGE(bufoff, gbase, voff) do { _Pragma("unroll") for (int _i = 0; _i < 2; ++_i) \
        __builtin_amdgcn_global_load_lds((const unsigned*)((const char*)(gbase) + (voff)[_i]), (LAS unsigned*)(lds + (bufoff) + ldsw + _i * 8192), 16, 0, 0); } while (0)
#define PG8_LDA(dst, b, h) do { _Pragma("unroll") for (int m = 0; m < 4; ++m) _Pragma("unroll") for (int k = 0; k < 2; ++k) dst[m][k] = *(const LAS bf16x8*)(lds + PG8_SA(b, h) + aoff + m * 2048 + k * 1024); } while (0)
#define PG8_LDB(dst, b, h) do { _Pragma("unroll") for (int n = 0; n < 2; ++n) _Pragma("unroll") for (int k = 0; k < 2; ++k) dst[n][k] = *(const LAS bf16x8*)(lds + PG8_SB(b, h) + boff + n * 2048 + k * 1024); } while (0)
#define PG8_MMA(ai, bj, At, Bt) do { __builtin_amdgcn_s_setprio(1); _Pragma("unroll") for (int m = 0; m < 4; ++m) _Pragma("unroll") for (int n = 0; n < 2; ++n) _Pragma("unroll") for (int k = 0; k < 2; ++k) \
        acc[ai][bj][m][n] = __builtin_amdgcn_mfma_f32_16x16x32_bf16(Bt[n][k], At[m][k], acc[ai][bj][m][n], 0, 0, 0); __builtin_amdgcn_s_setprio(0); } while (0)
#define PG8_WAIT_V(n) asm volatile("s_waitcnt vmcnt(" #n ")" ::: "memory")
#define PG8_WAIT_L(n) asm volatile("s_waitcnt lgkmcnt(" #n ")" ::: "memory")
#define PG8_BAR __builtin_amdgcn_s_barrier()
#define PG8_SCHED __builtin_amdgcn_sched_barrier(0)
    Unit cur, nxt; int ui = 0;
    if (!S.next(0, cur)) return;
    f32x4 acc[2][2][4][2];
#pragma unroll
    for (int a = 0; a < 2; ++a)
#pragma unroll
        for (int b = 0; b < 2; ++b)
#pragma unroll
            for (int m = 0; m < 4; ++m)
#pragma unroll
                for (int n = 0; n < 2; ++n) acc[a][b][m][n] = (f32x4){0.f, 0.f, 0.f, 0.f};
    bf16x8 At[4][2], B0[2][2], B1[2][2];
    const char* cA = (const char*)g.A + (size_t)cur.pm * tstepA; const char* cB = (const char*)g.Bt + (size_t)cur.pn * tstepB;
    const char* xB = (const char*)g.XBt;
    const char* xA = (const char*)g.XA + (size_t)cur.pm * tstepA + (size_t)cur.pn * (BM * 2);
#define PG8_SP(p) pg8_sgpr_ptr(p)
#define PG8_TA(t) PG8_SP((t) < nx ? xA + (size_t)(t) * kstep : cA + (size_t)((t) - nx) * kstep)
#define PG8_TB(t) PG8_SP((t) < nx ? xB + (size_t)(t) * kstep : cB + (size_t)((t) - nx) * kstep)
    { const char* a0 = PG8_TA(0); const char* b0 = PG8_TB(0); const char* a1p = PG8_TA(1); const char* b1p = PG8_TB(1);
    PG8_STAGE(PG8_SB(0, 0), b0, voffB); PG8_STAGE(PG8_SB(0, 1), b0 + hstepB, voffB); PG8_STAGE(PG8_SA(0, 0), a0, voffA); PG8_STAGE(PG8_SA(0, 1), a0 + hstepA, voffA);
    if (wr == 1) PG8_BAR;
    PG8_WAIT_V(2); PG8_BAR;
    PG8_STAGE(PG8_SB(1, 0), b1p, voffB); PG8_STAGE(PG8_SA(1, 0), a1p, voffA); PG8_STAGE(PG8_SB(1, 1), b1p + hstepB, voffB); }
    PG8_WAIT_V(6); PG8_BAR;
    for (;;) {
        const bool has_next = S.next(ui + 1, nxt);
        const char* nA = has_next ? (const char*)g.A + (size_t)nxt.pm * tstepA : cA; const char* nB = has_next ? (const char*)g.Bt + (size_t)nxt.pn * tstepB : cB;
        const char* nxA = has_next ? (const char*)g.XA + (size_t)nxt.pm * tstepA + (size_t)nxt.pn * (BM * 2) : xA;
        const char* n0A = nx ? nxA : nA; const char* n0B = nx ? xB : nB;
        for (int t = 0; t < nt; t += 2) {
            const bool last = (t == nt - 2);
            if constexpr (Epi::MID) { if (t == Epi::T_MID0) E.mid(acc, cur, wr, fr, lds, 0); if (t == Epi::T_MID1) E.mid(acc, cur, wr, fr, lds, 1); }
            const char* a1 = PG8_TA(t + 1);
            const char* a2 = PG8_SP(last ? n0A : PG8_TA(t + 2)); const char* b2 = PG8_SP(last ? n0B : PG8_TB(t + 2));
            const char* a3 = PG8_SP(last ? n0A + kstep : PG8_TA(t + 3)); const char* b3 = PG8_SP(last ? n0B + kstep : PG8_TB(t + 3));
            PG8_LDB(B0, 0, 0); PG8_LDB(B1, 0, 1); PG8_SCHED; PG8_LDA(At, 0, 0); PG8_STAGE(PG8_SA(1, 1), a1 + hstepA, voffA);
            PG8_WAIT_V(8); PG8_WAIT_L(0); PG8_BAR; PG8_MMA(0, 0, At, B0); PG8_MMA(0, 1, At, B1); PG8_BAR; PG8_SCHED;
            PG8_LDA(At, 0, 1); PG8_STAGE(PG8_SB(0, 0), b2, voffB); PG8_STAGE(PG8_SB(0, 1), b2 + hstepB, voffB); PG8_STAGE(PG8_SA(0, 0), a2, voffA);
            PG8_WAIT_V(8); PG8_WAIT_L(0); PG8_BAR; PG8_MMA(1, 0, At, B0); PG8_MMA(1, 1, At, B1); PG8_BAR; PG8_SCHED;
            PG8_LDB(B0, 1, 0); PG8_LDB(B1, 1, 1); PG8_SCHED; PG8_LDA(At, 1, 0); PG8_STAGE(PG8_SA(0, 1), a2 + hstepA, voffA);
            PG8_WAIT_V(8); PG8_WAIT_L(0); PG8_BAR; PG8_MMA(0, 0, At, B0); PG8_MMA(0, 1, At, B1); PG8_BAR; PG8_SCHED;
            PG8_LDA(At, 1, 1); PG8_STAGE(PG8_SB(1, 0), b3, voffB); PG8_STAGE(PG8_SB(1, 1), b3 + hstepB, voffB); PG8_STAGE(PG8_SA(1, 0), a3, voffA);
            PG8_WAIT_V(8); PG8_WAIT_L(0); PG8_BAR; PG8_MMA(1, 0, At, B0); PG8_MMA(1, 1, At, B1); PG8_BAR; PG8_SCHED;
        }
        if constexpr (ALIGN_EPI) { if (wr == 0) PG8_BAR; }
        E(acc, cur, wr, wc, fr, fq, lds);
        if (!has_next) break;
#pragma unroll
        for (int a = 0; a < 2; ++a)
#pragma unroll
            for (int b = 0; b < 2; ++b)
#pragma unroll
                for (int m = 0; m < 4; ++m)
#pragma unroll
                    for (int n = 0; n < 2; ++n) acc[a][b][m][n] = (f32x4){0.f, 0.f, 0.f, 0.f};
        cur = nxt; cA = nA; cB = nB; xA = nxA; ++ui;
        if constexpr (ALIGN_EPI) { if (wr == 1) PG8_BAR; }
    }
    PG8_WAIT_V(0);
    if constexpr (!ALIGN_EPI) { if (wr == 0) PG8_BAR; }
    PG8_BAR;
#undef PG8_SA
#undef PG8_SB
#undef PG8_STAGE
#undef PG8_LDA
#undef PG8_LDB
#undef PG8_MMA
#undef PG8_WAIT_V
#undef PG8_WAIT_L
#undef PG8_BAR
#undef PG8_SCHED
}
}

constexpr size_t MiB = 1u << 20;
constexpr size_t WS_CTL = 0, CTL_ZERO_BYTES = 1 * MiB;
constexpr size_t WS_KSUM = 512 * 1024;
constexpr size_t WS_RMS0 = 768 * 1024;
constexpr size_t WS_IDM = 15 * MiB;
constexpr size_t WS_K1 = 1 * MiB, WS_K2 = WS_K1 + 256 * 1024;
constexpr size_t WS_SSQA = WS_K1 + 512 * 1024;
constexpr size_t WS_WIN = 2 * MiB, WS_WOUT = 8 * MiB, WS_WQ = 10 * MiB;
constexpr size_t WS_SSQX = 14 * MiB;
constexpr size_t WS_XN = 16 * MiB;
constexpr size_t WS_PROJ = 48 * MiB;
constexpr size_t WS_QRY = 48 * MiB;
constexpr size_t WS_EIDX = 112 * MiB, WS_GATE = 120 * MiB;
constexpr size_t WS_Y = 144 * MiB;
constexpr size_t WS_XQH = 128 * MiB, WS_XQL = 240 * MiB;
constexpr size_t WS_CQ = 48 * MiB;
constexpr size_t WS_DELTA = 144 * MiB;
constexpr size_t WS_ED = 176 * MiB, WS_EU = 208 * MiB, WS_END = 256 * MiB;
constexpr int CW_BAR = 4096;

constexpr int SCR_BYTES = 151552;
constexpr int TAB_OFF = 131072;
constexpr int MISC_OFF = SCR_BYTES;
constexpr int LDS_BYTES = 155648;
constexpr int NWAVES = 8;

#define XB_TMO      128
#define XB_XCNT(j)  (256  + 64 * (j))
#define XB_XSUB(j)  (1280 + 64 * (j))
#define XB_XGEN(j)  (2304 + 64 * (j))
#define XB_TOP      3328
#define XB_TOPGEN   3392
#define XCD_BAR_WORDS 3456
#define XB_SPIN_CAP (1u << 18)
DI unsigned xb_ld(unsigned* p)              { return __hip_atomic_load(p, __ATOMIC_RELAXED, __HIP_MEMORY_SCOPE_AGENT); }
DI unsigned xb_add(unsigned* p, unsigned v) { return __hip_atomic_fetch_add(p, v, __ATOMIC_RELAXED, __HIP_MEMORY_SCOPE_AGENT); }
DI unsigned xb_xcc_id() { return (unsigned)__builtin_amdgcn_s_getreg((3 << 11) | 20) & 0xFu; }
#define XB_SPIN(cond, bar) do { unsigned _sp = 0; while (cond) { __builtin_amdgcn_s_sleep(1); \
    if ((++_sp & 255u) == 0u) { if (xb_ld(&(bar)[XB_TMO])) break; if (_sp > XB_SPIN_CAP) { atomicAdd(&(bar)[XB_TMO], 1u); break; } } } } while (0)
struct XcdBarrier { unsigned* bar; unsigned x; volatile LAS unsigned* st; };
DI XcdBarrier xcd_barrier_post(unsigned* bar, volatile LAS unsigned* st) {
    XcdBarrier b; b.bar = bar; b.x = xb_xcc_id(); b.st = st;
    if (threadIdx.x == 0) st[3] = xb_add(&bar[XB_XCNT(b.x)], 1u);
    return b;
}
DI void xcd_barrier_complete(unsigned* bar, unsigned x, unsigned& nloc, unsigned& nx, unsigned& ord) {
    const unsigned G = gridDim.x * gridDim.y * gridDim.z;
    unsigned sum, cnt, mine, below, sp = 0u;
    for (;;) {
        sum = 0u; cnt = 0u; mine = 0u; below = 0u;
#pragma unroll
        for (unsigned j = 0; j < 16; ++j) { const unsigned c = xb_ld(&bar[XB_XCNT(j)]); sum += c; cnt += (c > 0u) ? 1u : 0u; mine = (j == x) ? c : mine; below += (c > 0u && j < x) ? 1u : 0u; }
        if (sum == G) break;
        __builtin_amdgcn_s_sleep(1);
        if ((++sp & 255u) == 0u) { if (xb_ld(&bar[XB_TMO])) break; if (sp > XB_SPIN_CAP) { atomicAdd(&bar[XB_TMO], 1u); break; } }
    }
    nloc = mine > 0u ? mine : 1u; nx = cnt > 0u ? cnt : 1u; ord = below;
}
DI void xcd_barrier(const XcdBarrier& b) {
    asm volatile("s_waitcnt vmcnt(0)" ::: "memory");
    __syncthreads();
    if (threadIdx.x == 0) {
        unsigned* bar = b.bar;
        __builtin_amdgcn_s_waitcnt(0);
        unsigned nloc = b.st[0], nx = b.st[1];
        if (nloc == 0u) { unsigned ord; xcd_barrier_complete(bar, b.x, nloc, nx, ord); b.st[0] = nloc; b.st[1] = nx; b.st[2] = ord; }
        const unsigned old = xb_add(&bar[XB_XSUB(b.x)], 1u);
        const unsigned gen = old / nloc;
        if (old + 1u == (gen + 1u) * nloc) {
            __builtin_amdgcn_fence(__ATOMIC_RELEASE, "agent");
            asm volatile("s_waitcnt vmcnt(0)" ::: "memory");
            const unsigned og = xb_add(&bar[XB_TOP], 1u);
            const unsigned tg = og / nx;
            if (og + 1u == (tg + 1u) * nx) xb_add(&bar[XB_TOPGEN], 1u);
            else XB_SPIN(xb_ld(&bar[XB_TOPGEN]) == tg, bar);
            __builtin_amdgcn_fence(__ATOMIC_ACQUIRE, "agent");
            xb_add(&bar[XB_XGEN(b.x)], 1u);
            asm volatile("s_waitcnt vmcnt(0)" ::: "memory");
        } else {
            XB_SPIN(xb_ld(&bar[XB_XGEN(b.x)]) == gen, bar);
            __builtin_amdgcn_fence(__ATOMIC_ACQUIRE, "agent");
            asm volatile("s_waitcnt vmcnt(0)" ::: "memory");
        }
    }
    __syncthreads();
}

struct Frame {
    LAS unsigned char* lds;
    int tid, lane, wave, vcu, G;
};
struct Args { const float* in[14]; float* out; unsigned char* ws; int ph_lo, ph_hi, li, pad; };

DI void p0_transpose_item(const float* W, int K, int N, bf16_t* WT, const float* sc_lo, const float* sc_hi, int split, LAS float* scr, int item, int lane) {
    const int nblk = N / 32, kb = item / nblk, nb = item % nblk, k0 = 64 * kb, n0 = 32 * nb;
#pragma unroll 16
    for (int i = 0; i < 32; ++i) { const int kk = 2 * i + (lane >> 5); const int k = k0 + kk;
        float s = 1.0f; if (sc_lo) s = (k < split) ? sc_lo[k] : sc_hi[k - split];
        scr[kk * 33 + (lane & 31)] = W[(size_t)k * N + n0 + (lane & 31)] * s; }
    asm volatile("s_waitcnt lgkmcnt(0)" ::: "memory");
    const int c = lane & 7;
#pragma unroll
    for (int j = 0; j < 4; ++j) { const int n = (lane >> 3) + 8 * j; const LAS float* s = scr + (8 * c) * 33 + n;
        u32x4 o; o.x = cvtpk(s[0 * 33], s[1 * 33]); o.y = cvtpk(s[2 * 33], s[3 * 33]); o.z = cvtpk(s[4 * 33], s[5 * 33]); o.w = cvtpk(s[6 * 33], s[7 * 33]);
        st16_wt(WT + (size_t)(n0 + n) * K + k0 + 8 * c, o); }
    asm volatile("s_waitcnt lgkmcnt(0)" ::: "memory");
}
DI void p0_cvt_item(const float* src, bf16_t* dst, size_t item, int lane) {
    const f32x4* s = (const f32x4*)(src + item * 512) + 2 * lane;
    const f32x4 a = s[0], b = s[1];
    u32x4 o; o.x = cvtpk(a[0], a[1]); o.y = cvtpk(a[2], a[3]); o.z = cvtpk(b[0], b[1]); o.w = cvtpk(b[2], b[3]);
    *((u32x4*)(dst + item * 512) + lane) = o;
}
DI void p0_cvt8_item(const float* src, unsigned char* dst, size_t item, int lane, float sc) {
    const f32x4* s = (const f32x4*)(src + item * 512) + 2 * lane;
    const f32x4 a = s[0] * sc, b = s[1] * sc;
    int w0 = 0, w1 = 0;
    w0 = __builtin_amdgcn_cvt_pk_fp8_f32(a[0], a[1], w0, false); w0 = __builtin_amdgcn_cvt_pk_fp8_f32(a[2], a[3], w0, true);
    w1 = __builtin_amdgcn_cvt_pk_fp8_f32(b[0], b[1], w1, false); w1 = __builtin_amdgcn_cvt_pk_fp8_f32(b[2], b[3], w1, true);
    u32x2 o; o.x = (unsigned)w0; o.y = (unsigned)w1;
    *((u32x2*)(dst + item * 512) + lane) = o;
}
template <int U> struct CvtRegs { f32x4 a[U][2]; };
template <int U> DI void cvt8_load(CvtRegs<U>& r, const float* src, size_t item0, int lane) {
#pragma unroll
    for (int u = 0; u < U; ++u) { const f32x4* s = (const f32x4*)(src + (item0 + u) * 512) + 2 * lane; r.a[u][0] = __builtin_nontemporal_load(s); r.a[u][1] = __builtin_nontemporal_load(s + 1); }
}
template <int U> DI void cvt8_store(const CvtRegs<U>& r, unsigned char* dst, size_t item0, int lane, float sc, const float* colg) {
#pragma unroll
    for (int u = 0; u < U; ++u) { const size_t it = item0 + u; const int e = (int)(it >> 1), hh = (int)(it & 1), col = 512 * hh + 8 * lane;
        f32x4 x = r.a[u][0] * sc, y = r.a[u][1] * sc;
        if (colg) { x = x * *(const f32x4*)(colg + col); y = y * *(const f32x4*)(colg + col + 4); }
        int w0 = 0, w1 = 0;
        w0 = __builtin_amdgcn_cvt_pk_fp8_f32(x[0], x[1], w0, false); w0 = __builtin_amdgcn_cvt_pk_fp8_f32(x[2], x[3], w0, true);
        w1 = __builtin_amdgcn_cvt_pk_fp8_f32(y[0], y[1], w1, false); w1 = __builtin_amdgcn_cvt_pk_fp8_f32(y[2], y[3], w1, true);
        u32x2 o; o.x = (unsigned)w0; o.y = (unsigned)w1;
        *(u32x2*)(dst + (size_t)(col >> 7) * ((size_t)NEXP * 128) + (size_t)e * 128 + (col & 127)) = o; }
}
template <int U> DI void p0_xn_rows(const float* x, const float* g, bf16_t* xn, float* rms0, int row0, int lane) {
    f32x4 v[U][4];
#pragma unroll
    for (int u = 0; u < U; ++u)
#pragma unroll
        for (int j = 0; j < 4; ++j) v[u][j] = __builtin_nontemporal_load((const f32x4*)(x + (size_t)(row0 + u) * DM) + lane + 64 * j);
    f32x4 gg[4];
#pragma unroll
    for (int j = 0; j < 4; ++j) gg[j] = *((const f32x4*)g + lane + 64 * j);
#pragma unroll
    for (int u = 0; u < U; ++u) { float s = 0.f;
#pragma unroll
        for (int j = 0; j < 4; ++j) s += (v[u][j][0] * v[u][j][0] + v[u][j][1] * v[u][j][1]) + (v[u][j][2] * v[u][j][2] + v[u][j][3] * v[u][j][3]);
        const float rstd = 1.0f / sqrtf(wave_sum(s) * (1.f / DM) + EPS);
        u32x2* o8 = (u32x2*)(xn + (size_t)(row0 + u) * DM) + lane;
#pragma unroll
        for (int j = 0; j < 4; ++j) { u32x2 w; w.x = cvtpk(v[u][j][0] * rstd, v[u][j][1] * rstd); w.y = cvtpk(v[u][j][2] * rstd, v[u][j][3] * rstd); st8_wt(o8 + 64 * j, w); }
        if (lane == 0) st4_wt(rms0 + row0 + u, __float_as_uint(1.0f / rstd)); }
}
DI void p0_xn_row(const float* xrow, const float* g, bf16_t* orow, int lane) {
    const f32x4* xr = (const f32x4*)xrow + lane; const f32x4* gr = (const f32x4*)g + lane;
    f32x4 v[4]; float s = 0.f;
#pragma unroll
    for (int j = 0; j < 4; ++j) { v[j] = xr[64 * j]; s += (v[j][0] * v[j][0] + v[j][1] * v[j][1]) + (v[j][2] * v[j][2] + v[j][3] * v[j][3]); }
    const float rstd = 1.0f / sqrtf(wave_sum(s) * (1.f / DM) + EPS);
    u32x2* o8 = (u32x2*)orow + lane;
#pragma unroll
    for (int j = 0; j < 4; ++j) { const f32x4 gg = gr[64 * j]; u32x2 w; w.x = cvtpk(v[j][0] * rstd * gg[0], v[j][1] * rstd * gg[1]); w.y = cvtpk(v[j][2] * rstd * gg[2], v[j][3] * rstd * gg[3]); o8[64 * j] = w; }
}

namespace att {
DI void conv_rows4(const bf16_t* proj, const float* cw, bf16_t* Y, int r0, int lane) {
    const int ch = 8 * lane; const bool head = (r0 & (SEQ - 1)) == 0;
    const bf16_t* pr = proj + (size_t)r0 * DPROJ + ch;
    u32x4 bg[4], cg[6], hc[6];
#pragma unroll
    for (int i = 0; i < 4; ++i) bg[i] = *(const u32x4*)(pr + (size_t)i * DPROJ);
#pragma unroll
    for (int q = 0; q < 6; ++q) { cg[q] = (u32x4){0u, 0u, 0u, 0u}; hc[q] = (u32x4){0u, 0u, 0u, 0u};
        if (q >= 2 || !head) { cg[q] = *(const u32x4*)(pr + ((ptrdiff_t)q - 2) * DPROJ + 512); hc[q] = *(const u32x4*)(pr + ((ptrdiff_t)q - 2) * DPROJ + 1024); } }
    f32x4 w[3][2];
#pragma unroll
    for (int k = 0; k < 3; ++k) { w[k][0] = *(const f32x4*)(cw + k * 512 + ch); w[k][1] = *(const f32x4*)(cw + k * 512 + ch + 4); }
    float u[6][8];
#pragma unroll
    for (int q = 0; q < 6; ++q)
#pragma unroll
        for (int j = 0; j < 4; ++j) { u[q][2 * j] = bflo(cg[q][j]) * bflo(hc[q][j]); u[q][2 * j + 1] = bfhi(cg[q][j]) * bfhi(hc[q][j]); }
#pragma unroll
    for (int i = 0; i < 4; ++i) {
        float acc[8]; float ss = 0.f;
#pragma unroll
        for (int e = 0; e < 8; ++e) { float a = 0.f;
#pragma unroll
            for (int k = 0; k < 3; ++k) a += w[k][e >> 2][e & 3] * u[i + k][e];
            const float b = (e & 1) ? bfhi(bg[i][e >> 1]) : bflo(bg[i][e >> 1]);
            acc[e] = a * b; ss += acc[e] * acc[e]; }
        const float rstd = 1.0f / sqrtf(wave_sum(ss) * (1.f / 512.f) + EPS);
        u32x4 o; o.x = cvtpk(acc[0] * rstd, acc[1] * rstd); o.y = cvtpk(acc[2] * rstd, acc[3] * rstd); o.z = cvtpk(acc[4] * rstd, acc[5] * rstd); o.w = cvtpk(acc[6] * rstd, acc[7] * rstd);
        st16_wt(Y + (size_t)(r0 + i) * DM + ch, o);
    }
}
DI void conv_rows8(const bf16_t* proj, const float* cw, bf16_t* Y, int r0, int lane_) {
    int lane; asm volatile("v_mbcnt_lo_u32_b32 %0, -1, 0\n\tv_mbcnt_hi_u32_b32 %0, -1, %0" : "=v"(lane)); (void)lane_;
    const int ch = 8 * lane; const bool head = (r0 & (SEQ - 1)) == 0;
    const bf16_t* pr = proj + (size_t)r0 * DPROJ + ch;
    u32x4 bg[8], cg[10], hc[10];
#pragma unroll
    for (int i = 0; i < 8; ++i) bg[i] = *(const u32x4*)(pr + (size_t)i * DPROJ);
#pragma unroll
    for (int q = 0; q < 10; ++q) { cg[q] = (u32x4){0u, 0u, 0u, 0u}; hc[q] = (u32x4){0u, 0u, 0u, 0u};
        if (q >= 2 || !head) { cg[q] = *(const u32x4*)(pr + ((ptrdiff_t)q - 2) * DPROJ + 512); hc[q] = *(const u32x4*)(pr + ((ptrdiff_t)q - 2) * DPROJ + 1024); } }
    f32x4 w[3][2];
#pragma unroll
    for (int k = 0; k < 3; ++k) { w[k][0] = *(const f32x4*)(cw + k * 512 + ch); w[k][1] = *(const f32x4*)(cw + k * 512 + ch + 4); }
#pragma unroll
    for (int i = 0; i < 8; ++i) {
        float acc[8]; float ss = 0.f;
#pragma unroll
        for (int e = 0; e < 8; ++e) { float a = 0.f;
#pragma unroll
            for (int k = 0; k < 3; ++k) { const unsigned cw_ = cg[i + k][e >> 1], hw_ = hc[i + k][e >> 1]; const float uu = (e & 1) ? bfhi(cw_) * bfhi(hw_) : bflo(cw_) * bflo(hw_); a += w[k][e >> 2][e & 3] * uu; }
            const float b = (e & 1) ? bfhi(bg[i][e >> 1]) : bflo(bg[i][e >> 1]);
            acc[e] = a * b; ss += acc[e] * acc[e]; }
        const float rstd = 1.0f / sqrtf(wave_sum(ss) * (1.f / 512.f) + EPS);
        u32x4 o; o.x = cvtpk(acc[0] * rstd, acc[1] * rstd); o.y = cvtpk(acc[2] * rstd, acc[3] * rstd); o.z = cvtpk(acc[4] * rstd, acc[5] * rstd); o.w = cvtpk(acc[6] * rstd, acc[7] * rstd);
        st16_wt(Y + (size_t)(r0 + i) * DM + ch, o);
        __builtin_amdgcn_sched_barrier(0);
    }
}
}

namespace att2 {
using bf16=__hip_bfloat16;
using bf16x8=__attribute__((ext_vector_type(8)))short;
using s16x4=__attribute__((ext_vector_type(4)))short;
using f32x16=__attribute__((ext_vector_type(16)))float;
using u32x4=__attribute__((ext_vector_type(4)))unsigned;
constexpr int BATCH=8,NHEAD=8,SEQ=2048,D=64,PQ=3072,PO=1024;
constexpr int NW=8,QBLK=32,QB=QBLK*NW,KVBLK=64,NQB=SEQ/QB;
__device__ __forceinline__ int crow(int r,int hi){return (r&3)+8*(r>>2)+4*hi;}
#define SBAR() __builtin_amdgcn_sched_barrier(0)
__device__ __forceinline__ void cmask(f32x16&p0,f32x16&p1,int jb,int qrel,int hi){
  const float NEG=-INFINITY; int kb=64*jb+4*hi;
  #pragma unroll
  for(int r=0;r<16;++r){int kv=kb+(r&3)+8*(r>>2); if(kv>qrel)p0[r]=NEG; if(kv+32>qrel)p1[r]=NEG;}
}

constexpr int NSLOT=3, SLOTB=8192;
constexpr int LDS_K=0, LDS_V=NSLOT*SLOTB, LDS_WS=2*NSLOT*SLOTB, LDS_OST=LDS_WS+NW*64*4, LDS_KM=LDS_OST+NW*4096, LDS_BYTES=LDS_KM+2048;
constexpr float C2=0.125f*1.4426950408889634f;
__device__ __forceinline__ void glds16(const void*gsrc,unsigned lds_dst){unsigned keep;
  asm volatile("s_mov_b32 %0, m0\n\ts_mov_b32 m0, %2\n\ts_nop 0\n\tglobal_load_lds_dwordx4 %1, off\n\ts_mov_b32 m0, %0":"=&s"(keep):"v"(gsrc),"s"(lds_dst):"memory");}
__device__ __forceinline__ float max3f(float a,float b,float c){float r;asm("v_max3_f32 %0, %1, %2, %3":"=v"(r):"v"(a),"v"(b),"v"(c));return r;}
__device__ __forceinline__ float max2f(float a,float b){float r;asm("v_max_f32_e32 %0, %1, %2":"=v"(r):"v"(a),"v"(b));return r;}
__device__ __forceinline__ float fadd_s(float a,float b){float r;asm("v_add_f32_e32 %0, %1, %2":"=v"(r):"v"(a),"v"(b));return r;}
__device__ __forceinline__ float fsub_s(float a,float b){float r;asm("v_sub_f32_e32 %0, %1, %2":"=v"(r):"v"(a),"v"(b));return r;}
typedef float f32x2_t __attribute__((ext_vector_type(2))); typedef __bf16 bf16x2_t __attribute__((ext_vector_type(2)));
__device__ __forceinline__ unsigned cvtpk_s(float lo,float hi){f32x2_t v={lo,hi};bf16x2_t b=__builtin_convertvector(v,bf16x2_t);return __builtin_bit_cast(unsigned,b);}
#define WAIT_BAR(N) asm volatile("s_waitcnt vmcnt(" #N ") lgkmcnt(0)\n\ts_barrier":::"memory")

__device__ __forceinline__ void qkt(f32x16&p0,f32x16&p1,const char*Kslot,const bf16x8*qr,const f32x16&negm,int r32,int hi){
  const char*kb=Kslot+hi*1024+r32*16;
  #pragma unroll
  for(int d0=0;d0<4;++d0){
    const bf16x8 b0=*reinterpret_cast<const bf16x8*>(kb+d0*2048);
    const bf16x8 b1=*reinterpret_cast<const bf16x8*>(kb+d0*2048+512);
    if(d0==0){p0=__builtin_amdgcn_mfma_f32_32x32x16_bf16(b0,qr[0],negm,0,0,0);p1=__builtin_amdgcn_mfma_f32_32x32x16_bf16(b1,qr[0],negm,0,0,0);}
    else{p0=__builtin_amdgcn_mfma_f32_32x32x16_bf16(b0,qr[d0],p0,0,0,0);p1=__builtin_amdgcn_mfma_f32_32x32x16_bf16(b1,qr[d0],p1,0,0,0);}}
}
typedef __attribute__((address_space(3))) const char* lds_cptr;
typedef short v4i16_t __attribute__((ext_vector_type(4)));
__device__ __forceinline__ void kload8(bf16x8*kf,lds_cptr kp){
  kf[0]=*(const __attribute__((address_space(3))) bf16x8*)(kp);      kf[1]=*(const __attribute__((address_space(3))) bf16x8*)(kp+512);
  kf[2]=*(const __attribute__((address_space(3))) bf16x8*)(kp+2048); kf[3]=*(const __attribute__((address_space(3))) bf16x8*)(kp+2560);
  kf[4]=*(const __attribute__((address_space(3))) bf16x8*)(kp+4096); kf[5]=*(const __attribute__((address_space(3))) bf16x8*)(kp+4608);
  kf[6]=*(const __attribute__((address_space(3))) bf16x8*)(kp+6144); kf[7]=*(const __attribute__((address_space(3))) bf16x8*)(kp+6656);
}
__device__ __forceinline__ void kload2(bf16x8*kf,lds_cptr kp,int j){ kf[2*j]=*(const __attribute__((address_space(3))) bf16x8*)(kp+j*2048); kf[2*j+1]=*(const __attribute__((address_space(3))) bf16x8*)(kp+j*2048+512); }
__device__ __forceinline__ s16x4 vtr(lds_cptr p){ return __builtin_bit_cast(s16x4,__builtin_amdgcn_ds_read_tr16_b64_v4i16((__attribute__((address_space(3))) v4i16_t*)p)); }
__device__ __forceinline__ float rowmax(const f32x16&p0,const f32x16&p1){
  float a=max3f(p0[0],p0[1],p1[0]),b=max3f(p0[2],p0[3],p1[1]);a=max3f(a,p1[2],p1[3]);
  #pragma unroll
  for(int r=4;r<16;r+=4){a=max3f(a,p0[r],p0[r+1]);b=max3f(b,p0[r+2],p0[r+3]);a=max3f(a,p1[r],p1[r+1]);b=max3f(b,p1[r+2],p1[r+3]);}
  const float m=max2f(a,b);
  auto rr=__builtin_amdgcn_permlane32_swap(__float_as_uint(m),__float_as_uint(m),false,false);
  return max2f(__uint_as_float(rr[0]),__uint_as_float(rr[1]));
}
__device__ __forceinline__ void pv(f32x16*o,int vb,bf16x8 pa0,bf16x8 pa1,bf16x8 pa2,bf16x8 pa3){
  #pragma unroll
  for(int d0=0;d0<2;++d0){s16x4 lo[4],hi[4];
    #pragma unroll
    for(int ks=0;ks<4;++ks){
      asm volatile("ds_read_b64_tr_b16 %0,%1 offset:%c2":"=&v"(lo[ks]):"v"(vb),"i"(d0*4096+ks*1024):"memory");
      asm volatile("ds_read_b64_tr_b16 %0,%1 offset:%c2":"=&v"(hi[ks]):"v"(vb),"i"(d0*4096+ks*1024+512):"memory");}
    asm volatile("s_waitcnt lgkmcnt(0)":::"memory");SBAR();
    #define PK(k) (bf16x8){lo[k][0],lo[k][1],lo[k][2],lo[k][3],hi[k][0],hi[k][1],hi[k][2],hi[k][3]}
    o[d0]=__builtin_amdgcn_mfma_f32_32x32x16_bf16(pa0,PK(0),o[d0],0,0,0);
    o[d0]=__builtin_amdgcn_mfma_f32_32x32x16_bf16(pa1,PK(1),o[d0],0,0,0);
    o[d0]=__builtin_amdgcn_mfma_f32_32x32x16_bf16(pa2,PK(2),o[d0],0,0,0);
    o[d0]=__builtin_amdgcn_mfma_f32_32x32x16_bf16(pa3,PK(3),o[d0],0,0,0);
    #undef PK
  }
}

#ifndef ATTN_STORE16
#define ATTN_STORE16(p,v) st16_wt((void*)(p),(v))
#endif
template<int THRL> __device__ __forceinline__ void attn_unit(int b,int h,int qb,const bf16*Q,const bf16*__restrict__ K,const bf16*__restrict__ V,bf16*O,const float*ksum,float*ssqa,char*shm){
  int lane; asm volatile("v_mbcnt_lo_u32_b32 %0, -1, 0\n\tv_mbcnt_hi_u32_b32 %0, -1, %0":"=v"(lane));     const int tid=threadIdx.x,r32=lane&31,hi=lane>>5; const int wid=__builtin_amdgcn_readfirstlane(tid>>6);
  const long rowbase=(long)b*SEQ; const int q0=qb*QB;
  const bf16*Qw=Q+(rowbase+q0+wid*QBLK)*PQ+h*D;
  const bf16*Kh=K+rowbase*PQ+h*D,*Vh=V+rowbase*PQ+h*D;
  const unsigned lds0=(unsigned)(uintptr_t)shm;
  float*wsf=(float*)(shm+LDS_WS)+wid*64;
  const bf16*ksrc=Kh+(long)lane*PQ+wid*8;
  const bf16*vsrc=Vh+(long)(16*(wid&3)+(lane>>2))*PQ+(wid>>2)*32+(lane&3)*8;
  const unsigned kdst=lds0+LDS_K+wid*1024, vdst=lds0+LDS_V+wid*1024;
  #define DMA_K(t,slot) glds16(ksrc+(long)(t)*KVBLK*PQ,(unsigned)__builtin_amdgcn_readfirstlane(kdst+(slot)))
  #define DMA_V(t,slot) glds16(vsrc+(long)(t)*KVBLK*PQ,(unsigned)__builtin_amdgcn_readfirstlane(vdst+(slot)))
  const int vb0=(int)(lds0+LDS_V)+((lane>>4)&1)*32+(lane&3)*8+(4*hi+((lane&15)>>2))*64;
  const char*Kbase=shm+LDS_K; bf16x8 kf[8];
  const lds_cptr shm3=(lds_cptr)shm; const lds_cptr kp0=shm3+LDS_K+hi*1024+r32*16; const lds_cptr vp0=shm3+LDS_V+((lane>>4)&1)*32+(lane&3)*8+(4*hi+((lane&15)>>2))*64;
  const int NT=(q0+QB)/KVBLK;
  DMA_K(0,0);DMA_V(0,0);DMA_K(1,SLOTB);
  bf16x8 qr[4];
  #pragma unroll
  for(int d0=0;d0<4;++d0)qr[d0]=*reinterpret_cast<const bf16x8*>(&Qw[(long)r32*PQ+d0*16+hi*8]);
  unsigned selmask=(1u<<qb)-1u;
  { __attribute__((address_space(3))) float*km=(__attribute__((address_space(3))) float*)(shm+LDS_KM);
    if(tid<64*qb)km[tid]=ksum[(long)(b*8+(tid>>6))*512+h*64+(tid&63)];
    __syncthreads();
    if(qb>3){ float gt[7];
      #pragma unroll
      for(int n=0;n<7;++n){ float a=-3.0e38f;
        if(n<qb){ a=0.f;
          #pragma unroll
          for(int s=0;s<4;++s)
            #pragma unroll
            for(int j=0;j<8;++j)a+=__uint_as_float(((unsigned)(unsigned short)qr[s][j])<<16)*km[n*64+16*s+8*hi+j];
          a+=__shfl_xor(a,32); }
        gt[n]=a; }
      selmask=0u;
      #pragma unroll
      for(int n=0;n<7;++n){ int cnt=0;
        #pragma unroll
        for(int m2=0;m2<7;++m2)if(m2!=n)cnt+=(gt[m2]>gt[n]||(gt[m2]==gt[n]&&m2<n))?1:0;
        if(cnt<3&&n<qb)selmask|=1u<<n; } }
    __syncthreads(); }
  #define MMASK(P0,P1,t) do{ const int blk_=(t)>>2; if(blk_<qb&&!((selmask>>blk_)&1u)){ _Pragma("unroll") for(int r=0;r<16;++r){P0[r]=-1.0e30f;P1[r]=-1.0e30f;} } }while(0)
  float mhat=0.f,l_reg=0.f;f32x16 o[2];o[0]=f32x16{};o[1]=f32x16{};const f32x16 negm=f32x16{};
  const int qrel=wid*QBLK+r32;
  #define CMASK(P0,P1,t) do{int jb_=(t)-(NT-4); if(jb_>=0)cmask(P0,P1,jb_,qrel,hi);}while(0)
  bool resc=false;
  #define START(P0,P1) do{ const float rm=max2f(rowmax(P0,P1),-1000.0f); resc=false; \
    { const float dl=rm; mhat=fadd_s(mhat,dl); \
      _Pragma("unroll") for(int r=0;r<16;++r){P0[r]=fsub_s(P0[r],dl);P1[r]=fsub_s(P1[r],dl);} \
      } \
    _Pragma("unroll") for(int r=0;r<16;++r)P0[r]=__builtin_amdgcn_exp2f(P0[r]); }while(0)
  #define RESC() do{ if(resc){ asm volatile("s_waitcnt lgkmcnt(0)":::"memory"); \
      _Pragma("unroll") for(int d_=0;d_<2;++d_) _Pragma("unroll") for(int r=0;r<16;++r)o[d_][r]*=wsf[crow(r,hi)]; } }while(0)
  f32x16 pA0,pA1,pB0,pB1;
  int sl_prev=0,sl_cur=0,sl_next=SLOTB;
  #define ROT() do{sl_prev=sl_cur;sl_cur=sl_next;sl_next=(sl_next==(NSLOT-1)*SLOTB)?0:sl_next+SLOTB;}while(0)
  DMA_K(2,2*SLOTB);
  WAIT_BAR(3);
  qkt(pA0,pA1,Kbase,qr,negm,r32,hi);asm volatile("s_nop 15\n\ts_nop 7":"+v"(pA0),"+v"(pA1));CMASK(pA0,pA1,0);MMASK(pA0,pA1,0);
  START(pA0,pA1);
  _Pragma("unroll") for(int r=0;r<16;++r)pA1[r]=__builtin_amdgcn_exp2f(pA1[r]);
  WAIT_BAR(0);
  DMA_K(3,0);DMA_V(1,SLOTB);
  ROT();
  kload8(kf,kp0+sl_cur);
  WAIT_BAR(2);
  s16x4 vlo[8],vhi[8]; u32x4 pw0,pw1,pw2,pw3;
  #define PKW(P,B) cvtpk_s(P[B],P[B+1])
  #define PAF(k) __builtin_bit_cast(bf16x8,pw##k)
  #define VFR(i) (bf16x8){vlo[i][0],vlo[i][1],vlo[i][2],vlo[i][3],vhi[i][0],vhi[i][1],vhi[i][2],vhi[i][3]}
  #define PIN(x) asm volatile("":"+v"(x))
  #define MX3(a,b,c) __builtin_fmaxf(__builtin_fmaxf((a),(b)),(c))
  #define GAPA(MF,A0,A1,A2,A3,W0,W1,PW) do{ MF; sacc+=A0; sacc+=A1; sacc+=A2; sacc+=A3; PIN(sacc); W0; W1; PIN(PW); SBAR(); }while(0)
  #define EX(v) __builtin_amdgcn_exp2f(v)
  #define GAPB(MF,X,B) do{ MF; X[B]=EX(X[B]); X[B+1]=EX(X[B+1]); X[B+2]=EX(X[B+2]); X[B+3]=EX(X[B+3]); PIN(X); SBAR(); }while(0)
  #define VRD(i) do{ vlo[i]=vtr(vp_+(((i)>>2)*4096+((i)&3)*1024)); vhi[i]=vtr(vp_+(((i)>>2)*4096+((i)&3)*1024+512)); }while(0)
  #define KRD(G,j) do{ if(G){ kload2(kf,kp0+sl_next,j); SBAR(); } }while(0)
  #define STEP(C0,C1,P0,P1,t,GK,GV,GL) do{ SBAR(); \
    const lds_cptr vp_=vp0+sl_prev; \
    VRD(0); SBAR(); float sacc=(P0[0]+P0[1]); \
    GAPA(C0=__builtin_amdgcn_mfma_f32_32x32x16_bf16(kf[0],qr[0],negm,0,0,0), P0[2],P0[3],P0[4],P0[5],     pw0[0]=PKW(P0,0), pw0[1]=PKW(P0,2), pw0); \
    VRD(4); SBAR(); GAPA(C1=__builtin_amdgcn_mfma_f32_32x32x16_bf16(kf[1],qr[0],negm,0,0,0), P0[6],P0[7],P0[8],P0[9],     pw0[2]=PKW(P0,4), pw0[3]=PKW(P0,6), pw0); \
    VRD(1); SBAR(); GAPA(C0=__builtin_amdgcn_mfma_f32_32x32x16_bf16(kf[2],qr[1],C0,0,0,0),   P0[10],P0[11],P0[12],P0[13], pw1[0]=PKW(P0,8), pw1[1]=PKW(P0,10), pw1); \
    VRD(5); SBAR(); GAPA(C1=__builtin_amdgcn_mfma_f32_32x32x16_bf16(kf[3],qr[1],C1,0,0,0),   P0[14],P0[15],P1[0],P1[1],   pw1[2]=PKW(P0,12),pw1[3]=PKW(P0,14), pw1); \
    VRD(2); SBAR(); GAPA(C0=__builtin_amdgcn_mfma_f32_32x32x16_bf16(kf[4],qr[2],C0,0,0,0),   P1[2],P1[3],P1[4],P1[5],     pw2[0]=PKW(P1,0), pw2[1]=PKW(P1,2), pw2); \
    VRD(6); SBAR(); GAPA(C1=__builtin_amdgcn_mfma_f32_32x32x16_bf16(kf[5],qr[2],C1,0,0,0),   P1[6],P1[7],P1[8],P1[9],     pw2[2]=PKW(P1,4), pw2[3]=PKW(P1,6), pw2); \
    VRD(3); SBAR(); GAPA(C0=__builtin_amdgcn_mfma_f32_32x32x16_bf16(kf[6],qr[3],C0,0,0,0),   P1[10],P1[11],P1[12],P1[13], pw3[0]=PKW(P1,8), pw3[1]=PKW(P1,10), pw3); \
    VRD(7); SBAR(); GAPA(C1=__builtin_amdgcn_mfma_f32_32x32x16_bf16(kf[7],qr[3],C1,0,0,0),   P1[14],P1[15],0.f,0.f,       pw3[2]=PKW(P1,12),pw3[3]=PKW(P1,14), pw3); \
    l_reg+=sacc; \
    if(GK){DMA_K((t)+3,sl_cur);} if(GV){DMA_V((t)+1,sl_next);} \
    { const int blk_=(t)>>2; const float ms_=(blk_<qb&&!((selmask>>blk_)&1u))?1.0e30f:mhat;     \
      _Pragma("unroll") for(int r=0;r<16;++r){C0[r]-=ms_;C1[r]-=ms_;} } \
    CMASK(C0,C1,t); \
    { float a=MX3(C0[0],C0[1],C1[0]),b=MX3(C0[2],C0[3],C1[1]); a=MX3(a,C1[2],C1[3]); \
      _Pragma("unroll") for(int r=4;r<16;r+=4){a=MX3(a,C0[r],C0[r+1]);b=MX3(b,C0[r+2],C0[r+3]);a=MX3(a,C1[r],C1[r+1]);b=MX3(b,C1[r+2],C1[r+3]);} \
      float rm=__builtin_fmaxf(a,b); { auto rr=__builtin_amdgcn_permlane32_swap(__float_as_uint(rm),__float_as_uint(rm),false,false); rm=__builtin_fmaxf(__uint_as_float(rr[0]),__uint_as_float(rr[1])); } \
      resc=false; \
      if(__builtin_expect(__any(rm>(float)THRL),0)){ const float dl=__builtin_fmaxf(rm,0.f); mhat+=dl; \
        _Pragma("unroll") for(int r=0;r<16;++r){C0[r]-=dl;C1[r]-=dl;} \
        \
        const float f=__builtin_amdgcn_exp2f(-dl); l_reg*=f; if(hi==0)wsf[r32]=f; resc=true; } } \
    SBAR(); \
    GAPB(o[0]=__builtin_amdgcn_mfma_f32_32x32x16_bf16(PAF(0),VFR(0),o[0],0,0,0), C0,0); \
    GAPB(o[1]=__builtin_amdgcn_mfma_f32_32x32x16_bf16(PAF(0),VFR(4),o[1],0,0,0), C0,4); \
    KRD(GL,0); GAPB(o[0]=__builtin_amdgcn_mfma_f32_32x32x16_bf16(PAF(1),VFR(1),o[0],0,0,0), C0,8); \
    KRD(GL,1); GAPB(o[1]=__builtin_amdgcn_mfma_f32_32x32x16_bf16(PAF(1),VFR(5),o[1],0,0,0), C0,12); \
    KRD(GL,2); GAPB(o[0]=__builtin_amdgcn_mfma_f32_32x32x16_bf16(PAF(2),VFR(2),o[0],0,0,0), C1,0); \
    KRD(GL,3); GAPB(o[1]=__builtin_amdgcn_mfma_f32_32x32x16_bf16(PAF(2),VFR(6),o[1],0,0,0), C1,4); \
    GAPB(o[0]=__builtin_amdgcn_mfma_f32_32x32x16_bf16(PAF(3),VFR(3),o[0],0,0,0), C1,8); \
    GAPB(o[1]=__builtin_amdgcn_mfma_f32_32x32x16_bf16(PAF(3),VFR(7),o[1],0,0,0), C1,12); \
    }while(0)
  int t=1;
  #undef CMASK
  #define CMASK(P0,P1,t) do{}while(0)
  for(;t+5<NT;t+=2){
    STEP(pB0,pB1,pA0,pA1,t,true,true,true);     WAIT_BAR(2); RESC(); ROT();
    STEP(pA0,pA1,pB0,pB1,t+1,true,true,true);   WAIT_BAR(2); RESC(); ROT();
  }
  #undef CMASK
  #define CMASK(P0,P1,t) do{int jb_=(t)-(NT-4); if(jb_>=0)cmask(P0,P1,jb_,qrel,hi);}while(0)
  #define ENDW(tt) do{ if((tt)+3<NT){WAIT_BAR(2);} else if((tt)+2<NT){WAIT_BAR(1);} else {WAIT_BAR(0);} }while(0)
  for(;t+1<NT;t+=2){
    STEP(pB0,pB1,pA0,pA1,t,(t+3<NT),(t+1<NT),(t+1<NT));       ENDW(t);   RESC(); ROT();
    STEP(pA0,pA1,pB0,pB1,t+1,(t+4<NT),(t+2<NT),(t+2<NT));     ENDW(t+1); RESC(); ROT();
  }
  STEP(pB0,pB1,pA0,pA1,NT-1,false,false,false); RESC();
  { float sacc=pB0[0]+pB0[1]; _Pragma("unroll") for(int r=2;r<16;++r)sacc+=pB0[r]; _Pragma("unroll") for(int r=0;r<16;++r)sacc+=pB1[r]; l_reg+=sacc;
    pw0=(u32x4){PKW(pB0,0),PKW(pB0,2),PKW(pB0,4),PKW(pB0,6)};pw1=(u32x4){PKW(pB0,8),PKW(pB0,10),PKW(pB0,12),PKW(pB0,14)};pw2=(u32x4){PKW(pB1,0),PKW(pB1,2),PKW(pB1,4),PKW(pB1,6)};pw3=(u32x4){PKW(pB1,8),PKW(pB1,10),PKW(pB1,12),PKW(pB1,14)};
    SBAR(); pv(o,vb0+sl_cur,PAF(0),PAF(1),PAF(2),PAF(3)); }
  #undef PKW
  #undef PAF
  #undef VFR
  #undef PIN
  #undef MX3
  #undef GAPA
  #undef GAPB
  #undef EX
  #undef VRD
  #undef KRD
  #undef STEP
  #undef ENDW
  {auto rr=__builtin_amdgcn_permlane32_swap(__float_as_uint(l_reg),__float_as_uint(l_reg),false,false);l_reg=__uint_as_float(rr[0])+__uint_as_float(rr[1]);}
  if(hi==0)wsf[32+r32]=l_reg;asm volatile("s_waitcnt lgkmcnt(0)":::"memory");
  float rli[16];
  #pragma unroll
  for(int r=0;r<16;++r)rli[r]=__builtin_amdgcn_rcpf(wsf[32+crow(r,hi)]);
  bf16*Ow=O+(rowbase+q0+wid*QBLK)*PO+h*D;
  { bf16*stg=(bf16*)(shm+LDS_OST)+wid*2048;
    #pragma unroll
    for(int r=0;r<16;++r){const int orow=crow(r,hi);
      #pragma unroll
      for(int d0=0;d0<2;++d0)stg[orow*64+d0*32+r32]=__float2bfloat16(o[d0][r]*rli[r]);}
    asm volatile("s_waitcnt lgkmcnt(0)":::"memory");
    int l2; asm volatile("v_mbcnt_lo_u32_b32 %0, -1, 0\n\tv_mbcnt_hi_u32_b32 %0, -1, %0":"=v"(l2));
    #pragma unroll
    for(int i=0;i<4;++i){const int row=i*8+(l2>>3),ch=l2&7; const u32x4 v=*(const u32x4*)(stg+row*64+ch*8); ATTN_STORE16(Ow+(long)row*PO+ch*8,v);
      float ss=0.f;
      #pragma unroll
      for(int j=0;j<4;++j){const float a=__uint_as_float(v[j]<<16),c=__uint_as_float(v[j]&0xffff0000u);ss+=a*a+c*c;}
      ss+=__shfl_xor(ss,1);ss+=__shfl_xor(ss,2);ss+=__shfl_xor(ss,4);
      if(ch==0)ssqa[(rowbase+q0+wid*QBLK+row)*8+h]=ss;} }
  asm volatile("s_waitcnt lgkmcnt(0)\n\ts_barrier":::"memory");
  #undef DMA_K
  #undef DMA_V
  #undef MMASK
  #undef CMASK
  #undef START
  #undef RESC
  #undef ROT
}
constexpr int ATTN_LDS_BYTES=LDS_BYTES;
#undef SBAR
#undef WAIT_BAR
}


namespace p5 {
constexpr int KLD = 136, SLD = 264;
constexpr int OFF_KL = 0, OFF_S = 2 * 128 * KLD * 2, OFF_REC = OFF_S + 64 * SLD * 4, LDS_NEED = OFF_REC + 64 * 2 * 16 * 4;
static_assert(LDS_NEED <= SCR_BYTES && OFF_S % 16 == 0, "P5 LDS map");

DI unsigned mkkey(float s, unsigned low, unsigned lowmask) { unsigned u = __float_as_uint(s); u ^= (unsigned)((int)u >> 31) | 0x80000000u; return (u & ~lowmask) | low; }
DI float keyval(unsigned key, unsigned lowmask) { unsigned u = (key & ~lowmask) | ((lowmask + 1u) >> 1); return (u & 0x80000000u) ? __uint_as_float(u & 0x7fffffffu) : __uint_as_float(~u); }
DI unsigned umax(unsigned a, unsigned b) { return a > b ? a : b; }
DI unsigned umin(unsigned a, unsigned b) { return a < b ? a : b; }
template <int N> DI void sort_desc(unsigned (&a)[N]) {
#pragma unroll
    for (int k = 2; k <= N; k <<= 1)
#pragma unroll
        for (int j = k >> 1; j > 0; j >>= 1)
#pragma unroll
            for (int i = 0; i < N; ++i) { const int l = i ^ j; if (l > i) { const unsigned x = a[i], y = a[l], mx = umax(x, y), mn = umin(x, y); const bool desc = ((i & k) == 0); a[i] = desc ? mx : mn; a[l] = desc ? mn : mx; } }
}
template <int N> DI void merge_desc(unsigned (&a)[N]) {
#pragma unroll
    for (int j = N >> 1; j > 0; j >>= 1)
#pragma unroll
        for (int i = 0; i < N; ++i) { const int l = i ^ j; if (l > i) { const unsigned x = a[i], y = a[l]; a[i] = umax(x, y); a[l] = umin(x, y); } }
}
template <int XR> DI unsigned dppx(unsigned v) { return (unsigned)__builtin_amdgcn_update_dpp(0, (int)v, XR == 1 ? 0xB1 : XR == 2 ? 0x4E : 0x141, 0xF, 0xF, false); }
template <int XR> DI void xmerge16(unsigned (&a)[16]) {
    unsigned p[16];
#pragma unroll
    for (int i = 0; i < 16; ++i) p[i] = dppx<XR>(a[i]);
#pragma unroll
    for (int i = 0; i < 16; ++i) a[i] = umax(a[i], p[15 - i]);
    merge_desc<16>(a);
}

constexpr int SLD2 = 260;
constexpr int OFF_S2 = 0, OFF_REC2 = 128 * SLD2 * 4, LDS_NEED2 = OFF_REC2 + 128 * 2 * 16 * 4;
static_assert(LDS_NEED2 <= SCR_BYTES && OFF_REC2 % 16 == 0, "P5 LDS map (128-row chunks)");
DI int spos(int c) { return (c >> 7) * 130 + ((c >> 6) & 1) * 65 + (c & 63); }
struct KeyFrags { bf16x8 b[4][2]; };
DI void load_keys(KeyFrags& kf, const bf16_t* K1b, const bf16_t* K2b, int h, int lane, int w) {
    const bf16_t* base = ((w >> 2) ? K2b : K1b) + (size_t)(h * 128 + 32 * (w & 3) + (lane & 15)) * 128 + 8 * (lane >> 4);
#pragma unroll
    for (int ks = 0; ks < 4; ++ks)
#pragma unroll
        for (int nt = 0; nt < 2; ++nt) kf.b[ks][nt] = *(const bf16x8*)(base + (size_t)(16 * nt) * 128 + 32 * ks);
}
DI void top16(unsigned (&a)[16], const unsigned (&b)[16]) {
#pragma unroll
    for (int i = 0; i < 16; ++i) a[i] = umax(a[i], b[15 - i]);
    merge_desc<16>(a);
}
#define P5_LBAR() do { asm volatile("s_waitcnt lgkmcnt(0)" ::: "memory"); __builtin_amdgcn_s_barrier(); asm volatile("" ::: "memory"); } while (0)
DI void chunk128(const Frame& F, int r0, int h, const bf16_t* qry, const float* ssqx, int* eidt, float* gate, const KeyFrags& kf, const float* csrc, unsigned char* cdst, size_t citem0, float csc, const float* ccolg) {
    int tid; asm volatile("v_mov_b32 %0, %1" : "=v"(tid) : "v"(F.tid));
    const int lane = F.lane, w = F.wave;
    LAS float* S = (LAS float*)(F.lds + OFF_S2); LAS unsigned* REC = (LAS unsigned*)(F.lds + OFF_REC2);
    {
        const int half = w >> 2, n0 = 32 * (w & 3), fr = lane & 15, fq = lane >> 4;
#pragma unroll
        for (int mh = 0; mh < 2; ++mh) {
            f32x4 acc[4][2];
#pragma unroll
            for (int m = 0; m < 4; ++m) { acc[m][0] = (f32x4){0.f, 0.f, 0.f, 0.f}; acc[m][1] = (f32x4){0.f, 0.f, 0.f, 0.f}; }
            const bf16_t* qp = qry + (size_t)(r0 + 64 * mh + fr) * 2048 + h * 256 + half * 128 + 8 * fq;
#pragma unroll
            for (int ks = 0; ks < 4; ++ks)
#pragma unroll
                for (int m = 0; m < 4; ++m) { const bf16x8 a = *(const bf16x8*)(qp + (size_t)(16 * m) * 2048 + 32 * ks);
#pragma unroll
                    for (int nt = 0; nt < 2; ++nt) acc[m][nt] = __builtin_amdgcn_mfma_f32_16x16x32_bf16(a, kf.b[ks][nt], acc[m][nt], 0, 0, 0); }
#pragma unroll
            for (int m = 0; m < 4; ++m)
#pragma unroll
                for (int nt = 0; nt < 2; ++nt) { const int pos = spos(half * 128 + n0 + 16 * nt + fr);
#pragma unroll
                    for (int r = 0; r < 4; ++r) S[(64 * mh + 16 * m + 4 * fq + r) * SLD2 + pos] = acc[m][nt][r]; }
        }
    }
    P5_LBAR();
    CvtRegs<4> cvr; cvt8_load<4>(cvr, csrc, citem0, lane);
    const int row = tid >> 2, half = (tid >> 1) & 1, q2 = tid & 1, j4 = tid & 3;
    f32x4 sq0, sq1, sq2, sq3; { const f32x4* sp = (const f32x4*)(ssqx + (size_t)(r0 + row) * 16); sq0 = sp[0]; sq1 = sp[1]; sq2 = sp[2]; sq3 = sp[3]; }
    unsigned a[16];
    {
        unsigned b[16], c[16], d[16];
        const LAS float* sp = S + row * SLD2 + half * 130 + q2 * 65;
#pragma unroll
        for (int i = 0; i < 16; ++i) { a[i] = mkkey(sp[i], 127u - (unsigned)(64 * q2 + i), 127u); b[i] = mkkey(sp[16 + i], 127u - (unsigned)(64 * q2 + 16 + i), 127u);
            c[i] = mkkey(sp[32 + i], 127u - (unsigned)(64 * q2 + 32 + i), 127u); d[i] = mkkey(sp[48 + i], 127u - (unsigned)(64 * q2 + 48 + i), 127u); }
        sort_desc<16>(a); sort_desc<16>(b); top16(a, b);
        sort_desc<16>(c); sort_desc<16>(d); top16(c, d);
        top16(a, c);
    }
    xmerge16<1>(a);
    if (q2 == 0) {
#pragma unroll
        for (int i = 0; i < 16; ++i) REC[(row * 2 + half) * 16 + i] = a[i];
    }
    cvt8_store<4>(cvr, cdst, citem0, lane, csc, ccolg);
    cvt8_load<4>(cvr, csrc, citem0 + 4, lane);
    asm volatile("s_waitcnt lgkmcnt(0)" ::: "memory");
    unsigned t16[16];
#pragma unroll
    for (int e = 0; e < 16; ++e) {
        const int c = 16 * j4 + e; int ci = 0, st = 0;
        if (c >= 16) { ci = 1; st = 16; } if (c >= 24) { ci = 2; st = 24; } if (c >= 29) { ci = 3; st = 29; } if (c >= 33) { ci = 4; st = 33; }
        if (c >= 36) { ci = 5; st = 36; } if (c >= 38) { ci = 6; st = 38; } if (c >= 40) { ci = 7; st = 40; } if (c >= 42) { ci = 8 + (c - 42); st = c; }
        const int cj = c - st;
        unsigned key = 0u;
        if (c < 50) { const float v = keyval(REC[(row * 2) * 16 + ci], 127u) + keyval(REC[(row * 2 + 1) * 16 + cj], 127u); key = mkkey(v, (unsigned)((ci << 4) | cj), 255u); }
        t16[e] = key;
    }
    sort_desc<16>(t16);
    xmerge16<1>(t16); xmerge16<2>(t16);
    unsigned kk[4];
#pragma unroll
    for (int e = 0; e < 4; ++e) kk[e] = (j4 == 0) ? t16[e] : (j4 == 1) ? t16[4 + e] : (j4 == 2) ? t16[8 + e] : t16[12 + e];
    const float ssq = ((sq0[0] + sq0[1]) + (sq0[2] + sq0[3])) + ((sq1[0] + sq1[1]) + (sq1[2] + sq1[3])) + ((sq2[0] + sq2[1]) + (sq2[2] + sq2[3])) + ((sq3[0] + sq3[1]) + (sq3[2] + sq3[3]));
    const float rstd = 1.0f / sqrtf(ssq * (1.f / DM) + EPS);
    const float vmax = keyval(t16[0], 255u);
    float ev[4]; float es = 0.f;
#pragma unroll
    for (int e = 0; e < 4; ++e) { ev[e] = __expf(rstd * (keyval(kk[e], 255u) - vmax)); es += ev[e]; }
    es += __uint_as_float(dppx<1>(__float_as_uint(es))); es += __uint_as_float(dppx<2>(__float_as_uint(es)));
    const float inv = 1.0f / es;
    int* et = eidt + (size_t)(r0 + row) * 128 + (4 * (j4 & 1)) * 16 + 2 * h + (j4 >> 1);
#pragma unroll
    for (int e = 0; e < 4; ++e) { const unsigned cd = kk[e] & 255u;
        et[16 * e] = (int)(127u - (REC[(row * 2) * 16 + (cd >> 4)] & 127u)) * 128 + (int)(127u - (REC[(row * 2 + 1) * 16 + (cd & 15u)] & 127u)); }
    *(f32x4*)(gate + (size_t)(r0 + row) * 128 + h * 16 + 4 * j4) = (f32x4){ev[0] * inv, ev[1] * inv, ev[2] * inv, ev[3] * inv};
    cvt8_store<4>(cvr, cdst, citem0 + 4, lane, csc, ccolg);
    P5_LBAR();
}
}

namespace p5w {
using p5::mkkey; using p5::keyval; using p5::umax; using p5::umin; using p5::sort_desc; using p5::merge_desc; using p5::top16;
constexpr int KPITCH = 272, KHALF = 128 * KPITCH, OFF_REC = 2 * KHALF, REC_WAVE = 32 * 33 * 4;
static_assert(OFF_REC + NWAVES * REC_WAVE <= SCR_BYTES && KHALF % 16 == 0, "P5 (wave-owned rows) LDS map");
DI void keys_to_lds(LAS unsigned char* lds, const bf16_t* K1b, const bf16_t* K2b, int h, int tid_) {
    int tid; asm volatile("v_mov_b32 %0, %1" : "=v"(tid) : "v"(tid_));
    u32x4 v[8];
#pragma unroll
    for (int i = 0; i < 8; ++i) { const int id = tid + 512 * (i & 3); const int row = id >> 4, c = id & 15;
        v[i] = *(const u32x4*)(((i >> 2) ? K2b : K1b) + (size_t)(h * 128 + row) * 128 + 8 * c); }
#pragma unroll
    for (int i = 0; i < 8; ++i) { const int id = tid + 512 * (i & 3); const int row = id >> 4, c = id & 15;
        *(LAS u32x4*)(lds + (i >> 2) * KHALF + row * KPITCH + 16 * c) = v[i]; }
}
DI void sort16_desc(unsigned (&a)[16]) {
#define P5W_CE(i, j) do { const unsigned x_ = a[i], y_ = a[j]; a[i] = umax(x_, y_); a[j] = umin(x_, y_); } while (0)
    P5W_CE(0, 13); P5W_CE(1, 12); P5W_CE(2, 15); P5W_CE(3, 14); P5W_CE(4, 8); P5W_CE(5, 6); P5W_CE(7, 11); P5W_CE(9, 10);
    P5W_CE(0, 5); P5W_CE(1, 7); P5W_CE(2, 9); P5W_CE(3, 4); P5W_CE(6, 13); P5W_CE(8, 14); P5W_CE(10, 15); P5W_CE(11, 12);
    P5W_CE(0, 1); P5W_CE(2, 3); P5W_CE(4, 5); P5W_CE(6, 8); P5W_CE(7, 9); P5W_CE(10, 11); P5W_CE(12, 13); P5W_CE(14, 15);
    P5W_CE(0, 2); P5W_CE(1, 3); P5W_CE(4, 10); P5W_CE(5, 11); P5W_CE(6, 7); P5W_CE(8, 9); P5W_CE(12, 14); P5W_CE(13, 15);
    P5W_CE(1, 2); P5W_CE(3, 12); P5W_CE(4, 6); P5W_CE(5, 7); P5W_CE(8, 10); P5W_CE(9, 11); P5W_CE(13, 14);
    P5W_CE(1, 4); P5W_CE(2, 6); P5W_CE(5, 8); P5W_CE(7, 10); P5W_CE(9, 13); P5W_CE(11, 14);
    P5W_CE(2, 4); P5W_CE(3, 6); P5W_CE(9, 12); P5W_CE(11, 13);
    P5W_CE(3, 5); P5W_CE(6, 8); P5W_CE(7, 9); P5W_CE(10, 12);
    P5W_CE(3, 4); P5W_CE(5, 6); P5W_CE(7, 8); P5W_CE(9, 10); P5W_CE(11, 12);
    P5W_CE(6, 7); P5W_CE(8, 9);
#undef P5W_CE
}
DI void sort10_desc(unsigned (&a)[16]) {
#define P5W_CE(i, j) do { const unsigned x_ = a[i], y_ = a[j]; a[i] = umax(x_, y_); a[j] = umin(x_, y_); } while (0)
    P5W_CE(0, 8); P5W_CE(1, 9); P5W_CE(2, 7); P5W_CE(3, 5); P5W_CE(4, 6);
    P5W_CE(0, 2); P5W_CE(1, 4); P5W_CE(5, 8); P5W_CE(7, 9);
    P5W_CE(0, 3); P5W_CE(2, 4); P5W_CE(5, 7); P5W_CE(6, 9);
    P5W_CE(0, 1); P5W_CE(3, 6); P5W_CE(8, 9);
    P5W_CE(1, 5); P5W_CE(2, 3); P5W_CE(4, 8); P5W_CE(6, 7);
    P5W_CE(1, 2); P5W_CE(3, 5); P5W_CE(4, 6); P5W_CE(7, 8);
    P5W_CE(2, 3); P5W_CE(4, 5); P5W_CE(6, 7);
    P5W_CE(3, 4); P5W_CE(5, 6);
#undef P5W_CE
}
DI unsigned bperm(int addr, unsigned v) { return (unsigned)__builtin_amdgcn_ds_bpermute(addr, (int)v); }
DI void xmerge32(unsigned (&a)[16], int paddr) {
    unsigned p[16];
#pragma unroll
    for (int i = 0; i < 16; ++i) p[i] = bperm(paddr, a[i]);
#pragma unroll
    for (int i = 0; i < 16; ++i) a[i] = umax(a[i], p[15 - i]);
    merge_desc<16>(a);
}
template <class Hook> DI void half_a(unsigned (&k0)[16], unsigned (&k2)[16], unsigned (&k3)[16], const bf16x8 (&bq)[8], const LAS unsigned char* kl, int p4, const Hook& after_first_step) {
    f32x16 acc[4];
#pragma unroll
    for (int mt = 0; mt < 4; ++mt)
#pragma unroll
        for (int r = 0; r < 16; ++r) acc[mt][r] = 0.f;
    bf16x8 ka[2][4];
#pragma unroll
    for (int mt = 0; mt < 4; ++mt) ka[0][mt] = *(const LAS bf16x8*)(kl + (32 * mt) * KPITCH);
#pragma unroll
    for (int ks = 0; ks < 8; ++ks) {
        if (ks < 7) {
#pragma unroll
            for (int mt = 0; mt < 4; ++mt) ka[(ks + 1) & 1][mt] = *(const LAS bf16x8*)(kl + (32 * mt) * KPITCH + 32 * (ks + 1));
        }
#pragma unroll
        for (int mt = 0; mt < 4; ++mt) acc[mt] = __builtin_amdgcn_mfma_f32_32x32x16_bf16(ka[ks & 1][mt], bq[ks], acc[mt], 0, 0, 0);
        __builtin_amdgcn_sched_barrier(0);
        if (ks == 0) { after_first_step(); __builtin_amdgcn_sched_barrier(0); }
    }
    unsigned k1[16];
    unsigned pb; asm volatile("v_xor_b32 %0, 4, %1" : "=v"(pb) : "v"(p4));
#pragma unroll
    for (int r = 0; r < 16; ++r) { const unsigned c = (unsigned)(123 - ((r & 3) + 8 * (r >> 2)));
        k0[r] = mkkey(acc[0][r], pb, 127u) | c; k1[r] = mkkey(acc[1][r], pb, 127u) | (c - 32u); k2[r] = mkkey(acc[2][r], pb, 127u) | (c - 64u); k3[r] = mkkey(acc[3][r], pb, 127u) | (c - 96u); }
    sort16_desc(k0); sort16_desc(k1); top16(k0, k1);
}
DI void half_b(unsigned (&k0)[16], unsigned (&k2)[16], unsigned (&k3)[16], int paddr) {
    sort16_desc(k2); sort16_desc(k3); top16(k2, k3);
    top16(k0, k2);
    xmerge32(k0, paddr);
}
#define P5W_SEG() do { asm volatile("" ::: "memory"); __builtin_amdgcn_sched_barrier(0); } while (0)
DI void unit_rows32(LAS unsigned char* lds, int lane_, int wave, int r0, int h, const bf16_t* qry, const float* ssqx, int* eidt, float* gate,
                    const float* csrc, unsigned char* cdst, size_t citem0, float csc, const float* ccolg) {
    int lane; asm volatile("v_mbcnt_lo_u32_b32 %0, -1, 0\n\tv_mbcnt_hi_u32_b32 %0, -1, %0" : "=v"(lane)); (void)lane_;
    const int qrow = lane & 31, p = lane >> 5, paddr = (lane ^ 32) << 2;
    const bool hi = p != 0;
    const int row = r0 + qrow;
    float rstd;
    { const f32x4* sp = (const f32x4*)(ssqx + (size_t)row * 16); const f32x4 sq0 = sp[0], sq1 = sp[1], sq2 = sp[2], sq3 = sp[3];
      const float ssq = ((sq0[0] + sq0[1]) + (sq0[2] + sq0[3])) + ((sq1[0] + sq1[1]) + (sq1[2] + sq1[3])) + ((sq2[0] + sq2[1]) + (sq2[2] + sq2[3])) + ((sq3[0] + sq3[1]) + (sq3[2] + sq3[3]));
      rstd = 1.0f / sqrtf(ssq * (1.f / DM) + EPS); }
    const bf16_t* qp = qry + (size_t)row * 2048 + h * 256 + 8 * p;
    const LAS unsigned char* kl = lds + qrow * KPITCH + 16 * p;
    unsigned a0[16], a1[16];
    CvtRegs<3> cv3;
    {
        bf16x8 bq[8];
#pragma unroll
        for (int ks = 0; ks < 8; ++ks) bq[ks] = *(const bf16x8*)(qp + 16 * ks);
        unsigned k2[16], k3[16];
        half_a(a0, k2, k3, bq, kl, 4 * p, [&]() { cvt8_load<3>(cv3, csrc, citem0, lane); });
        P5W_SEG();
        cvt8_store<3>(cv3, cdst, citem0, lane, csc, ccolg);
#pragma unroll
        for (int ks = 0; ks < 8; ++ks) bq[ks] = *(const bf16x8*)(qp + 128 + 16 * ks);
        cvt8_load<3>(cv3, csrc, citem0 + 3, lane);
        P5W_SEG();
        half_b(a0, k2, k3, paddr);
        P5W_SEG();
        cvt8_store<3>(cv3, cdst, citem0 + 3, lane, csc, ccolg);
        P5W_SEG();
        half_a(a1, k2, k3, bq, kl + KHALF, 4 * p, [&]() { cvt8_load<3>(cv3, csrc, citem0 + 6, lane); });
        P5W_SEG();
        cvt8_store<3>(cv3, cdst, citem0 + 6, lane, csc, ccolg);
        cvt8_load<3>(cv3, csrc, citem0 + 9, lane);
        P5W_SEG();
        half_b(a1, k2, k3, paddr);
        P5W_SEG();
        cvt8_store<3>(cv3, cdst, citem0 + 9, lane, csc, ccolg);
    }
    CvtRegs<4> cv4; cvt8_load<4>(cv4, csrc, citem0 + 12, lane);
    P5W_SEG();
    LAS unsigned* REC = (LAS unsigned*)(lds + OFF_REC + wave * REC_WAVE) + qrow * 33;
    if (!hi) {
#pragma unroll
        for (int i = 0; i < 16; ++i) REC[i] = a0[i];
    } else {
#pragma unroll
        for (int i = 0; i < 16; ++i) REC[16 + i] = a1[i];
    }
    float f0[16], f1[16];
#pragma unroll
    for (int i = 0; i < 16; ++i) { f0[i] = keyval(a0[i], 127u); f1[i] = keyval(a1[i], 127u); }
    float g1[8]; unsigned cp[8];
#pragma unroll
    for (int k = 0; k < 8; ++k) { g1[k] = hi ? f1[2 * k + 1] : f1[2 * k]; cp[k] = (unsigned)(2 * k) | (unsigned)p; }
    unsigned t[16], u[16];
#pragma unroll
    for (int k = 0; k < 8; ++k) t[k] = mkkey(f0[0] + g1[k], cp[k], 255u);
#pragma unroll
    for (int k = 0; k < 4; ++k) t[8 + k] = mkkey(f0[1] + g1[k], 16u | cp[k], 255u);
    t[12] = mkkey(f0[2] + g1[0], 32u | cp[0], 255u); t[13] = mkkey(f0[2] + g1[1], 32u | cp[1], 255u);
    { const unsigned kx = mkkey(f0[2] + f1[4], 32u | 4u, 255u); t[14] = hi ? 0u : kx; }
    t[15] = mkkey(f0[3] + g1[0], 48u | cp[0], 255u); u[0] = mkkey(f0[3] + g1[1], 48u | cp[1], 255u);
    u[1] = mkkey(f0[4] + g1[0], 64u | cp[0], 255u);
    { const unsigned kx = mkkey(f0[4] + f1[2], 64u | 2u, 255u); u[2] = hi ? 0u : kx; }
    u[3] = mkkey(f0[5] + g1[0], 80u | cp[0], 255u); u[4] = mkkey(f0[6] + g1[0], 96u | cp[0], 255u); u[5] = mkkey(f0[7] + g1[0], 112u | cp[0], 255u);
#pragma unroll
    for (int k = 0; k < 4; ++k) { const float fv = hi ? f0[12 + k] : f0[8 + k]; u[6 + k] = mkkey(fv + f1[0], ((unsigned)(8 + k + 4 * p) << 4), 255u); }
    sort16_desc(t); sort10_desc(u);
#pragma unroll
    for (int k = 10; k < 16; ++k) u[k] = 0u;
    top16(t, u);
    xmerge32(t, paddr);
    P5W_SEG();
    cvt8_store<4>(cv4, cdst, citem0 + 12, lane, csc, ccolg);
    unsigned kk[8];
#pragma unroll
    for (int e = 0; e < 8; ++e) kk[e] = hi ? t[8 + e] : t[e];
    const float vmax = keyval(t[0], 255u);
    float ev[8]; float es = 0.f;
#pragma unroll
    for (int e = 0; e < 8; ++e) { ev[e] = __expf(rstd * (keyval(kk[e], 255u) - vmax)); es += ev[e]; }
    es += __uint_as_float(bperm(paddr, __float_as_uint(es)));
    const float inv = 1.0f / es;
    asm volatile("s_waitcnt lgkmcnt(0)" ::: "memory");
    int* et = eidt + (size_t)row * 128 + 2 * h + p;
#pragma unroll
    for (int e = 0; e < 8; ++e) { const unsigned cd = kk[e] & 255u;
        et[16 * e] = (int)(127u - (REC[cd >> 4] & 127u)) * 128 + (int)(127u - (REC[16 + (cd & 15u)] & 127u)); }
    float* gp = gate + (size_t)row * 128 + h * 16 + 8 * p;
    *(f32x4*)gp = (f32x4){ev[0] * inv, ev[1] * inv, ev[2] * inv, ev[3] * inv};
    *(f32x4*)(gp + 4) = (f32x4){ev[4] * inv, ev[5] * inv, ev[6] * inv, ev[7] * inv};
}
}

namespace p6 {
constexpr float SC_DOWN = 64.0f, SC_UP = 4.0f;
constexpr size_t SLICE = (size_t)NEXP * 128;
DI float gelu_erf(float v) { return 0.5f * v * (1.0f + erff(v * 0.70710678118654752f)); }
DI f32x2_t up8(unsigned w, bool hi) { return hi ? __builtin_amdgcn_cvt_pk_f32_fp8(w, true) : __builtin_amdgcn_cvt_pk_f32_fp8(w, false); }
DI float dot16(const u32x4 v, const f32x2_t (&x)[8]) {
    f32x2_t a = up8(v.x, false) * x[0];
    a = up8(v.x, true) * x[1] + a; a = up8(v.y, false) * x[2] + a; a = up8(v.y, true) * x[3] + a;
    a = up8(v.z, false) * x[4] + a; a = up8(v.z, true) * x[5] + a; a = up8(v.w, false) * x[6] + a; a = up8(v.w, true) * x[7] + a;
    return a.x + a.y;
}
DI void axpy16(f32x2_t (&o)[8], const u32x4 v, float c) {
    o[0] = up8(v.x, false) * c + o[0]; o[1] = up8(v.x, true) * c + o[1]; o[2] = up8(v.y, false) * c + o[2]; o[3] = up8(v.y, true) * c + o[3];
    o[4] = up8(v.z, false) * c + o[4]; o[5] = up8(v.z, true) * c + o[5]; o[6] = up8(v.w, false) * c + o[6]; o[7] = up8(v.w, true) * c + o[7];
}
template <int CTRL> DI float dppf(float v) { return __int_as_float(__builtin_amdgcn_update_dpp(0, __float_as_int(v), CTRL, 0xF, 0xF, false)); }
DI float grp8_sum(float v) { v += dppf<0xB1>(v); v += dppf<0x4E>(v); v += dppf<0x141>(v); return v; }
template <int S> DI int bcast8(int v) { return __builtin_amdgcn_ds_swizzle(v, (S << 5) | 0x18); }
template <int S> DI float bcast8f(float v) { return __int_as_float(__builtin_amdgcn_ds_swizzle(__float_as_int(v), (S << 5) | 0x18)); }
DI float row_rstd(const float* ssqx, int t) {
    const f32x4* sp = (const f32x4*)(ssqx + (size_t)t * 16); const f32x4 s0 = sp[0], s1 = sp[1], s2 = sp[2], s3 = sp[3];
    const float ssq = ((s0[0] + s0[1]) + (s0[2] + s0[3])) + ((s1[0] + s1[1]) + (s1[2] + s1[3])) + ((s2[0] + s2[1]) + (s2[2] + s2[3])) + ((s3[0] + s3[1]) + (s3[2] + s3[3]));
    return 1.0f / sqrtf(ssq * (1.f / DM) + EPS);
}

typedef int v2i_t __attribute__((ext_vector_type(2)));
DI long mk64(unsigned lo, unsigned hi) { return (long)(((unsigned long long)hi << 32) | (unsigned long long)lo); }
typedef int i32x4 __attribute__((ext_vector_type(4)));
struct Ids { i32x4 e0, e1, e2, e3; };
DI Ids ids_lds(const LAS unsigned char* slot, int lane) { Ids d; const LAS i32x4* ep = (const LAS i32x4*)(slot + (lane >> 3) * 64); d.e0 = ep[0]; d.e1 = ep[1]; d.e2 = ep[2]; d.e3 = ep[3]; return d; }
template <int I> DI int id_of(const Ids& d) { return I == 0 ? d.e0.x : I == 1 ? d.e0.y : I == 2 ? d.e0.z : I == 3 ? d.e0.w : I == 4 ? d.e1.x : I == 5 ? d.e1.y : I == 6 ? d.e1.z : I == 7 ? d.e1.w :
                                                   I == 8 ? d.e2.x : I == 9 ? d.e2.y : I == 10 ? d.e2.z : I == 11 ? d.e2.w : I == 12 ? d.e3.x : I == 13 ? d.e3.y : I == 14 ? d.e3.z : d.e3.w; }
template <int I> DI void dma1(LAS unsigned char* img, const unsigned char* slice, const Ids& d, int lane) {
    __builtin_amdgcn_global_load_lds((const unsigned*)(slice + (size_t)id_of<I>(d) * 128 + 16 * ((lane & 7) ^ (lane >> 3))), (LAS unsigned*)(img + I * 1024), 16, 0, 0);
}
DI void dma_all(LAS unsigned char* img, const unsigned char* slice, const Ids& d, int lane) {
    dma1<0>(img, slice, d, lane); dma1<1>(img, slice, d, lane); dma1<2>(img, slice, d, lane); dma1<3>(img, slice, d, lane); dma1<4>(img, slice, d, lane); dma1<5>(img, slice, d, lane); dma1<6>(img, slice, d, lane); dma1<7>(img, slice, d, lane);
    dma1<8>(img, slice, d, lane); dma1<9>(img, slice, d, lane); dma1<10>(img, slice, d, lane); dma1<11>(img, slice, d, lane); dma1<12>(img, slice, d, lane); dma1<13>(img, slice, d, lane); dma1<14>(img, slice, d, lane); dma1<15>(img, slice, d, lane);
}
DI void smalls_dma(LAS unsigned char* slot, const int* eidt, int t, const unsigned char* ahi, const unsigned char* alo, int lane_) {
    int lane; asm volatile("v_mov_b32 %0, %1" : "=v"(lane) : "v"(lane_));
    const unsigned char* src = (lane < 32) ? (const unsigned char*)(eidt + (size_t)t * 128) + 16 * lane : (lane < 40) ? ahi + 16 * (lane - 32) : (lane < 48) ? alo + 16 * (lane - 40) : ahi + 16 * (lane & 7);
    __builtin_amdgcn_global_load_lds((const unsigned*)src, (LAS unsigned*)slot, 16, 0, 0);
}
DI void split8(float v0, float v1, float v2, float v3, unsigned& hi, unsigned& lo) {
    int h = 0; h = __builtin_amdgcn_cvt_pk_fp8_f32(v0, v1, h, false); h = __builtin_amdgcn_cvt_pk_fp8_f32(v2, v3, h, true);
    const f32x2_t b01 = __builtin_amdgcn_cvt_pk_f32_fp8(h, false), b23 = __builtin_amdgcn_cvt_pk_f32_fp8(h, true);
    int l = 0; l = __builtin_amdgcn_cvt_pk_fp8_f32((v0 - b01.x) * 16.0f, (v1 - b01.y) * 16.0f, l, false); l = __builtin_amdgcn_cvt_pk_fp8_f32((v2 - b23.x) * 16.0f, (v3 - b23.y) * 16.0f, l, true);
    hi = (unsigned)h; lo = (unsigned)l;
}
#define P6_WAITV(N) asm volatile("s_waitcnt vmcnt(" #N ")" ::: "memory")
#define P6_WAITL() asm volatile("s_waitcnt lgkmcnt(0)" ::: "memory")
DI void xq_token(int t, int lane, const bf16_t* x1b, unsigned char* xqh, unsigned char* xql) {
    const u32x4* xp = (const u32x4*)(x1b + (size_t)t * DM + 16 * lane); const u32x4 w0 = xp[0], w1 = xp[1];
    unsigned h0, h1, h2, h3, l0, l1, l2, l3;
    split8(bflo(w0.x), bfhi(w0.x), bflo(w0.y), bfhi(w0.y), h0, l0); split8(bflo(w0.z), bfhi(w0.z), bflo(w0.w), bfhi(w0.w), h1, l1);
    split8(bflo(w1.x), bfhi(w1.x), bflo(w1.y), bfhi(w1.y), h2, l2); split8(bflo(w1.z), bfhi(w1.z), bflo(w1.w), bfhi(w1.w), h3, l3);
    const u32x4 h = (u32x4){h0, h1, h2, h3}, l = (u32x4){l0, l1, l2, l3};
    st16_wt(xqh + (size_t)t * DM + 16 * lane, h); st16_wt(xql + (size_t)t * DM + 16 * lane, l);
}
DI void down_run(int j, int lw, int nlw, int lane, LAS unsigned char* img, LAS unsigned char* sm, LAS unsigned char* rs, const int* eidt, const unsigned char* xqh, const unsigned char* xql, const unsigned char* EDs, bf16_t* part) {
    if (lw >= M_TOK) return;
    const int n = lane & 15, kq = lane >> 4, key = n & 7;
    const int cnt = (M_TOK - 1 - lw) / nlw + 1, tl = lw + (cnt - 1) * nlw;
#define P6_TOK(i) ((lw + (i) * nlw <= tl) ? lw + (i) * nlw : tl)
#define P6_SM(t, slot) smalls_dma(slot, eidt, (t), xqh + (size_t)(t) * DM + 128 * j, xql + (size_t)(t) * DM + 128 * j, lane)
    P6_SM(P6_TOK(0), sm); P6_SM(P6_TOK(1), sm + 1024);
    P6_WAITV(0);
    Ids idn = ids_lds(sm, lane);
    P6_WAITL();
    dma_all(img, EDs, idn, lane);
    for (int i = 0; i < cnt; ++i) {
        const int t = lw + i * nlw;
        LAS unsigned char* cur = sm + (i & 1) * 1024; LAS unsigned char* nxs = sm + ((i + 1) & 1) * 1024;
        long a[4];
        { u32x4 a01 = (u32x4){0u, 0u, 0u, 0u}, a23 = (u32x4){0u, 0u, 0u, 0u};
          if (n < 2) { a01 = *(const LAS u32x4*)(cur + 512 + 128 * n + 32 * kq); a23 = *(const LAS u32x4*)(cur + 512 + 128 * n + 32 * kq + 16); }
          P6_WAITL();
          a[0] = mk64(a01.x, a01.y); a[1] = mk64(a01.z, a01.w); a[2] = mk64(a23.x, a23.y); a[3] = mk64(a23.z, a23.w); }
        { const int t2 = P6_TOK(i + 2); P6_SM(t2, cur); }
        float r[8];
#define P6_GRP(GI) { P6_WAITV(14); \
            const LAS unsigned char* row = img + (16 * (GI) + n) * 128; \
            const u32x4 b01 = *(const LAS u32x4*)(row + 16 * ((2 * kq) ^ key)), b23 = *(const LAS u32x4*)(row + 16 * ((2 * kq + 1) ^ key)); \
            if ((GI) == 0) idn = ids_lds(nxs, lane); \
            P6_WAITL(); \
            dma1<2 * (GI)>(img, EDs, idn, lane); dma1<2 * (GI) + 1>(img, EDs, idn, lane);     \
            f32x4 acc = (f32x4){0.f, 0.f, 0.f, 0.f}; \
            acc = __builtin_amdgcn_mfma_f32_16x16x32_fp8_fp8(a[0], mk64(b01.x, b01.y), acc, 0, 0, 0); \
            acc = __builtin_amdgcn_mfma_f32_16x16x32_fp8_fp8(a[1], mk64(b01.z, b01.w), acc, 0, 0, 0); \
            acc = __builtin_amdgcn_mfma_f32_16x16x32_fp8_fp8(a[2], mk64(b23.x, b23.y), acc, 0, 0, 0); \
            acc = __builtin_amdgcn_mfma_f32_16x16x32_fp8_fp8(a[3], mk64(b23.z, b23.w), acc, 0, 0, 0); \
            r[GI] = acc[0] + acc[1] * (1.0f / 16.0f); }
        P6_GRP(0) P6_GRP(1) P6_GRP(2) P6_GRP(3) P6_GRP(4) P6_GRP(5) P6_GRP(6) P6_GRP(7)
#undef P6_GRP
        if (lane < 16) {
#pragma unroll
            for (int gi = 0; gi < 8; ++gi) *(LAS unsigned short*)(rs + 2 * (16 * gi + n)) = (unsigned short)(cvtpk(r[gi], 0.f) & 0xffffu);
        }
        P6_WAITL();
        const unsigned w = *(const LAS unsigned*)(rs + 4 * lane);
        P6_WAITL();
        *(unsigned*)(part + ((size_t)j * M_TOK + t) * 128 + 2 * lane) = w;
    }
    P6_WAITV(0); P6_WAITL();
#undef P6_SM
}
DI void c_token(int t, int lane, const float* ssqx, const float* gate, const bf16_t* part, unsigned char* cq) {
    const float rstd = row_rstd(ssqx, t);
    const float2 G = *(const float2*)(gate + (size_t)t * 128 + 2 * lane);
    float a0 = 0.f, a1 = 0.f;
#pragma unroll
    for (int jj = 0; jj < 8; ++jj) { const unsigned w = *(const unsigned*)(part + ((size_t)jj * M_TOK + t) * 128 + 2 * lane); a0 += bflo(w); a1 += bfhi(w); }
    const float c0 = G.x * gelu_erf(a0 * rstd * (1.0f / SC_DOWN)) * (128.0f / SC_UP), c1 = G.y * gelu_erf(a1 * rstd * (1.0f / SC_DOWN)) * (128.0f / SC_UP);
    unsigned hi, lo; split8(c0, c1, 0.f, 0.f, hi, lo);
    *(unsigned short*)(cq + (size_t)t * 256 + 2 * lane) = (unsigned short)(hi & 0xffffu); *(unsigned short*)(cq + (size_t)t * 256 + 128 + 2 * lane) = (unsigned short)(lo & 0xffffu);
}
DI void up_run(int j, int lw, int nlw, int lane, LAS unsigned char* img, LAS unsigned char* sm, LAS unsigned char* rs, const int* eidt, const unsigned char* cq, const unsigned char* EUs, bf16_t* delta) {
    if (lw >= M_TOK) return;
    const int n = lane & 15, kq = lane >> 4, r = n >> 1, ch = n & 1;
    const int cnt = (M_TOK - 1 - lw) / nlw + 1, tl = lw + (cnt - 1) * nlw;
#define P6_SM(t, slot) smalls_dma(slot, eidt, (t), cq + (size_t)(t) * 256, cq + (size_t)(t) * 256 + 128, lane)
    P6_SM(P6_TOK(0), sm); P6_SM(P6_TOK(1), sm + 1024);
    P6_WAITV(0);
    Ids idn = ids_lds(sm, lane);
    P6_WAITL();
    dma_all(img, EUs, idn, lane);
    for (int i = 0; i < cnt; ++i) {
        const int t = lw + i * nlw;
        LAS unsigned char* cur = sm + (i & 1) * 1024; LAS unsigned char* nxs = sm + ((i + 1) & 1) * 1024;
        long a[4];
        { u32x2 w[4];
#pragma unroll
          for (int sx = 0; sx < 4; ++sx) { w[sx] = (u32x2){0u, 0u}; if (n < 2) w[sx] = *(const LAS u32x2*)(cur + 512 + 128 * n + 32 * sx + 8 * kq); }
          P6_WAITL();
#pragma unroll
          for (int sx = 0; sx < 4; ++sx) a[sx] = mk64(w[sx].x, w[sx].y); }
        { const int t2 = P6_TOK(i + 2); P6_SM(t2, cur); }
        f32x4 acc[8];
#pragma unroll
        for (int cb = 0; cb < 8; ++cb) acc[cb] = (f32x4){0.f, 0.f, 0.f, 0.f};
#define P6_KS(SX) { P6_WAITV(12); \
            v2i_t b[8]; \
            _Pragma("unroll") for (int cb = 0; cb < 8; ++cb) b[cb] = __builtin_amdgcn_ds_read_tr8_b64_v2i32((LAS v2i_t*)(img + (32 * (SX) + 8 * kq + r) * 128 + 16 * (cb ^ r) + 8 * ch)); \
            if ((SX) == 0) idn = ids_lds(nxs, lane); \
            P6_WAITL(); \
            dma1<4 * (SX)>(img, EUs, idn, lane); dma1<4 * (SX) + 1>(img, EUs, idn, lane); dma1<4 * (SX) + 2>(img, EUs, idn, lane); dma1<4 * (SX) + 3>(img, EUs, idn, lane); \
            _Pragma("unroll") for (int cb = 0; cb < 8; ++cb) acc[cb] = __builtin_amdgcn_mfma_f32_16x16x32_fp8_fp8(a[SX], mk64((unsigned)b[cb].x, (unsigned)b[cb].y), acc[cb], 0, 0, 0); }
        P6_KS(0) P6_KS(1) P6_KS(2) P6_KS(3)
#undef P6_KS
        if (lane < 16) {
#pragma unroll
            for (int cb = 0; cb < 8; ++cb) *(LAS unsigned short*)(rs + 2 * (16 * cb + n)) = (unsigned short)(cvtpk((acc[cb][0] + acc[cb][1] * (1.0f / 16.0f)) * (1.0f / 128.0f), 0.f) & 0xffffu);
        }
        P6_WAITL();
        const unsigned w = *(const LAS unsigned*)(rs + 4 * lane);
        P6_WAITL();
        *(unsigned*)(delta + (size_t)t * DM + 128 * j + 2 * lane) = w;
    }
    P6_WAITV(0); P6_WAITL();
#undef P6_SM
#undef P6_TOK
}
DI int opaque_lane() { int l; asm volatile("v_mbcnt_lo_u32_b32 %0, -1, 0\n\tv_mbcnt_hi_u32_b32 %0, -1, %0" : "=v"(l)); return l; }
#define P6I_T(i) (t0 + (((i) < 64 ? (i) : 63) & 7))
#define P6I_S(i) (((i) < 64 ? (i) : 63) >> 3)
DI void own_down(int t0, LAS unsigned char* img, LAS unsigned char* sm, const int* eidt, const unsigned char* xqh, const unsigned char* xql, const unsigned char* ED, float (&pacc)[8][8]) {
    const int lane = opaque_lane();
    const int n = lane & 15, kq = lane >> 4, key = n & 7;
#define P6I_SM(i, slot) smalls_dma(slot, eidt, P6I_T(i), xqh + (size_t)P6I_T(i) * DM + 128 * P6I_S(i), xql + (size_t)P6I_T(i) * DM + 128 * P6I_S(i), lane)
    P6I_SM(0, sm); P6I_SM(1, sm + 1024);
    P6_WAITV(0);
    Ids idn = ids_lds(sm, lane);
    P6_WAITL();
    dma_all(img, ED, idn, lane);
    for (int s = 0; s < 8; ++s) {
#define P6I_GRP(GI, TOK) { P6_WAITV(14); \
            const LAS unsigned char* row = img + (16 * (GI) + n) * 128; \
            const u32x4 b01 = *(const LAS u32x4*)(row + 16 * ((2 * kq) ^ key)), b23 = *(const LAS u32x4*)(row + 16 * ((2 * kq + 1) ^ key)); \
            if ((GI) == 0) idn = ids_lds(nxs, lane); \
            P6_WAITL(); \
            dma1<2 * (GI)>(img, nsl, idn, lane); dma1<2 * (GI) + 1>(img, nsl, idn, lane); \
            f32x4 acc = (f32x4){0.f, 0.f, 0.f, 0.f}; \
            acc = __builtin_amdgcn_mfma_f32_16x16x32_fp8_fp8(a[0], mk64(b01.x, b01.y), acc, 0, 0, 0); \
            acc = __builtin_amdgcn_mfma_f32_16x16x32_fp8_fp8(a[1], mk64(b01.z, b01.w), acc, 0, 0, 0); \
            acc = __builtin_amdgcn_mfma_f32_16x16x32_fp8_fp8(a[2], mk64(b23.x, b23.y), acc, 0, 0, 0); \
            acc = __builtin_amdgcn_mfma_f32_16x16x32_fp8_fp8(a[3], mk64(b23.z, b23.w), acc, 0, 0, 0); \
            pacc[TOK][GI] += acc[0] + acc[1] * (1.0f / 16.0f); }
#define P6I_ITEM(TOK) { const int i = 8 * s + (TOK); \
            LAS unsigned char* cur = sm + ((TOK) & 1) * 1024; LAS unsigned char* nxs = sm + (((TOK) + 1) & 1) * 1024; \
            long a[4]; \
            { u32x4 a01 = (u32x4){0u, 0u, 0u, 0u}, a23 = (u32x4){0u, 0u, 0u, 0u}; \
              if (n < 2) { a01 = *(const LAS u32x4*)(cur + 512 + 128 * n + 32 * kq); a23 = *(const LAS u32x4*)(cur + 512 + 128 * n + 32 * kq + 16); } \
              P6_WAITL(); \
              a[0] = mk64(a01.x, a01.y); a[1] = mk64(a01.z, a01.w); a[2] = mk64(a23.x, a23.y); a[3] = mk64(a23.z, a23.w); } \
            P6I_SM(i + 2, cur); \
            const unsigned char* nsl = ED + (size_t)P6I_S(i + 1) * SLICE;                   \
            P6I_GRP(0, TOK) P6I_GRP(1, TOK) P6I_GRP(2, TOK) P6I_GRP(3, TOK) P6I_GRP(4, TOK) P6I_GRP(5, TOK) P6I_GRP(6, TOK) P6I_GRP(7, TOK) }
        P6I_ITEM(0) P6I_ITEM(1) P6I_ITEM(2) P6I_ITEM(3) P6I_ITEM(4) P6I_ITEM(5) P6I_ITEM(6) P6I_ITEM(7)
#undef P6I_ITEM
#undef P6I_GRP
    }
    P6_WAITV(0); P6_WAITL();
#undef P6I_SM
}
DI void own_c(int t0, LAS unsigned char* img, const float (&pacc)[8][8], const float* ssqx, const float* gate, unsigned char* cq) {
    const int lane = opaque_lane();
    LAS float* pf = (LAS float*)img;
    if (lane < 16) {
#pragma unroll
        for (int tok = 0; tok < 8; ++tok)
#pragma unroll
            for (int gi = 0; gi < 8; ++gi) pf[tok * 128 + 16 * gi + lane] = pacc[tok][gi];
    }
    const float rl = row_rstd(ssqx, t0 + (lane & 7));
    float2 G[8];
#pragma unroll
    for (int tok = 0; tok < 8; ++tok) G[tok] = *(const float2*)(gate + (size_t)(t0 + tok) * 128 + 2 * lane);
    P6_WAITL();
#pragma unroll
    for (int tok = 0; tok < 8; ++tok) {
        const float rstd = __int_as_float(__builtin_amdgcn_readlane(__float_as_int(rl), tok));
        const f32x2_t d = *(const LAS f32x2_t*)(pf + tok * 128 + 2 * lane);
        const float c0 = G[tok].x * gelu_erf(d.x * rstd * (1.0f / SC_DOWN)) * (128.0f / SC_UP), c1 = G[tok].y * gelu_erf(d.y * rstd * (1.0f / SC_DOWN)) * (128.0f / SC_UP);
        unsigned hi, lo; split8(c0, c1, 0.f, 0.f, hi, lo);
        *(unsigned short*)(cq + (size_t)(t0 + tok) * 256 + 2 * lane) = (unsigned short)(hi & 0xffffu); *(unsigned short*)(cq + (size_t)(t0 + tok) * 256 + 128 + 2 * lane) = (unsigned short)(lo & 0xffffu);
    }
    asm volatile("s_waitcnt vmcnt(0) lgkmcnt(0)" ::: "memory");
}
DI void own_c2(int t0, LAS unsigned char* img, const float (&pacc)[8][8], const float* ssqx, const float* gate, unsigned char* cq, const int* eidt, const unsigned char* EU) {
    const int lane = opaque_lane();
    LAS float* pf = (LAS float*)img;
    if (lane < 16) {
#pragma unroll
        for (int tok = 0; tok < 8; ++tok)
#pragma unroll
            for (int gi = 0; gi < 8; ++gi) pf[tok * 128 + 16 * gi + lane] = pacc[tok][gi];
    }
    Ids idn; { const i32x4* ep = (const i32x4*)(eidt + (size_t)t0 * 128 + (lane >> 3) * 16); idn.e0 = ep[0]; idn.e1 = ep[1]; idn.e2 = ep[2]; idn.e3 = ep[3]; }
    const float rl = row_rstd(ssqx, t0 + (lane & 7));
    float2 G[8];
#pragma unroll
    for (int tok = 0; tok < 8; ++tok) G[tok] = *(const float2*)(gate + (size_t)(t0 + tok) * 128 + 2 * lane);
    P6_WAITL();
    f32x2_t d[8];
#pragma unroll
    for (int tok = 0; tok < 8; ++tok) d[tok] = *(const LAS f32x2_t*)(pf + tok * 128 + 2 * lane);
    P6_WAITL();
    dma_all(img, EU, idn, lane);
#pragma unroll
    for (int tok = 0; tok < 8; ++tok) {
        const float rstd = __int_as_float(__builtin_amdgcn_readlane(__float_as_int(rl), tok));
        const float c0 = G[tok].x * gelu_erf(d[tok].x * rstd * (1.0f / SC_DOWN)) * (128.0f / SC_UP), c1 = G[tok].y * gelu_erf(d[tok].y * rstd * (1.0f / SC_DOWN)) * (128.0f / SC_UP);
        unsigned hi, lo; split8(c0, c1, 0.f, 0.f, hi, lo);
        *(unsigned short*)(cq + (size_t)(t0 + tok) * 256 + 2 * lane) = (unsigned short)(hi & 0xffffu); *(unsigned short*)(cq + (size_t)(t0 + tok) * 256 + 128 + 2 * lane) = (unsigned short)(lo & 0xffffu);
    }
    asm volatile("s_waitcnt vmcnt(0) lgkmcnt(0)" ::: "memory");
}
template <bool PREFILLED> DI void own_up(int t0, LAS unsigned char* img, LAS unsigned char* sm, LAS unsigned char* rs, const int* eidt, const unsigned char* cq, const unsigned char* EU, bf16_t* delta) {
    const int lane = opaque_lane();
    const int n = lane & 15, kq = lane >> 4, r = n >> 1, ch = n & 1;
#define P6I_SM(i, slot) smalls_dma(slot, eidt, P6I_T(i), cq + (size_t)P6I_T(i) * 256, cq + (size_t)P6I_T(i) * 256 + 128, lane)
    P6I_SM(0, sm); P6I_SM(1, sm + 1024);
    P6_WAITV(0);
    Ids idn = ids_lds(sm, lane);
    P6_WAITL();
    if (!PREFILLED) dma_all(img, EU, idn, lane);
    for (int i = 0; i < 64; ++i) {
        const int t = t0 + (i & 7), sl = i >> 3;
        LAS unsigned char* cur = sm + (i & 1) * 1024; LAS unsigned char* nxs = sm + ((i + 1) & 1) * 1024;
        long a[4];
        { u32x2 w[4];
#pragma unroll
          for (int sx = 0; sx < 4; ++sx) { w[sx] = (u32x2){0u, 0u}; if (n < 2) w[sx] = *(const LAS u32x2*)(cur + 512 + 128 * n + 32 * sx + 8 * kq); }
          P6_WAITL();
#pragma unroll
          for (int sx = 0; sx < 4; ++sx) a[sx] = mk64(w[sx].x, w[sx].y); }
        P6I_SM(i + 2, cur);
        const unsigned char* nsl = EU + (size_t)P6I_S(i + 1) * SLICE;
        f32x4 acc[8];
#pragma unroll
        for (int cb = 0; cb < 8; ++cb) acc[cb] = (f32x4){0.f, 0.f, 0.f, 0.f};
#define P6I_KS(SX) { P6_WAITV(12); \
            v2i_t b[8]; \
            _Pragma("unroll") for (int cb = 0; cb < 8; ++cb) b[cb] = __builtin_amdgcn_ds_read_tr8_b64_v2i32((LAS v2i_t*)(img + (32 * (SX) + 8 * kq + r) * 128 + 16 * (cb ^ r) + 8 * ch)); \
            if ((SX) == 0) idn = ids_lds(nxs, lane); \
            P6_WAITL(); \
            dma1<4 * (SX)>(img, nsl, idn, lane); dma1<4 * (SX) + 1>(img, nsl, idn, lane); dma1<4 * (SX) + 2>(img, nsl, idn, lane); dma1<4 * (SX) + 3>(img, nsl, idn, lane); \
            _Pragma("unroll") for (int cb = 0; cb < 8; ++cb) acc[cb] = __builtin_amdgcn_mfma_f32_16x16x32_fp8_fp8(a[SX], mk64((unsigned)b[cb].x, (unsigned)b[cb].y), acc[cb], 0, 0, 0); }
        P6I_KS(0) P6I_KS(1) P6I_KS(2) P6I_KS(3)
#undef P6I_KS
        if (lane < 16) {
#pragma unroll
            for (int cb = 0; cb < 8; ++cb) *(LAS unsigned short*)(rs + 2 * (16 * cb + n)) = (unsigned short)(cvtpk((acc[cb][0] + acc[cb][1] * (1.0f / 16.0f)) * (1.0f / 128.0f), 0.f) & 0xffffu);
        }
        P6_WAITL();
        const unsigned w = *(const LAS unsigned*)(rs + 4 * lane);
        P6_WAITL();
        *(unsigned*)(delta + (size_t)t * DM + 128 * sl + 2 * lane) = w;
    }
    P6_WAITV(0); P6_WAITL();
#undef P6I_SM
}
#undef P6I_T
#undef P6I_S
DI void final_token(int t, int lane, float* outp, const bf16_t* x1b, const bf16_t* delta, const float* g_fin) {
    f32x4* orow = (f32x4*)(outp + (size_t)t * DM) + lane; const u32x2* xr = (const u32x2*)(x1b + (size_t)t * DM) + lane; const u32x2* dr = (const u32x2*)(delta + (size_t)t * DM) + lane; const f32x4* gr = (const f32x4*)g_fin + lane;
    f32x4 v[4]; float ss = 0.f;
#pragma unroll
    for (int i = 0; i < 4; ++i) { const u32x2 d = dr[64 * i], x = xr[64 * i]; v[i][0] = bflo(x.x) + bflo(d.x); v[i][1] = bfhi(x.x) + bfhi(d.x); v[i][2] = bflo(x.y) + bflo(d.y); v[i][3] = bfhi(x.y) + bfhi(d.y);
        ss += (v[i][0] * v[i][0] + v[i][1] * v[i][1]) + (v[i][2] * v[i][2] + v[i][3] * v[i][3]); }
    const float r2 = 1.0f / sqrtf(wave_sum(ss) * (1.f / DM) + EPS);
#pragma unroll
    for (int i = 0; i < 4; ++i) orow[64 * i] = v[i] * r2 * gr[64 * i];
}
template <int U> DI void final_tokens(int tb, int lane, float* outp, const bf16_t* x1b, const bf16_t* delta, const float* g_fin) {
    u32x2 xr[U][4], dr[U][4];
#pragma unroll
    for (int u = 0; u < U; ++u) { const u32x2* xp = (const u32x2*)(x1b + (size_t)(tb + u) * DM) + lane; const u32x2* dp = (const u32x2*)(delta + (size_t)(tb + u) * DM) + lane;
#pragma unroll
        for (int i = 0; i < 4; ++i) { xr[u][i] = xp[64 * i]; dr[u][i] = dp[64 * i]; } }
    f32x4 g[4];
#pragma unroll
    for (int i = 0; i < 4; ++i) g[i] = *((const f32x4*)g_fin + lane + 64 * i);
#pragma unroll
    for (int u = 0; u < U; ++u) { f32x4 v[4]; float ss = 0.f;
#pragma unroll
        for (int i = 0; i < 4; ++i) { const u32x2 d = dr[u][i], x = xr[u][i]; v[i][0] = bflo(x.x) + bflo(d.x); v[i][1] = bfhi(x.x) + bfhi(d.x); v[i][2] = bflo(x.y) + bflo(d.y); v[i][3] = bfhi(x.y) + bfhi(d.y);
            ss += (v[i][0] * v[i][0] + v[i][1] * v[i][1]) + (v[i][2] * v[i][2] + v[i][3] * v[i][3]); }
        const float r2 = 1.0f / sqrtf(wave_sum(ss) * (1.f / DM) + EPS);
        f32x4* orow = (f32x4*)(outp + (size_t)(tb + u) * DM) + lane;
#pragma unroll
        for (int i = 0; i < 4; ++i) __builtin_nontemporal_store(v[i] * r2 * g[i], orow + 64 * i); }
}
}

constexpr int N_LAUNCHES = MK_N_LAUNCHES;
constexpr int N_PHASES = 7;

__global__ void __launch_bounds__(NWAVES * 64, 2) hymba_fwd(Args args) {
    extern __shared__ __attribute__((aligned(16))) unsigned char lds_raw[];
    Frame F;
    F.lds = (LAS unsigned char*)lds_raw;
    volatile LAS unsigned* MISC = (volatile LAS unsigned*)(F.lds + MISC_OFF);
    F.tid = threadIdx.x; F.lane = F.tid & 63; F.wave = __builtin_amdgcn_readfirstlane(F.tid >> 6);
    F.G = gridDim.x; { const int bx = blockIdx.x; F.vcu = (F.G % 8 == 0) ? (bx % 8) * (F.G / 8) + bx / 8 : bx; }
    unsigned char* ws = args.ws;
    unsigned* ctl = (unsigned*)(ws + WS_CTL);
    const float* x = args.in[0]; const float* g_mix = args.in[1]; const float* w_in = args.in[2]; const float* conv_w = args.in[3];
    const float* g_conv = args.in[4]; const float* g_attn = args.in[5]; const float* w_out = args.in[6]; const float* g_ffn = args.in[7];
    const float* w_q = args.in[8]; const float* sk1 = args.in[9]; const float* sk2 = args.in[10]; const float* e_down = args.in[11]; const float* e_up = args.in[12];
    const float* g_fin = args.in[13];
    float* out = args.out;
    bf16_t* WinT = (bf16_t*)(ws + WS_WIN); bf16_t* WoutT = (bf16_t*)(ws + WS_WOUT); bf16_t* WqT = (bf16_t*)(ws + WS_WQ);
    bf16_t* K1b = (bf16_t*)(ws + WS_K1); bf16_t* K2b = (bf16_t*)(ws + WS_K2);
    bf16_t* XN = (bf16_t*)(ws + WS_XN); bf16_t* PROJ = (bf16_t*)(ws + WS_PROJ); bf16_t* QRY = (bf16_t*)(ws + WS_QRY); bf16_t* Yb = (bf16_t*)(ws + WS_Y);
    unsigned char* ED8 = ws + WS_ED; unsigned char* EU8 = ws + WS_EU;
    float* KSUM = (float*)(ws + WS_KSUM); float* SSQA = (float*)(ws + WS_SSQA); float* SSQX = (float*)(ws + WS_SSQX);
    float* RMS0 = (float*)(ws + WS_RMS0); bf16_t* IDM = (bf16_t*)(ws + WS_IDM);
    int* EIDX = (int*)(ws + WS_EIDX); float* GATE = (float*)(ws + WS_GATE);

    if (F.tid < 64) MISC[F.tid] = 0u;
    __syncthreads();
    XcdBarrier bar; bar.bar = ctl + CW_BAR; bar.x = 0; bar.st = nullptr;
    if (N_LAUNCHES == 1) bar = xcd_barrier_post(ctl + CW_BAR, MISC + 8);
#define GRID_BAR() do { if (N_LAUNCHES == 1) xcd_barrier(bar); } while (0)
    const int lo = args.ph_lo, hi = args.ph_hi;
#define IN(k) (lo <= (k) && (k) < hi)
#define BOTH(k) (IN(k) && IN((k) + 1))
    const int gw = F.vcu * NWAVES + F.wave, NGW = F.G * NWAVES;

    if (IN(0)) for (int rep = 0; rep < NREP(0); ++rep) {
        LAS float* scr = (LAS float*)(F.lds + F.wave * 16384);
        constexpr int I_IN = (DM / 64) * (DPROJ / 32), I_OUT = (DM / 64) * (DM / 32), I_Q = (DM / 64) * (2048 / 32);
        constexpr int I_SK = 131072 / 512, I_EX = (NEXP * DM) / 512;
        for (int r0 = gw * 4; r0 < M_TOK; r0 += NGW * 4) p0_xn_rows<4>(x, g_mix, XN, RMS0, r0, F.lane);
        for (int n = gw; n < 256; n += NGW) {
            u32x4 z0 = (u32x4){0u, 0u, 0u, 0u}, z1 = z0; const int kk = n - 16 * F.lane;
            if (kk >= 0 && kk < 16) { const unsigned one = (kk & 1) ? 0x3F800000u : 0x00003F80u; const int wi = kk >> 1;
                if (wi < 4) { if (wi == 0) z0.x = one; else if (wi == 1) z0.y = one; else if (wi == 2) z0.z = one; else z0.w = one; }
                else { if (wi == 4) z1.x = one; else if (wi == 5) z1.y = one; else if (wi == 6) z1.z = one; else z1.w = one; } }
            st16_wt(IDM + (size_t)n * DM + 16 * F.lane, z0); st16_wt(IDM + (size_t)n * DM + 16 * F.lane + 8, z1);
        }
        constexpr int NITEMS = I_IN + I_OUT + I_Q + 2 * I_SK;
        const int p0_items = (NGW == NITEMS - I_IN) ? I_IN : NITEMS;
        for (int it = gw; it < p0_items; it += NGW) {
            int r = it;
            if (r < I_IN) { p0_transpose_item(w_in, DM, DPROJ, WinT, g_mix, g_mix, DM, scr, r, F.lane); continue; } r -= I_IN;
            if (r < I_OUT) { p0_transpose_item(w_out, DM, DM, WoutT, g_conv, g_attn, 512, scr, r, F.lane); continue; } r -= I_OUT;
            if (r < I_Q) { p0_transpose_item(w_q, DM, 2048, WqT, g_ffn, g_ffn, DM, scr, r, F.lane); continue; } r -= I_Q;
            if (r < I_SK) { p0_cvt_item(sk1, K1b, (size_t)r, F.lane); continue; } r -= I_SK;
            p0_cvt_item(sk2, K2b, (size_t)r, F.lane);
        }
        if (BOTH(0)) GRID_BAR();
    }
    if (IN(1)) for (int rep = 0; rep < NREP(1); ++rep) {
        pg8::Gemm g{XN, WinT, M_TOK, DPROJ, DM, DM, DM}; pg8::StaticOrder S; S.init(M_TOK, DPROJ, F.G, (int)blockIdx.x);
        pg8::EpiProj E{PROJ, KSUM};
        pg8::gemm_phase<pg8::EpiProj, pg8::StaticOrder, true>(F.lds, g, S, E);
        if (BOTH(1)) GRID_BAR();
    }
    if (IN(2)) for (int rep = 0; rep < NREP(2); ++rep) {
        bool conv_done = false;
        for (int v = F.vcu; v < 256; v += F.G) {
            const int bh = v >> 2, s = v & 3;
            att2::attn_unit<8>(bh >> 3, bh & 7, s, (const att2::bf16*)(PROJ + QOFF), (const att2::bf16*)(PROJ + KOFF), (const att2::bf16*)(PROJ + VOFF), (att2::bf16*)(Yb + 512), KSUM, SSQA, (char*)lds_raw);
            if (!conv_done) { conv_done = true;
                if (NGW * 8 == M_TOK) att::conv_rows8(PROJ, conv_w, Yb, gw * 8, F.lane);
                else for (int r0 = gw * 4; r0 < M_TOK; r0 += NGW * 4) att::conv_rows4(PROJ, conv_w, Yb, r0, F.lane); }
            att2::attn_unit<8>(bh >> 3, bh & 7, 7 - s, (const att2::bf16*)(PROJ + QOFF), (const att2::bf16*)(PROJ + KOFF), (const att2::bf16*)(PROJ + VOFF), (att2::bf16*)(Yb + 512), KSUM, SSQA, (char*)lds_raw);
        }
        if (!conv_done) for (int r0 = gw * 4; r0 < M_TOK; r0 += NGW * 4) att::conv_rows4(PROJ, conv_w, Yb, r0, F.lane);
        __syncthreads();
        { constexpr int J_OUT = (DM / 64) * (DM / 32), J_Q = (DM / 64) * (2048 / 32), J_SK = 131072 / 512;
          if (NGW == J_OUT + J_Q + 2 * J_SK) {
              LAS float* scr2 = (LAS float*)(F.lds + F.wave * 16384); const int r = gw;
              if (r < J_OUT) p0_transpose_item(w_out, DM, DM, WoutT, g_conv, g_attn, 512, scr2, r, F.lane);
              else if (r < J_OUT + J_Q) p0_transpose_item(w_q, DM, 2048, WqT, g_ffn, g_ffn, DM, scr2, r - J_OUT, F.lane);
              else { const int q = r - J_OUT - J_Q; if (q < J_SK) p0_cvt_item(sk1, K1b, (size_t)q, F.lane); else p0_cvt_item(sk2, K2b, (size_t)(q - J_SK), F.lane); }
              __syncthreads(); } }
        if (BOTH(2)) GRID_BAR();
    }
    if (IN(3)) for (int rep = 0; rep < NREP(3); ++rep) {
        pg8::StaticOrder S; S.init(M_TOK, DM, F.G, (int)blockIdx.x);
        pg8::Unit u0;
        if (S.next(0, u0)) {
            if (F.tid < 256) { const f32x4* sp = (const f32x4*)(SSQA + (size_t)(u0.pm * 256 + F.tid) * 8); const f32x4 a = sp[0], b = sp[1];
                const float ms = (((a[0] + a[1]) + (a[2] + a[3])) + ((b[0] + b[1]) + (b[2] + b[3]))) * (1.f / 512.f) + EPS; const float rms = sqrtf(ms);
                LAS float* tab = (LAS float*)(F.lds + TAB_OFF); tab[F.tid] = rms; tab[256 + F.tid] = 1.0f / rms; tab[1536 + F.tid] = RMS0[u0.pm * 256 + F.tid]; }
            else ((LAS f32x4*)(F.lds + TAB_OFF + 2048))[F.tid - 256] = ((const f32x4*)g_ffn)[F.tid - 256];
        }
        __syncthreads();
        pg8::Gemm g{Yb, WoutT, M_TOK, DM, DM, DM, DM, XN, IDM, 4};
        pg8::EpiX1 E{x, out, XN, SSQX, TAB_OFF, ws + WS_XQH, ws + WS_XQL};
        pg8::gemm_phase<pg8::EpiX1, pg8::StaticOrder, false>(F.lds, g, S, E);
        if (BOTH(3)) GRID_BAR();
    }
    if (IN(4)) for (int rep = 0; rep < NREP(4); ++rep) {
        pg8::Gemm g{XN, WqT, M_TOK, 2048, DM, DM, DM}; pg8::HeadOrder S; S.init(M_TOK, 2048, F.G, (int)blockIdx.x);
        pg8::EpiBf16 E{QRY, 2048};
        pg8::gemm_phase<pg8::EpiBf16, pg8::HeadOrder, true>(F.lds, g, S, E);
        asm volatile("s_waitcnt vmcnt(0)" ::: "memory");
        __syncthreads();
    }
    if (IN(5)) for (int rep = 0; rep < NREP(5); ++rep) {
        if (!IN(4)) { }
        pg8::HeadOrder S; S.init(M_TOK, 2048, F.G, (int)blockIdx.x);
        pg8::Unit u5; int cur_h = -1;
        for (int ui = 0; S.next(ui, u5); ++ui) {
            const int h = u5.pn; const int L = ui * F.G + (int)blockIdx.x;
            if (h != cur_h) {
                __syncthreads();
                p5w::keys_to_lds(F.lds, K1b, K2b, h, F.tid);
                __syncthreads();
                cur_h = h;
                if (F.wave >= 4) __builtin_amdgcn_s_sleep(24);
            }
            const int it0 = (L * NWAVES + F.wave) * 16; const bool dn = it0 < (NEXP * DM) / 512;
            p5w::unit_rows32(F.lds, F.lane, F.wave, u5.pm * 256 + 32 * F.wave, h, QRY, SSQX, EIDX, GATE, dn ? e_down : e_up, dn ? ED8 : EU8, (size_t)(dn ? it0 : it0 - (NEXP * DM) / 512), dn ? p6::SC_DOWN : p6::SC_UP, nullptr);
        }
        __syncthreads();
        if (BOTH(5)) GRID_BAR();
    }
    if (IN(6)) {
        bf16_t* DELTA = (bf16_t*)(ws + WS_DELTA); unsigned char* CQ = ws + WS_CQ; const bf16_t* X1S = XN;
        LAS unsigned char* img = F.lds + F.wave * 16384; LAS unsigned char* sm = F.lds + 131072 + F.wave * 2048; LAS unsigned char* rs = F.lds + 147456 + F.wave * 256;
        for (int g = gw; g < M_TOK / 8; g += NGW) {
            const int t0 = 8 * g;
            float pacc[8][8];
#pragma unroll
            for (int a = 0; a < 8; ++a)
#pragma unroll
                for (int b = 0; b < 8; ++b) pacc[a][b] = 0.f;
            p6::own_down(t0, img, sm, EIDX, ws + WS_XQH, ws + WS_XQL, ED8, pacc);
            p6::own_c2(t0, img, pacc, SSQX, GATE, CQ, EIDX, EU8);
            p6::own_up<true>(t0, img, sm, rs, EIDX, CQ, EU8, DELTA);
            asm volatile("s_waitcnt vmcnt(0)" ::: "memory");
            p6::final_tokens<8>(t0, p6::opaque_lane(), out, X1S, DELTA, g_fin);
        }
    }
#undef IN
#undef BOTH
#undef GRID_BAR
}

extern "C" void kernel_launch(void* const* d_in, const int* in_sizes, int n_in, void* d_out, int out_size, void* d_ws, size_t ws_size, hipStream_t stream) {
    static int grid = 0;
    if (grid == 0) {
        if (n_in != 14 || in_sizes[0] != M_TOK * DM || out_size != M_TOK * DM || ws_size < WS_END) { fprintf(stderr, "kernel_launch: unexpected problem shape (n_in %d, in0 %d, out %d, ws %zu)\n", n_in, n_in > 0 ? in_sizes[0] : -1, out_size, ws_size); grid = -1; return; }
        int dev = 0, cus = 0;
        if (hipGetDevice(&dev) != hipSuccess || hipDeviceGetAttribute(&cus, hipDeviceAttributeMultiprocessorCount, dev) != hipSuccess) { grid = -1; return; }
        if (hipFuncSetAttribute((const void*)hymba_fwd, hipFuncAttributeMaxDynamicSharedMemorySize, LDS_BYTES) != hipSuccess) { fprintf(stderr, "kernel_launch: hipFuncSetAttribute failed\n"); grid = -1; return; }
        (void)hipGetLastError();
        grid = cus;
        if (grid != 256) fprintf(stderr, "kernel_launch: %d CUs (built for 256)\n", grid);
    }
    if (grid < 0) return;
    if (hipMemsetAsync((char*)d_ws + WS_CTL, 0, CTL_ZERO_BYTES, stream) != hipSuccess) return;
    Args a{};
    for (int i = 0; i < 14; ++i) a.in[i] = (const float*)d_in[i];
    a.out = (float*)d_out; a.ws = (unsigned char*)d_ws;
    if (N_LAUNCHES == 1) {
        a.ph_lo = 0; a.ph_hi = N_PHASES; a.li = 0;
        hipLaunchKernelGGL(hymba_fwd, dim3(grid), dim3(NWAVES * 64), LDS_BYTES, stream, a);
    } else {
        for (int li = 0; li < N_PHASES; ++li) { a.ph_lo = li; a.ph_hi = li + 1; a.li = li; hipLaunchKernelGGL(hymba_fwd, dim3(grid), dim3(NWAVES * 64), LDS_BYTES, stream, a); }
    }
}
```

```cpp
#include <hip/hip_runtime.h>
#include <hip/hip_bf16.h>
#include <cstdio>
#include <cstdint>
#include <cmath>

#ifndef MK_N_LAUNCHES
#define MK_N_LAUNCHES 1
#endif

#ifndef PROBE_REP
#define PROBE_REP 0
#endif
#define NREP(k) (((PROBE_REP >> (k)) & 1) + 1)
#define DI __device__ __forceinline__
#define LAS __attribute__((address_space(3)))
#define GAS __attribute__((address_space(1)))

typedef unsigned short bf16_t;
typedef short bf16x8 __attribute__((ext_vector_type(8)));
typedef float f32x4 __attribute__((ext_vector_type(4)));
typedef float f32x16 __attribute__((ext_vector_type(16)));
typedef unsigned u32x4 __attribute__((ext_vector_type(4)));
typedef unsigned u32x2 __attribute__((ext_vector_type(2)));
typedef float f32x2_t __attribute__((ext_vector_type(2)));
typedef __bf16 bf16x2_t __attribute__((ext_vector_type(2)));

constexpr int M_TOK = 16384, DM = 1024, DPROJ = 3072, SEQ = 2048, NBATCH = 8, NH = 8, HD = 64;
constexpr int KOFF = 2048, VOFF = 2560, QOFF = 1536;
constexpr int NEXP = 16384, PEER_H = 8, PEER_TOPK = 16;
constexpr float EPS = 1e-6f;
constexpr float C2 = 0.125f * 1.4426950408889634f;

DI unsigned cvtpk(float lo, float hi) { f32x2_t v = {lo, hi}; bf16x2_t b = __builtin_convertvector(v, bf16x2_t); return __builtin_bit_cast(unsigned, b); }
DI float bflo(unsigned w) { return __uint_as_float(w << 16); }
DI float bfhi(unsigned w) { return __uint_as_float(w & 0xffff0000u); }
DI void st16_wt(void* p, u32x4 v) { asm volatile("global_store_dwordx4 %0, %1, off sc1\n\ts_nop 1" :: "v"(p), "v"(v) : "memory"); }
DI void st4_wt(void* p, unsigned v) { asm volatile("global_store_dword %0, %1, off sc1" :: "v"(p), "v"(v) : "memory"); }
DI void st8_wt(void* p, u32x2 v) { asm volatile("global_store_dwordx2 %0, %1, off sc1" :: "v"(p), "v"(v) : "memory"); }
DI float wave_sum(float v) {
#pragma unroll
    for (int o = 1; o < 64; o <<= 1) v += __shfl_xor(v, o);
    return v;
}

namespace pg8 {
constexpr int BM = 256, BK = 64, HALF = 128, HTB = HALF * BK * 2, STAGE_BYTES = 8 * HTB, NXCD = 8, WGM = 8;
__host__ __device__ __forceinline__ int lds_byte(int r, int c) { const int st = (r >> 4) * 2 + (c >> 5), rr = r & 15, cc = c & 31, ob = rr * 64 + cc * 2; return st * 1024 + (ob ^ (((ob >> 9) & 1) << 5)); }
__host__ __device__ __forceinline__ void stage_rc(int b, int& R, int& C) { const int st = b / 1024, sb = b % 1024, swz = sb ^ (((sb >> 9) & 1) << 5); R = (st >> 1) * 16 + swz / 64; C = (st & 1) * 32 + (swz % 64) / 2; }
__host__ __device__ __forceinline__ int perm32(int rho) { const int n = rho >> 4, i = rho & 15; return 8 * (i >> 2) + 4 * n + (i & 3); }

struct Unit { int pm, pn; };
struct Gemm { const bf16_t* A; const bf16_t* Bt; int M, N, K, lda, ldb; const bf16_t* XA = nullptr; const bf16_t* XBt = nullptr; int nx = 0; };

struct StaticOrder {
    int nM, nN, nwg, G, c;
    __host__ __device__ void init(int M, int N, int G_, int c_) { nM = M / BM; nN = N / BM; nwg = nM * nN; G = G_; c = c_; }
    __host__ __device__ bool next(int i, Unit& u) const {
        const long L = (long)i * G + c; if (L >= nwg) return false;
        int wgid = (int)L; { const int q = nwg / NXCD, r = nwg % NXCD, xcd = wgid % NXCD, off = wgid / NXCD; wgid = (xcd < r ? xcd * (q + 1) : r * (q + 1) + (xcd - r) * q) + off; }
        const int nig = WGM * nN, gid = wgid / nig, fm = gid * WGM, gsz = (nM - fm) < WGM ? (nM - fm) : WGM;
        u.pm = fm + ((wgid % nig) % gsz); u.pn = (wgid % nig) / gsz; return true;
    }
};

struct HeadOrder {
    StaticOrder S; bool head;
    __host__ __device__ void init(int M, int N, int G_, int c_) { S.init(M, N, G_, c_); head = (G_ == 256 && S.nM == 64 && S.nN == 8); }
    __host__ __device__ bool next(int i, Unit& u) const {
        if (!head) return S.next(i, u);
        if (i >= 2) return false;
        const int xcd = S.c % NXCD, off = S.c / NXCD;
        u.pm = 8 * xcd + 4 * i + (off & 3); u.pn = off >> 2; return true;
    }
};

struct EpiBf16 {
    static constexpr bool PERM = true, MID = false;
    bf16_t* O; int ldc;
    DI void mid(f32x4 (&)[2][2][4][2], const Unit&, int, int, LAS unsigned char*, int) const {}
    DI void operator()(const f32x4 (&acc)[2][2][4][2], const Unit& u, int wr, int wc, int fr, int fq, LAS unsigned char*) const {
        const int row0 = u.pm * BM + wr * 64 + fr, col0 = u.pn * BM + wc * 32 + 8 * fq;
#pragma unroll
        for (int ai = 0; ai < 2; ++ai)
#pragma unroll
            for (int m = 0; m < 4; ++m) { bf16_t* rowp = O + (size_t)(row0 + ai * HALF + m * 16) * ldc + col0;
#pragma unroll
                for (int bj = 0; bj < 2; ++bj) { const f32x4 v0 = acc[ai][bj][m][0], v1 = acc[ai][bj][m][1];
                    u32x4 w; w.x = cvtpk(v0[0], v0[1]); w.y = cvtpk(v0[2], v0[3]); w.z = cvtpk(v1[0], v1[1]); w.w = cvtpk(v1[2], v1[3]);
                    *(u32x4*)(rowp + bj * HALF) = w; } }
    }
};
struct EpiProj {
    static constexpr bool PERM = true, MID = false;
    bf16_t* O; float* ksum;
    DI void mid(f32x4 (&)[2][2][4][2], const Unit&, int, int, LAS unsigned char*, int) const {}
    DI void operator()(const f32x4 (&acc)[2][2][4][2], const Unit& u, int wr, int wc, int fr, int fq, LAS unsigned char*) const {
        const int row0 = u.pm * BM + wr * 64 + fr, col0 = u.pn * BM + wc * 32 + 8 * fq;
        const float sc = (u.pn == 6 || u.pn == 7) ? C2 : 1.0f;
#pragma unroll
        for (int ai = 0; ai < 2; ++ai)
#pragma unroll
            for (int m = 0; m < 4; ++m) { bf16_t* rowp = O + (size_t)(row0 + ai * HALF + m * 16) * DPROJ + col0;
#pragma unroll
                for (int bj = 0; bj < 2; ++bj) { const f32x4 v0 = acc[ai][bj][m][0] * sc, v1 = acc[ai][bj][m][1] * sc;
                    u32x4 w; w.x = cvtpk(v0[0], v0[1]); w.y = cvtpk(v0[2], v0[3]); w.z = cvtpk(v1[0], v1[1]); w.w = cvtpk(v1[2], v1[3]);
                    st16_wt(rowp + bj * HALF, w); } }
        if (u.pn == 8 || u.pn == 9) {
            float* kd = ksum + (size_t)u.pm * 512 + (u.pn - 8) * 256 + wc * 32 + 8 * fq;
#pragma unroll
            for (int bj = 0; bj < 2; ++bj)
#pragma unroll
                for (int n = 0; n < 2; ++n)
#pragma unroll
                    for (int j = 0; j < 4; ++j) {
                        float s = 0.f;
#pragma unroll
                        for (int ai = 0; ai < 2; ++ai)
#pragma unroll
                            for (int m = 0; m < 4; ++m) s += acc[ai][bj][m][n][j];
                        s += __shfl_xor(s, 1); s += __shfl_xor(s, 2); s += __shfl_xor(s, 4); s += __shfl_xor(s, 8);
                        if (fr == 0) atomicAdd(kd + bj * HALF + 4 * n + j, s);
                    }
        }
    }
};
struct EpiX1 {
    static constexpr bool PERM = true, MID = true;
    const float* x; float* x1; bf16_t* x1b; float* ssqx; int tab_off; unsigned char* xqh; unsigned char* xql;
    static constexpr int T_MID0 = 4, T_MID1 = 12;
    DI void mid(f32x4 (&acc)[2][2][4][2], const Unit&, int wr, int fr, LAS unsigned char* lds, int which) const {
        const LAS float* tabA = (const LAS float*)(lds + tab_off) + (which ? 0 : 1536);
#pragma unroll
        for (int ai = 0; ai < 2; ++ai)
#pragma unroll
            for (int m = 0; m < 4; ++m) { const float f = tabA[ai * HALF + wr * 64 + m * 16 + fr];
#pragma unroll
                for (int bj = 0; bj < 2; ++bj)
#pragma unroll
                    for (int n = 0; n < 2; ++n) acc[ai][bj][m][n] *= f; }
    }
    DI void operator()(const f32x4 (&acc)[2][2][4][2], const Unit& u, int wr, int wc, int fr, int fq, LAS unsigned char* lds) const {
        int tbo = tab_off; asm volatile("" : "+s"(tbo));
        const LAS float* tabB = (const LAS float*)(lds + tbo) + 256; const LAS float* gtab = (const LAS float*)(lds + tbo) + 512;
        const int col0 = u.pn * BM + wc * 32 + 8 * fq;
#pragma unroll
        for (int ai = 0; ai < 2; ++ai) {
#pragma unroll
            for (int m = 0; m < 4; ++m) { const int r = ai * HALF + wr * 64 + m * 16 + fr; const float rs = tabB[r]; const size_t off = (size_t)(u.pm * BM + r) * DM + col0;
                float ss = 0.f;
#pragma unroll
                for (int bj = 0; bj < 2; ++bj) {
                    const f32x4 v0 = acc[ai][bj][m][0] * rs, v1 = acc[ai][bj][m][1] * rs;
                    u32x4 w; w.x = cvtpk(v0[0], v0[1]); w.y = cvtpk(v0[2], v0[3]); w.z = cvtpk(v1[0], v1[1]); w.w = cvtpk(v1[2], v1[3]);
                    st16_wt(x1b + off + bj * HALF, w);
                    { const f32x4 ga = *(const LAS f32x4*)(gtab + col0 + bj * HALF), gb = *(const LAS f32x4*)(gtab + col0 + bj * HALF + 4);
                      const f32x2_t u01 = (f32x2_t){bflo(w.x) * ga[0], bfhi(w.x) * ga[1]}, u23 = (f32x2_t){bflo(w.y) * ga[2], bfhi(w.y) * ga[3]}, u45 = (f32x2_t){bflo(w.z) * gb[0], bfhi(w.z) * gb[1]}, u67 = (f32x2_t){bflo(w.w) * gb[2], bfhi(w.w) * gb[3]};
                      int h0 = 0, h1 = 0; h0 = __builtin_amdgcn_cvt_pk_fp8_f32(u01.x, u01.y, h0, false); h0 = __builtin_amdgcn_cvt_pk_fp8_f32(u23.x, u23.y, h0, true); h1 = __builtin_amdgcn_cvt_pk_fp8_f32(u45.x, u45.y, h1, false); h1 = __builtin_amdgcn_cvt_pk_fp8_f32(u67.x, u67.y, h1, true);
                      const f32x2_t b01 = __builtin_amdgcn_cvt_pk_f32_fp8(h0, false), b23 = __builtin_amdgcn_cvt_pk_f32_fp8(h0, true), b45 = __builtin_amdgcn_cvt_pk_f32_fp8(h1, false), b67 = __builtin_amdgcn_cvt_pk_f32_fp8(h1, true);
                      int l0 = 0, l1 = 0; l0 = __builtin_amdgcn_cvt_pk_fp8_f32((u01.x - b01.x) * 16.f, (u01.y - b01.y) * 16.f, l0, false); l0 = __builtin_amdgcn_cvt_pk_fp8_f32((u23.x - b23.x) * 16.f, (u23.y - b23.y) * 16.f, l0, true);
                      l1 = __builtin_amdgcn_cvt_pk_fp8_f32((u45.x - b45.x) * 16.f, (u45.y - b45.y) * 16.f, l1, false); l1 = __builtin_amdgcn_cvt_pk_fp8_f32((u67.x - b67.x) * 16.f, (u67.y - b67.y) * 16.f, l1, true);
                      u32x2 qh, ql; qh.x = (unsigned)h0; qh.y = (unsigned)h1; ql.x = (unsigned)l0; ql.y = (unsigned)l1;
                      *(u32x2*)(xqh + off + bj * HALF) = qh; *(u32x2*)(xql + off + bj * HALF) = ql; }
                    ss += ((v0[0] * v0[0] + v0[1] * v0[1]) + (v0[2] * v0[2] + v0[3] * v0[3])) + ((v1[0] * v1[0] + v1[1] * v1[1]) + (v1[2] * v1[2] + v1[3] * v1[3])); }
                ss += __shfl_xor(ss, 16); ss += __shfl_xor(ss, 32);
                if (fq == 0) ssqx[(size_t)(u.pm * BM + r) * 16 + u.pn * 4 + wc] = ss; }
        }
    }
};

DI const char* pg8_sgpr_ptr(const char* p) { const unsigned long long v = (unsigned long long)p; const unsigned lo = __builtin_amdgcn_readfirstlane((unsigned)v), hi = __builtin_amdgcn_readfirstlane((unsigned)(v >> 32)); return (const char*)(((unsigned long long)hi << 32) | lo); }
template <class Epi, class Sched, bool ALIGN_EPI>
DI void gemm_phase(LAS unsigned char* lds, const Gemm g, const Sched& S, const Epi& E) {
    const int tid = threadIdx.x, wid = __builtin_amdgcn_readfirstlane(tid >> 6), lane = tid & 63, wr = wid >> 2, wc = wid & 3, fr = lane & 15, fq = lane >> 4;
    const int K = g.K, nx = g.nx, nt = K / BK + nx;
    unsigned voffA[2], voffB[2];
#pragma unroll
    for (int i = 0; i < 2; ++i) { int R, C; stage_rc(tid * 16 + i * 8192, R, C); const int Rb = Epi::PERM ? ((R & ~31) + perm32(R & 31)) : R;
        voffA[i] = (unsigned)(R * g.lda + C) * 2u; voffB[i] = (unsigned)(Rb * g.ldb + C) * 2u; }
    const size_t kstep = (size_t)(BK * 2);
    const size_t hstepA = (size_t)HALF * g.lda * 2, hstepB = (size_t)HALF * g.ldb * 2;
    const size_t tstepA = 2 * hstepA, tstepB = 2 * hstepB;
    const unsigned ldsw = (unsigned)wid * 1024u;
    const int aoff = lds_byte(wr * 64 + fr, fq * 8), boff = lds_byte(wc * 32 + fr, fq * 8);
#define PG8_SA(b, h) (((b) * 2 + (h)) * HTB)
#define PG8_SB(b, h) ((4 + (b) * 2 + (h)) * HTB)
#define PG8_STAGE(bufoff, gbase, voff) do { _Pragma("unroll") for (int _i = 0; _i < 2; ++_i) \
        __builtin_amdgcn_global_load_lds((const unsigned*)((const char*)(gbase) + (voff)[_i]), (LAS unsigned*)(lds + (bufoff) + ldsw + _i * 8192), 16, 0, 0); } while (0)
#define PG8_LDA(dst, b, h) do { _Pragma("unroll") for (int m = 0; m < 4; ++m) _Pragma("unroll") for (int k = 0; k < 2; ++k) dst[m][k] = *(const LAS bf16x8*)(lds + PG8_SA(b, h) + aoff + m * 2048 + k * 1024); } while (0)
#define PG8_LDB(dst, b, h) do { _Pragma("unroll") for (int n = 0; n < 2; ++n) _Pragma("unroll") for (int k = 0; k < 2; ++k) dst[n][k] = *(const LAS bf16x8*)(lds + PG8_SB(b, h) + boff + n * 2048 + k * 1024); } while (0)
#define PG8_MMA(ai, bj, At, Bt) do { __builtin_amdgcn_s_setprio(1); _Pragma("unroll") for (int m = 0; m < 4; ++m) _Pragma("unroll") for (int n = 0; n < 2; ++n) _Pragma("unroll") for (int k = 0; k < 2; ++k) \
        acc[ai][bj][m][n] = __builtin_amdgcn_mfma_f32_16x16x32_bf16(Bt[n][k], At[m][k], acc[ai][bj][m][n], 0, 0, 0); __builtin_amdgcn_s_setprio(0); } while (0)
#define PG8_WAIT_V(n) asm volatile("s_waitcnt vmcnt(" #n ")" ::: "memory")
#define PG8_WAIT_L(n) asm volatile("s_waitcnt lgkmcnt(" #n ")" ::: "memory")
#define PG8_BAR __builtin_amdgcn_s_barrier()
#define PG8_SCHED __builtin_amdgcn_sched_barrier(0)
    Unit cur, nxt; int ui = 0;
    if (!S.next(0, cur)) return;
    f32x4 acc[2][2][4][2];
#pragma unroll
    for (int a = 0; a < 2; ++a)
#pragma unroll
        for (int b = 0; b < 2; ++b)
#pragma unroll
            for (int m = 0; m < 4; ++m)
#pragma unroll
                for (int n = 0; n < 2; ++n) acc[a][b][m][n] = (f32x4){0.f, 0.f, 0.f, 0.f};
    bf16x8 At[4][2], B0[2][2], B1[2][2];
    const char* cA = (const char*)g.A + (size_t)cur.pm * tstepA; const char* cB = (const char*)g.Bt + (size_t)cur.pn * tstepB;
    const char* xB = (const char*)g.XBt;
    const char* xA = (const char*)g.XA + (size_t)cur.pm * tstepA + (size_t)cur.pn * (BM * 2);
#define PG8_SP(p) pg8_sgpr_ptr(p)
#define PG8_TA(t) PG8_SP((t) < nx ? xA + (size_t)(t) * kstep : cA + (size_t)((t) - nx) * kstep)
#define PG8_TB(t) PG8_SP((t) < nx ? xB + (size_t)(t) * kstep : cB + (size_t)((t) - nx) * kstep)
    { const char* a0 = PG8_TA(0); const char* b0 = PG8_TB(0); const char* a1p = PG8_TA(1); const char* b1p = PG8_TB(1);
    PG8_STAGE(PG8_SB(0, 0), b0, voffB); PG8_STAGE(PG8_SB(0, 1), b0 + hstepB, voffB); PG8_STAGE(PG8_SA(0, 0), a0, voffA); PG8_STAGE(PG8_SA(0, 1), a0 + hstepA, voffA);
    if (wr == 1) PG8_BAR;
    PG8_WAIT_V(2); PG8_BAR;
    PG8_STAGE(PG8_SB(1, 0), b1p, voffB); PG8_STAGE(PG8_SA(1, 0), a1p, voffA); PG8_STAGE(PG8_SB(1, 1), b1p + hstepB, voffB); }
    PG8_WAIT_V(6); PG8_BAR;
    for (;;) {
        const bool has_next = S.next(ui + 1, nxt);
        const char* nA = has_next ? (const char*)g.A + (size_t)nxt.pm * tstepA : cA; const char* nB = has_next ? (const char*)g.Bt + (size_t)nxt.pn * tstepB : cB;
        const char* nxA = has_next ? (const char*)g.XA + (size_t)nxt.pm * tstepA + (size_t)nxt.pn * (BM * 2) : xA;
        const char* n0A = nx ? nxA : nA; const char* n0B = nx ? xB : nB;
        for (int t = 0; t < nt; t += 2) {
            const bool last = (t == nt - 2);
            if constexpr (Epi::MID) { if (t == Epi::T_MID0) E.mid(acc, cur, wr, fr, lds, 0); if (t == Epi::T_MID1) E.mid(acc, cur, wr, fr, lds, 1); }
            const char* a1 = PG8_TA(t + 1);
            const char* a2 = PG8_SP(last ? n0A : PG8_TA(t + 2)); const char* b2 = PG8_SP(last ? n0B : PG8_TB(t + 2));
            const char* a3 = PG8_SP(last ? n0A + kstep : PG8_TA(t + 3)); const char* b3 = PG8_SP(last ? n0B + kstep : PG8_TB(t + 3));
            PG8_LDB(B0, 0, 0); PG8_LDB(B1, 0, 1); PG8_SCHED; PG8_LDA(At, 0, 0); PG8_STAGE(PG8_SA(1, 1), a1 + hstepA, voffA);
            PG8_WAIT_V(8); PG8_WAIT_L(0); PG8_BAR; PG8_MMA(0, 0, At, B0); PG8_MMA(0, 1, At, B1); PG8_BAR; PG8_SCHED;
            PG8_LDA(At, 0, 1); PG8_STAGE(PG8_SB(0, 0), b2, voffB); PG8_STAGE(PG8_SB(0, 1), b2 + hstepB, voffB); PG8_STAGE(PG8_SA(0, 0), a2, voffA);
            PG8_WAIT_V(8); PG8_WAIT_L(0); PG8_BAR; PG8_MMA(1, 0, At, B0); PG8_MMA(1, 1, At, B1); PG8_BAR; PG8_SCHED;
            PG8_LDB(B0, 1, 0); PG8_LDB(B1, 1, 1); PG8_SCHED; PG8_LDA(At, 1, 0); PG8_STAGE(PG8_SA(0, 1), a2 + hstepA, voffA);
            PG8_WAIT_V(8); PG8_WAIT_L(0); PG8_BAR; PG8_MMA(0, 0, At, B0); PG8_MMA(0, 1, At, B1); PG8_BAR; PG8_SCHED;
            PG8_LDA(At, 1, 1); PG8_STAGE(PG8_SB(1, 0), b3, voffB); PG8_STAGE(PG8_SB(1, 1), b3 + hstepB, voffB); PG8_STAGE(PG8_SA(1, 0), a3, voffA);
            PG8_WAIT_V(8); PG8_WAIT_L(0); PG8_BAR; PG8_MMA(1, 0, At, B0); PG8_MMA(1, 1, At, B1); PG8_BAR; PG8_SCHED;
        }
        if constexpr (ALIGN_EPI) { if (wr == 0) PG8_BAR; }
        E(acc, cur, wr, wc, fr, fq, lds);
        if (!has_next) break;
#pragma unroll
        for (int a = 0; a < 2; ++a)
#pragma unroll
            for (int b = 0; b < 2; ++b)
#pragma unroll
                for (int m = 0; m < 4; ++m)
#pragma unroll
                    for (int n = 0; n < 2; ++n) acc[a][b][m][n] = (f32x4){0.f, 0.f, 0.f, 0.f};
        cur = nxt; cA = nA; cB = nB; xA = nxA; ++ui;
        if constexpr (ALIGN_EPI) { if (wr == 1) PG8_BAR; }
    }
    PG8_WAIT_V(0);
    if constexpr (!ALIGN_EPI) { if (wr == 0) PG8_BAR; }
    PG8_BAR;
#undef PG8_SA
#undef PG8_SB
#undef PG8_STAGE
#undef PG8_LDA
#undef PG8_LDB
#undef PG8_MMA
#undef PG8_WAIT_V
#undef PG8_WAIT_L
#undef PG8_BAR
#undef PG8_SCHED
}
}

constexpr size_t MiB = 1u << 20;
constexpr size_t WS_CTL = 0, CTL_ZERO_BYTES = 1 * MiB;
constexpr size_t WS_KSUM = 512 * 1024;
constexpr size_t WS_RMS0 = 768 * 1024;
constexpr size_t WS_IDM = 15 * MiB;
constexpr size_t WS_K1 = 1 * MiB, WS_K2 = WS_K1 + 256 * 1024;
constexpr size_t WS_SSQA = WS_K1 + 512 * 1024;
constexpr size_t WS_WIN = 2 * MiB, WS_WOUT = 8 * MiB, WS_WQ = 10 * MiB;
constexpr size_t WS_SSQX = 14 * MiB;
constexpr size_t WS_XN = 16 * MiB;
constexpr size_t WS_PROJ = 48 * MiB;
constexpr size_t WS_QRY = 48 * MiB;
constexpr size_t WS_EIDX = 112 * MiB, WS_GATE = 120 * MiB;
constexpr size_t WS_Y = 144 * MiB;
constexpr size_t WS_XQH = 128 * MiB, WS_XQL = 240 * MiB;
constexpr size_t WS_CQ = 48 * MiB;
constexpr size_t WS_DELTA = 144 * MiB;
constexpr size_t WS_ED = 176 * MiB, WS_EU = 208 * MiB, WS_END = 256 * MiB;
constexpr int CW_BAR = 4096;

constexpr int SCR_BYTES = 151552;
constexpr int TAB_OFF = 131072;
constexpr int MISC_OFF = SCR_BYTES;
constexpr int LDS_BYTES = 155648;
constexpr int NWAVES = 8;

#define XB_TMO      128
#define XB_XCNT(j)  (256  + 64 * (j))
#define XB_XSUB(j)  (1280 + 64 * (j))
#define XB_XGEN(j)  (2304 + 64 * (j))
#define XB_TOP      3328
#define XB_TOPGEN   3392
#define XCD_BAR_WORDS 3456
#define XB_SPIN_CAP (1u << 18)
DI unsigned xb_ld(unsigned* p)              { return __hip_atomic_load(p, __ATOMIC_RELAXED, __HIP_MEMORY_SCOPE_AGENT); }
DI unsigned xb_add(unsigned* p, unsigned v) { return __hip_atomic_fetch_add(p, v, __ATOMIC_RELAXED, __HIP_MEMORY_SCOPE_AGENT); }
DI unsigned xb_xcc_id() { return (unsigned)__builtin_amdgcn_s_getreg((3 << 11) | 20) & 0xFu; }
#define XB_SPIN(cond, bar) do { unsigned _sp = 0; while (cond) { __builtin_amdgcn_s_sleep(1); \
    if ((++_sp & 255u) == 0u) { if (xb_ld(&(bar)[XB_TMO])) break; if (_sp > XB_SPIN_CAP) { atomicAdd(&(bar)[XB_TMO], 1u); break; } } } } while (0)
struct XcdBarrier { unsigned* bar; unsigned x; volatile LAS unsigned* st; };
DI XcdBarrier xcd_barrier_post(unsigned* bar, volatile LAS unsigned* st) {
    XcdBarrier b; b.bar = bar; b.x = xb_xcc_id(); b.st = st;
    if (threadIdx.x == 0) st[3] = xb_add(&bar[XB_XCNT(b.x)], 1u);
    return b;
}
DI void xcd_barrier_complete(unsigned* bar, unsigned x, unsigned& nloc, unsigned& nx, unsigned& ord) {
    const unsigned G = gridDim.x * gridDim.y * gridDim.z;
    unsigned sum, cnt, mine, below, sp = 0u;
    for (;;) {
        sum = 0u; cnt = 0u; mine = 0u; below = 0u;
#pragma unroll
        for (unsigned j = 0; j < 16; ++j) { const unsigned c = xb_ld(&bar[XB_XCNT(j)]); sum += c; cnt += (c > 0u) ? 1u : 0u; mine = (j == x) ? c : mine; below += (c > 0u && j < x) ? 1u : 0u; }
        if (sum == G) break;
        __builtin_amdgcn_s_sleep(1);
        if ((++sp & 255u) == 0u) { if (xb_ld(&bar[XB_TMO])) break; if (sp > XB_SPIN_CAP) { atomicAdd(&bar[XB_TMO], 1u); break; } }
    }
    nloc = mine > 0u ? mine : 1u; nx = cnt > 0u ? cnt : 1u; ord = below;
}
DI void xcd_barrier(const XcdBarrier& b) {
    asm volatile("s_waitcnt vmcnt(0)" ::: "memory");
    __syncthreads();
    if (threadIdx.x == 0) {
        unsigned* bar = b.bar;
        __builtin_amdgcn_s_waitcnt(0);
        unsigned nloc = b.st[0], nx = b.st[1];
        if (nloc == 0u) { unsigned ord; xcd_barrier_complete(bar, b.x, nloc, nx, ord); b.st[0] = nloc; b.st[1] = nx; b.st[2] = ord; }
        const unsigned old = xb_add(&bar[XB_XSUB(b.x)], 1u);
        const unsigned gen = old / nloc;
        if (old + 1u == (gen + 1u) * nloc) {
            __builtin_amdgcn_fence(__ATOMIC_RELEASE, "agent");
            asm volatile("s_waitcnt vmcnt(0)" ::: "memory");
            const unsigned og = xb_add(&bar[XB_TOP], 1u);
            const unsigned tg = og / nx;
            if (og + 1u == (tg + 1u) * nx) xb_add(&bar[XB_TOPGEN], 1u);
            else XB_SPIN(xb_ld(&bar[XB_TOPGEN]) == tg, bar);
            __builtin_amdgcn_fence(__ATOMIC_ACQUIRE, "agent");
            xb_add(&bar[XB_XGEN(b.x)], 1u);
            asm volatile("s_waitcnt vmcnt(0)" ::: "memory");
        } else {
            XB_SPIN(xb_ld(&bar[XB_XGEN(b.x)]) == gen, bar);
            __builtin_amdgcn_fence(__ATOMIC_ACQUIRE, "agent");
            asm volatile("s_waitcnt vmcnt(0)" ::: "memory");
        }
    }
    __syncthreads();
}

struct Frame {
    LAS unsigned char* lds;
    int tid, lane, wave, vcu, G;
};
struct Args { const float* in[14]; float* out; unsigned char* ws; int ph_lo, ph_hi, li, pad; };

DI void p0_transpose_item(const float* W, int K, int N, bf16_t* WT, const float* sc_lo, const float* sc_hi, int split, LAS float* scr, int item, int lane) {
    const int nblk = N / 32, kb = item / nblk, nb = item % nblk, k0 = 64 * kb, n0 = 32 * nb;
#pragma unroll 16
    for (int i = 0; i < 32; ++i) { const int kk = 2 * i + (lane >> 5); const int k = k0 + kk;
        float s = 1.0f; if (sc_lo) s = (k < split) ? sc_lo[k] : sc_hi[k - split];
        scr[kk * 33 + (lane & 31)] = W[(size_t)k * N + n0 + (lane & 31)] * s; }
    asm volatile("s_waitcnt lgkmcnt(0)" ::: "memory");
    const int c = lane & 7;
#pragma unroll
    for (int j = 0; j < 4; ++j) { const int n = (lane >> 3) + 8 * j; const LAS float* s = scr + (8 * c) * 33 + n;
        u32x4 o; o.x = cvtpk(s[0 * 33], s[1 * 33]); o.y = cvtpk(s[2 * 33], s[3 * 33]); o.z = cvtpk(s[4 * 33], s[5 * 33]); o.w = cvtpk(s[6 * 33], s[7 * 33]);
        st16_wt(WT + (size_t)(n0 + n) * K + k0 + 8 * c, o); }
    asm volatile("s_waitcnt lgkmcnt(0)" ::: "memory");
}
DI void p0_cvt_item(const float* src, bf16_t* dst, size_t item, int lane) {
    const f32x4* s = (const f32x4*)(src + item * 512) + 2 * lane;
    const f32x4 a = s[0], b = s[1];
    u32x4 o; o.x = cvtpk(a[0], a[1]); o.y = cvtpk(a[2], a[3]); o.z = cvtpk(b[0], b[1]); o.w = cvtpk(b[2], b[3]);
    *((u32x4*)(dst + item * 512) + lane) = o;
}
DI void p0_cvt8_item(const float* src, unsigned char* dst, size_t item, int lane, float sc) {
    const f32x4* s = (const f32x4*)(src + item * 512) + 2 * lane;
    const f32x4 a = s[0] * sc, b = s[1] * sc;
    int w0 = 0, w1 = 0;
    w0 = __builtin_amdgcn_cvt_pk_fp8_f32(a[0], a[1], w0, false); w0 = __builtin_amdgcn_cvt_pk_fp8_f32(a[2], a[3], w0, true);
    w1 = __builtin_amdgcn_cvt_pk_fp8_f32(b[0], b[1], w1, false); w1 = __builtin_amdgcn_cvt_pk_fp8_f32(b[2], b[3], w1, true);
    u32x2 o; o.x = (unsigned)w0; o.y = (unsigned)w1;
    *((u32x2*)(dst + item * 512) + lane) = o;
}
template <int U> struct CvtRegs { f32x4 a[U][2]; };
template <int U> DI void cvt8_load(CvtRegs<U>& r, const float* src, size_t item0, int lane) {
#pragma unroll
    for (int u = 0; u < U; ++u) { const f32x4* s = (const f32x4*)(src + (item0 + u) * 512) + 2 * lane; r.a[u][0] = __builtin_nontemporal_load(s); r.a[u][1] = __builtin_nontemporal_load(s + 1); }
}
template <int U> DI void cvt8_store(const CvtRegs<U>& r, unsigned char* dst, size_t item0, int lane, float sc, const float* colg) {
#pragma unroll
    for (int u = 0; u < U; ++u) { const size_t it = item0 + u; const int e = (int)(it >> 1), hh = (int)(it & 1), col = 512 * hh + 8 * lane;
        f32x4 x = r.a[u][0] * sc, y = r.a[u][1] * sc;
        if (colg) { x = x * *(const f32x4*)(colg + col); y = y * *(const f32x4*)(colg + col + 4); }
        int w0 = 0, w1 = 0;
        w0 = __builtin_amdgcn_cvt_pk_fp8_f32(x[0], x[1], w0, false); w0 = __builtin_amdgcn_cvt_pk_fp8_f32(x[2], x[3], w0, true);
        w1 = __builtin_amdgcn_cvt_pk_fp8_f32(y[0], y[1], w1, false); w1 = __builtin_amdgcn_cvt_pk_fp8_f32(y[2], y[3], w1, true);
        u32x2 o; o.x = (unsigned)w0; o.y = (unsigned)w1;
        *(u32x2*)(dst + (size_t)(col >> 7) * ((size_t)NEXP * 128) + (size_t)e * 128 + (col & 127)) = o; }
}
template <int U> DI void p0_xn_rows(const float* x, const float* g, bf16_t* xn, float* rms0, int row0, int lane) {
    f32x4 v[U][4];
#pragma unroll
    for (int u = 0; u < U; ++u)
#pragma unroll
        for (int j = 0; j < 4; ++j) v[u][j] = __builtin_nontemporal_load((const f32x4*)(x + (size_t)(row0 + u) * DM) + lane + 64 * j);
    f32x4 gg[4];
#pragma unroll
    for (int j = 0; j < 4; ++j) gg[j] = *((const f32x4*)g + lane + 64 * j);
#pragma unroll
    for (int u = 0; u < U; ++u) { float s = 0.f;
#pragma unroll
        for (int j = 0; j < 4; ++j) s += (v[u][j][0] * v[u][j][0] + v[u][j][1] * v[u][j][1]) + (v[u][j][2] * v[u][j][2] + v[u][j][3] * v[u][j][3]);
        const float rstd = 1.0f / sqrtf(wave_sum(s) * (1.f / DM) + EPS);
        u32x2* o8 = (u32x2*)(xn + (size_t)(row0 + u) * DM) + lane;
#pragma unroll
        for (int j = 0; j < 4; ++j) { u32x2 w; w.x = cvtpk(v[u][j][0] * rstd, v[u][j][1] * rstd); w.y = cvtpk(v[u][j][2] * rstd, v[u][j][3] * rstd); st8_wt(o8 + 64 * j, w); }
        if (lane == 0) st4_wt(rms0 + row0 + u, __float_as_uint(1.0f / rstd)); }
}
DI void p0_xn_row(const float* xrow, const float* g, bf16_t* orow, int lane) {
    const f32x4* xr = (const f32x4*)xrow + lane; const f32x4* gr = (const f32x4*)g + lane;
    f32x4 v[4]; float s = 0.f;
#pragma unroll
    for (int j = 0; j < 4; ++j) { v[j] = xr[64 * j]; s += (v[j][0] * v[j][0] + v[j][1] * v[j][1]) + (v[j][2] * v[j][2] + v[j][3] * v[j][3]); }
    const float rstd = 1.0f / sqrtf(wave_sum(s) * (1.f / DM) + EPS);
    u32x2* o8 = (u32x2*)orow + lane;
#pragma unroll
    for (int j = 0; j < 4; ++j) { const f32x4 gg = gr[64 * j]; u32x2 w; w.x = cvtpk(v[j][0] * rstd * gg[0], v[j][1] * rstd * gg[1]); w.y = cvtpk(v[j][2] * rstd * gg[2], v[j][3] * rstd * gg[3]); o8[64 * j] = w; }
}

namespace att {
DI void conv_rows4(const bf16_t* proj, const float* cw, bf16_t* Y, int r0, int lane) {
    const int ch = 8 * lane; const bool head = (r0 & (SEQ - 1)) == 0;
    const bf16_t* pr = proj + (size_t)r0 * DPROJ + ch;
    u32x4 bg[4], cg[6], hc[6];
#pragma unroll
    for (int i = 0; i < 4; ++i) bg[i] = *(const u32x4*)(pr + (size_t)i * DPROJ);
#pragma unroll
    for (int q = 0; q < 6; ++q) { cg[q] = (u32x4){0u, 0u, 0u, 0u}; hc[q] = (u32x4){0u, 0u, 0u, 0u};
        if (q >= 2 || !head) { cg[q] = *(const u32x4*)(pr + ((ptrdiff_t)q - 2) * DPROJ + 512); hc[q] = *(const u32x4*)(pr + ((ptrdiff_t)q - 2) * DPROJ + 1024); } }
    f32x4 w[3][2];
#pragma unroll
    for (int k = 0; k < 3; ++k) { w[k][0] = *(const f32x4*)(cw + k * 512 + ch); w[k][1] = *(const f32x4*)(cw + k * 512 + ch + 4); }
    float u[6][8];
#pragma unroll
    for (int q = 0; q < 6; ++q)
#pragma unroll
        for (int j = 0; j < 4; ++j) { u[q][2 * j] = bflo(cg[q][j]) * bflo(hc[q][j]); u[q][2 * j + 1] = bfhi(cg[q][j]) * bfhi(hc[q][j]); }
#pragma unroll
    for (int i = 0; i < 4; ++i) {
        float acc[8]; float ss = 0.f;
#pragma unroll
        for (int e = 0; e < 8; ++e) { float a = 0.f;
#pragma unroll
            for (int k = 0; k < 3; ++k) a += w[k][e >> 2][e & 3] * u[i + k][e];
            const float b = (e & 1) ? bfhi(bg[i][e >> 1]) : bflo(bg[i][e >> 1]);
            acc[e] = a * b; ss += acc[e] * acc[e]; }
        const float rstd = 1.0f / sqrtf(wave_sum(ss) * (1.f / 512.f) + EPS);
        u32x4 o; o.x = cvtpk(acc[0] * rstd, acc[1] * rstd); o.y = cvtpk(acc[2] * rstd, acc[3] * rstd); o.z = cvtpk(acc[4] * rstd, acc[5] * rstd); o.w = cvtpk(acc[6] * rstd, acc[7] * rstd);
        st16_wt(Y + (size_t)(r0 + i) * DM + ch, o);
    }
}
DI void conv_rows8(const bf16_t* proj, const float* cw, bf16_t* Y, int r0, int lane_) {
    int lane; asm volatile("v_mbcnt_lo_u32_b32 %0, -1, 0\n\tv_mbcnt_hi_u32_b32 %0, -1, %0" : "=v"(lane)); (void)lane_;
    const int ch = 8 * lane; const bool head = (r0 & (SEQ - 1)) == 0;
    const bf16_t* pr = proj + (size_t)r0 * DPROJ + ch;
    u32x4 bg[8], cg[10], hc[10];
#pragma unroll
    for (int i = 0; i < 8; ++i) bg[i] = *(const u32x4*)(pr + (size_t)i * DPROJ);
#pragma unroll
    for (int q = 0; q < 10; ++q) { cg[q] = (u32x4){0u, 0u, 0u, 0u}; hc[q] = (u32x4){0u, 0u, 0u, 0u};
        if (q >= 2 || !head) { cg[q] = *(const u32x4*)(pr + ((ptrdiff_t)q - 2) * DPROJ + 512); hc[q] = *(const u32x4*)(pr + ((ptrdiff_t)q - 2) * DPROJ + 1024); } }
    f32x4 w[3][2];
#pragma unroll
    for (int k = 0; k < 3; ++k) { w[k][0] = *(const f32x4*)(cw + k * 512 + ch); w[k][1] = *(const f32x4*)(cw + k * 512 + ch + 4); }
#pragma unroll
    for (int i = 0; i < 8; ++i) {
        float acc[8]; float ss = 0.f;
#pragma unroll
        for (int e = 0; e < 8; ++e) { float a = 0.f;
#pragma unroll
            for (int k = 0; k < 3; ++k) { const unsigned cw_ = cg[i + k][e >> 1], hw_ = hc[i + k][e >> 1]; const float uu = (e & 1) ? bfhi(cw_) * bfhi(hw_) : bflo(cw_) * bflo(hw_); a += w[k][e >> 2][e & 3] * uu; }
            const float b = (e & 1) ? bfhi(bg[i][e >> 1]) : bflo(bg[i][e >> 1]);
            acc[e] = a * b; ss += acc[e] * acc[e]; }
        const float rstd = 1.0f / sqrtf(wave_sum(ss) * (1.f / 512.f) + EPS);
        u32x4 o; o.x = cvtpk(acc[0] * rstd, acc[1] * rstd); o.y = cvtpk(acc[2] * rstd, acc[3] * rstd); o.z = cvtpk(acc[4] * rstd, acc[5] * rstd); o.w = cvtpk(acc[6] * rstd, acc[7] * rstd);
        st16_wt(Y + (size_t)(r0 + i) * DM + ch, o);
        __builtin_amdgcn_sched_barrier(0);
    }
}
}

namespace att2 {
using bf16=__hip_bfloat16;
using bf16x8=__attribute__((ext_vector_type(8)))short;
using s16x4=__attribute__((ext_vector_type(4)))short;
using f32x16=__attribute__((ext_vector_type(16)))float;
using u32x4=__attribute__((ext_vector_type(4)))unsigned;
constexpr int BATCH=8,NHEAD=8,SEQ=2048,D=64,PQ=3072,PO=1024;
constexpr int NW=8,QBLK=32,QB=QBLK*NW,KVBLK=64,NQB=SEQ/QB;
__device__ __forceinline__ int crow(int r,int hi){return (r&3)+8*(r>>2)+4*hi;}
#define SBAR() __builtin_amdgcn_sched_barrier(0)
__device__ __forceinline__ void cmask(f32x16&p0,f32x16&p1,int jb,int qrel,int hi){
  const float NEG=-INFINITY; int kb=64*jb+4*hi;
  #pragma unroll
  for(int r=0;r<16;++r){int kv=kb+(r&3)+8*(r>>2); if(kv>qrel)p0[r]=NEG; if(kv+32>qrel)p1[r]=NEG;}
}

constexpr int NSLOT=3, SLOTB=8192;
constexpr int LDS_K=0, LDS_V=NSLOT*SLOTB, LDS_WS=2*NSLOT*SLOTB, LDS_OST=LDS_WS+NW*64*4, LDS_KM=LDS_OST+NW*4096, LDS_BYTES=LDS_KM+2048;
constexpr float C2=0.125f*1.4426950408889634f;
__device__ __forceinline__ void glds16(const void*gsrc,unsigned lds_dst){unsigned keep;
  asm volatile("s_mov_b32 %0, m0\n\ts_mov_b32 m0, %2\n\ts_nop 0\n\tglobal_load_lds_dwordx4 %1, off\n\ts_mov_b32 m0, %0":"=&s"(keep):"v"(gsrc),"s"(lds_dst):"memory");}
__device__ __forceinline__ float max3f(float a,float b,float c){float r;asm("v_max3_f32 %0, %1, %2, %3":"=v"(r):"v"(a),"v"(b),"v"(c));return r;}
__device__ __forceinline__ float max2f(float a,float b){float r;asm("v_max_f32_e32 %0, %1, %2":"=v"(r):"v"(a),"v"(b));return r;}
__device__ __forceinline__ float fadd_s(float a,float b){float r;asm("v_add_f32_e32 %0, %1, %2":"=v"(r):"v"(a),"v"(b));return r;}
__device__ __forceinline__ float fsub_s(float a,float b){float r;asm("v_sub_f32_e32 %0, %1, %2":"=v"(r):"v"(a),"v"(b));return r;}
typedef float f32x2_t __attribute__((ext_vector_type(2))); typedef __bf16 bf16x2_t __attribute__((ext_vector_type(2)));
__device__ __forceinline__ unsigned cvtpk_s(float lo,float hi){f32x2_t v={lo,hi};bf16x2_t b=__builtin_convertvector(v,bf16x2_t);return __builtin_bit_cast(unsigned,b);}
#define WAIT_BAR(N) asm volatile("s_waitcnt vmcnt(" #N ") lgkmcnt(0)\n\ts_barrier":::"memory")

__device__ __forceinline__ void qkt(f32x16&p0,f32x16&p1,const char*Kslot,const bf16x8*qr,const f32x16&negm,int r32,int hi){
  const char*kb=Kslot+hi*1024+r32*16;
  #pragma unroll
  for(int d0=0;d0<4;++d0){
    const bf16x8 b0=*reinterpret_cast<const bf16x8*>(kb+d0*2048);
    const bf16x8 b1=*reinterpret_cast<const bf16x8*>(kb+d0*2048+512);
    if(d0==0){p0=__builtin_amdgcn_mfma_f32_32x32x16_bf16(b0,qr[0],negm,0,0,0);p1=__builtin_amdgcn_mfma_f32_32x32x16_bf16(b1,qr[0],negm,0,0,0);}
    else{p0=__builtin_amdgcn_mfma_f32_32x32x16_bf16(b0,qr[d0],p0,0,0,0);p1=__builtin_amdgcn_mfma_f32_32x32x16_bf16(b1,qr[d0],p1,0,0,0);}}
}
typedef __attribute__((address_space(3))) const char* lds_cptr;
typedef short v4i16_t __attribute__((ext_vector_type(4)));
__device__ __forceinline__ void kload8(bf16x8*kf,lds_cptr kp){
  kf[0]=*(const __attribute__((address_space(3))) bf16x8*)(kp);      kf[1]=*(const __attribute__((address_space(3))) bf16x8*)(kp+512);
  kf[2]=*(const __attribute__((address_space(3))) bf16x8*)(kp+2048); kf[3]=*(const __attribute__((address_space(3))) bf16x8*)(kp+2560);
  kf[4]=*(const __attribute__((address_space(3))) bf16x8*)(kp+4096); kf[5]=*(const __attribute__((address_space(3))) bf16x8*)(kp+4608);
  kf[6]=*(const __attribute__((address_space(3))) bf16x8*)(kp+6144); kf[7]=*(const __attribute__((address_space(3))) bf16x8*)(kp+6656);
}
__device__ __forceinline__ void kload2(bf16x8*kf,lds_cptr kp,int j){ kf[2*j]=*(const __attribute__((address_space(3))) bf16x8*)(kp+j*2048); kf[2*j+1]=*(const __attribute__((address_space(3))) bf16x8*)(kp+j*2048+512); }
__device__ __forceinline__ s16x4 vtr(lds_cptr p){ return __builtin_bit_cast(s16x4,__builtin_amdgcn_ds_read_tr16_b64_v4i16((__attribute__((address_space(3))) v4i16_t*)p)); }
__device__ __forceinline__ float rowmax(const f32x16&p0,const f32x16&p1){
  float a=max3f(p0[0],p0[1],p1[0]),b=max3f(p0[2],p0[3],p1[1]);a=max3f(a,p1[2],p1[3]);
  #pragma unroll
  for(int r=4;r<16;r+=4){a=max3f(a,p0[r],p0[r+1]);b=max3f(b,p0[r+2],p0[r+3]);a=max3f(a,p1[r],p1[r+1]);b=max3f(b,p1[r+2],p1[r+3]);}
  const float m=max2f(a,b);
  auto rr=__builtin_amdgcn_permlane32_swap(__float_as_uint(m),__float_as_uint(m),false,false);
  return max2f(__uint_as_float(rr[0]),__uint_as_float(rr[1]));
}
__device__ __forceinline__ void pv(f32x16*o,int vb,bf16x8 pa0,bf16x8 pa1,bf16x8 pa2,bf16x8 pa3){
  #pragma unroll
  for(int d0=0;d0<2;++d0){s16x4 lo[4],hi[4];
    #pragma unroll
    for(int ks=0;ks<4;++ks){
      asm volatile("ds_read_b64_tr_b16 %0,%1 offset:%c2":"=&v"(lo[ks]):"v"(vb),"i"(d0*4096+ks*1024):"memory");
      asm volatile("ds_read_b64_tr_b16 %0,%1 offset:%c2":"=&v"(hi[ks]):"v"(vb),"i"(d0*4096+ks*1024+512):"memory");}
    asm volatile("s_waitcnt lgkmcnt(0)":::"memory");SBAR();
    #define PK(k) (bf16x8){lo[k][0],lo[k][1],lo[k][2],lo[k][3],hi[k][0],hi[k][1],hi[k][2],hi[k][3]}
    o[d0]=__builtin_amdgcn_mfma_f32_32x32x16_bf16(pa0,PK(0),o[d0],0,0,0);
    o[d0]=__builtin_amdgcn_mfma_f32_32x32x16_bf16(pa1,PK(1),o[d0],0,0,0);
    o[d0]=__builtin_amdgcn_mfma_f32_32x32x16_bf16(pa2,PK(2),o[d0],0,0,0);
    o[d0]=__builtin_amdgcn_mfma_f32_32x32x16_bf16(pa3,PK(3),o[d0],0,0,0);
    #undef PK
  }
}

#ifndef ATTN_STORE16
#define ATTN_STORE16(p,v) st16_wt((void*)(p),(v))
#endif
template<int THRL> __device__ __forceinline__ void attn_unit(int b,int h,int qb,const bf16*Q,const bf16*__restrict__ K,const bf16*__restrict__ V,bf16*O,const float*ksum,float*ssqa,char*shm){
  int lane; asm volatile("v_mbcnt_lo_u32_b32 %0, -1, 0\n\tv_mbcnt_hi_u32_b32 %0, -1, %0":"=v"(lane));     const int tid=threadIdx.x,r32=lane&31,hi=lane>>5; const int wid=__builtin_amdgcn_readfirstlane(tid>>6);
  const long rowbase=(long)b*SEQ; const int q0=qb*QB;
  const bf16*Qw=Q+(rowbase+q0+wid*QBLK)*PQ+h*D;
  const bf16*Kh=K+rowbase*PQ+h*D,*Vh=V+rowbase*PQ+h*D;
  const unsigned lds0=(unsigned)(uintptr_t)shm;
  float*wsf=(float*)(shm+LDS_WS)+wid*64;
  const bf16*ksrc=Kh+(long)lane*PQ+wid*8;
  const bf16*vsrc=Vh+(long)(16*(wid&3)+(lane>>2))*PQ+(wid>>2)*32+(lane&3)*8;
  const unsigned kdst=lds0+LDS_K+wid*1024, vdst=lds0+LDS_V+wid*1024;
  #define DMA_K(t,slot) glds16(ksrc+(long)(t)*KVBLK*PQ,(unsigned)__builtin_amdgcn_readfirstlane(kdst+(slot)))
  #define DMA_V(t,slot) glds16(vsrc+(long)(t)*KVBLK*PQ,(unsigned)__builtin_amdgcn_readfirstlane(vdst+(slot)))
  const int vb0=(int)(lds0+LDS_V)+((lane>>4)&1)*32+(lane&3)*8+(4*hi+((lane&15)>>2))*64;
  const char*Kbase=shm+LDS_K; bf16x8 kf[8];
  const lds_cptr shm3=(lds_cptr)shm; const lds_cptr kp0=shm3+LDS_K+hi*1024+r32*16; const lds_cptr vp0=shm3+LDS_V+((lane>>4)&1)*32+(lane&3)*8+(4*hi+((lane&15)>>2))*64;
  const int NT=(q0+QB)/KVBLK;
  DMA_K(0,0);DMA_V(0,0);DMA_K(1,SLOTB);
  bf16x8 qr[4];
  #pragma unroll
  for(int d0=0;d0<4;++d0)qr[d0]=*reinterpret_cast<const bf16x8*>(&Qw[(long)r32*PQ+d0*16+hi*8]);
  unsigned selmask=(1u<<qb)-1u;
  { __attribute__((address_space(3))) float*km=(__attribute__((address_space(3))) float*)(shm+LDS_KM);
    if(tid<64*qb)km[tid]=ksum[(long)(b*8+(tid>>6))*512+h*64+(tid&63)];
    __syncthreads();
    if(qb>3){ float gt[7];
      #pragma unroll
      for(int n=0;n<7;++n){ float a=-3.0e38f;
        if(n<qb){ a=0.f;
          #pragma unroll
          for(int s=0;s<4;++s)
            #pragma unroll
            for(int j=0;j<8;++j)a+=__uint_as_float(((unsigned)(unsigned short)qr[s][j])<<16)*km[n*64+16*s+8*hi+j];
          a+=__shfl_xor(a,32); }
        gt[n]=a; }
      selmask=0u;
      #pragma unroll
      for(int n=0;n<7;++n){ int cnt=0;
        #pragma unroll
        for(int m2=0;m2<7;++m2)if(m2!=n)cnt+=(gt[m2]>gt[n]||(gt[m2]==gt[n]&&m2<n))?1:0;
        if(cnt<3&&n<qb)selmask|=1u<<n; } }
    __syncthreads(); }
  #define MMASK(P0,P1,t) do{ const int blk_=(t)>>2; if(blk_<qb&&!((selmask>>blk_)&1u)){ _Pragma("unroll") for(int r=0;r<16;++r){P0[r]=-1.0e30f;P1[r]=-1.0e30f;} } }while(0)
  float mhat=0.f,l_reg=0.f;f32x16 o[2];o[0]=f32x16{};o[1]=f32x16{};const f32x16 negm=f32x16{};
  const int qrel=wid*QBLK+r32;
  #define CMASK(P0,P1,t) do{int jb_=(t)-(NT-4); if(jb_>=0)cmask(P0,P1,jb_,qrel,hi);}while(0)
  bool resc=false;
  #define START(P0,P1) do{ const float rm=max2f(rowmax(P0,P1),-1000.0f); resc=false; \
    { const float dl=rm; mhat=fadd_s(mhat,dl); \
      _Pragma("unroll") for(int r=0;r<16;++r){P0[r]=fsub_s(P0[r],dl);P1[r]=fsub_s(P1[r],dl);} \
      } \
    _Pragma("unroll") for(int r=0;r<16;++r)P0[r]=__builtin_amdgcn_exp2f(P0[r]); }while(0)
  #define RESC() do{ if(resc){ asm volatile("s_waitcnt lgkmcnt(0)":::"memory"); \
      _Pragma("unroll") for(int d_=0;d_<2;++d_) _Pragma("unroll") for(int r=0;r<16;++r)o[d_][r]*=wsf[crow(r,hi)]; } }while(0)
  f32x16 pA0,pA1,pB0,pB1;
  int sl_prev=0,sl_cur=0,sl_next=SLOTB;
  #define ROT() do{sl_prev=sl_cur;sl_cur=sl_next;sl_next=(sl_next==(NSLOT-1)*SLOTB)?0:sl_next+SLOTB;}while(0)
  DMA_K(2,2*SLOTB);
  WAIT_BAR(3);
  qkt(pA0,pA1,Kbase,qr,negm,r32,hi);asm volatile("s_nop 15\n\ts_nop 7":"+v"(pA0),"+v"(pA1));CMASK(pA0,pA1,0);MMASK(pA0,pA1,0);
  START(pA0,pA1);
  _Pragma("unroll") for(int r=0;r<16;++r)pA1[r]=__builtin_amdgcn_exp2f(pA1[r]);
  WAIT_BAR(0);
  DMA_K(3,0);DMA_V(1,SLOTB);
  ROT();
  kload8(kf,kp0+sl_cur);
  WAIT_BAR(2);
  s16x4 vlo[8],vhi[8]; u32x4 pw0,pw1,pw2,pw3;
  #define PKW(P,B) cvtpk_s(P[B],P[B+1])
  #define PAF(k) __builtin_bit_cast(bf16x8,pw##k)
  #define VFR(i) (bf16x8){vlo[i][0],vlo[i][1],vlo[i][2],vlo[i][3],vhi[i][0],vhi[i][1],vhi[i][2],vhi[i][3]}
  #define PIN(x) asm volatile("":"+v"(x))
  #define MX3(a,b,c) __builtin_fmaxf(__builtin_fmaxf((a),(b)),(c))
  #define GAPA(MF,A0,A1,A2,A3,W0,W1,PW) do{ MF; sacc+=A0; sacc+=A1; sacc+=A2; sacc+=A3; PIN(sacc); W0; W1; PIN(PW); SBAR(); }while(0)
  #define EX(v) __builtin_amdgcn_exp2f(v)
  #define GAPB(MF,X,B) do{ MF; X[B]=EX(X[B]); X[B+1]=EX(X[B+1]); X[B+2]=EX(X[B+2]); X[B+3]=EX(X[B+3]); PIN(X); SBAR(); }while(0)
  #define VRD(i) do{ vlo[i]=vtr(vp_+(((i)>>2)*4096+((i)&3)*1024)); vhi[i]=vtr(vp_+(((i)>>2)*4096+((i)&3)*1024+512)); }while(0)
  #define KRD(G,j) do{ if(G){ kload2(kf,kp0+sl_next,j); SBAR(); } }while(0)
  #define STEP(C0,C1,P0,P1,t,GK,GV,GL) do{ SBAR(); \
    const lds_cptr vp_=vp0+sl_prev; \
    VRD(0); SBAR(); float sacc=(P0[0]+P0[1]); \
    GAPA(C0=__builtin_amdgcn_mfma_f32_32x32x16_bf16(kf[0],qr[0],negm,0,0,0), P0[2],P0[3],P0[4],P0[5],     pw0[0]=PKW(P0,0), pw0[1]=PKW(P0,2), pw0); \
    VRD(4); SBAR(); GAPA(C1=__builtin_amdgcn_mfma_f32_32x32x16_bf16(kf[1],qr[0],negm,0,0,0), P0[6],P0[7],P0[8],P0[9],     pw0[2]=PKW(P0,4), pw0[3]=PKW(P0,6), pw0); \
    VRD(1); SBAR(); GAPA(C0=__builtin_amdgcn_mfma_f32_32x32x16_bf16(kf[2],qr[1],C0,0,0,0),   P0[10],P0[11],P0[12],P0[13], pw1[0]=PKW(P0,8), pw1[1]=PKW(P0,10), pw1); \
    VRD(5); SBAR(); GAPA(C1=__builtin_amdgcn_mfma_f32_32x32x16_bf16(kf[3],qr[1],C1,0,0,0),   P0[14],P0[15],P1[0],P1[1],   pw1[2]=PKW(P0,12),pw1[3]=PKW(P0,14), pw1); \
    VRD(2); SBAR(); GAPA(C0=__builtin_amdgcn_mfma_f32_32x32x16_bf16(kf[4],qr[2],C0,0,0,0),   P1[2],P1[3],P1[4],P1[5],     pw2[0]=PKW(P1,0), pw2[1]=PKW(P1,2), pw2); \
    VRD(6); SBAR(); GAPA(C1=__builtin_amdgcn_mfma_f32_32x32x16_bf16(kf[5],qr[2],C1,0,0,0),   P1[6],P1[7],P1[8],P1[9],     pw2[2]=PKW(P1,4), pw2[3]=PKW(P1,6), pw2); \
    VRD(3); SBAR(); GAPA(C0=__builtin_amdgcn_mfma_f32_32x32x16_bf16(kf[6],qr[3],C0,0,0,0),   P1[10],P1[11],P1[12],P1[13], pw3[0]=PKW(P1,8), pw3[1]=PKW(P1,10), pw3); \
    VRD(7); SBAR(); GAPA(C1=__builtin_amdgcn_mfma_f32_32x32x16_bf16(kf[7],qr[3],C1,0,0,0),   P1[14],P1[15],0.f,0.f,       pw3[2]=PKW(P1,12),pw3[3]=PKW(P1,14), pw3); \
    l_reg+=sacc; \
    if(GK){DMA_K((t)+3,sl_cur);} if(GV){DMA_V((t)+1,sl_next);} \
    { const int blk_=(t)>>2; const float ms_=(blk_<qb&&!((selmask>>blk_)&1u))?1.0e30f:mhat;     \
      _Pragma("unroll") for(int r=0;r<16;++r){C0[r]-=ms_;C1[r]-=ms_;} } \
    CMASK(C0,C1,t); \
    { float a=MX3(C0[0],C0[1],C1[0]),b=MX3(C0[2],C0[3],C1[1]); a=MX3(a,C1[2],C1[3]); \
      _Pragma("unroll") for(int r=4;r<16;r+=4){a=MX3(a,C0[r],C0[r+1]);b=MX3(b,C0[r+2],C0[r+3]);a=MX3(a,C1[r],C1[r+1]);b=MX3(b,C1[r+2],C1[r+3]);} \
      float rm=__builtin_fmaxf(a,b); { auto rr=__builtin_amdgcn_permlane32_swap(__float_as_uint(rm),__float_as_uint(rm),false,false); rm=__builtin_fmaxf(__uint_as_float(rr[0]),__uint_as_float(rr[1])); } \
      resc=false; \
      if(__builtin_expect(__any(rm>(float)THRL),0)){ const float dl=__builtin_fmaxf(rm,0.f); mhat+=dl; \
        _Pragma("unroll") for(int r=0;r<16;++r){C0[r]-=dl;C1[r]-=dl;} \
        \
        const float f=__builtin_amdgcn_exp2f(-dl); l_reg*=f; if(hi==0)wsf[r32]=f; resc=true; } } \
    SBAR(); \
    GAPB(o[0]=__builtin_amdgcn_mfma_f32_32x32x16_bf16(PAF(0),VFR(0),o[0],0,0,0), C0,0); \
    GAPB(o[1]=__builtin_amdgcn_mfma_f32_32x32x16_bf16(PAF(0),VFR(4),o[1],0,0,0), C0,4); \
    KRD(GL,0); GAPB(o[0]=__builtin_amdgcn_mfma_f32_32x32x16_bf16(PAF(1),VFR(1),o[0],0,0,0), C0,8); \
    KRD(GL,1); GAPB(o[1]=__builtin_amdgcn_mfma_f32_32x32x16_bf16(PAF(1),VFR(5),o[1],0,0,0), C0,12); \
    KRD(GL,2); GAPB(o[0]=__builtin_amdgcn_mfma_f32_32x32x16_bf16(PAF(2),VFR(2),o[0],0,0,0), C1,0); \
    KRD(GL,3); GAPB(o[1]=__builtin_amdgcn_mfma_f32_32x32x16_bf16(PAF(2),VFR(6),o[1],0,0,0), C1,4); \
    GAPB(o[0]=__builtin_amdgcn_mfma_f32_32x32x16_bf16(PAF(3),VFR(3),o[0],0,0,0), C1,8); \
    GAPB(o[1]=__builtin_amdgcn_mfma_f32_32x32x16_bf16(PAF(3),VFR(7),o[1],0,0,0), C1,12); \
    }while(0)
  int t=1;
  #undef CMASK
  #define CMASK(P0,P1,t) do{}while(0)
  for(;t+5<NT;t+=2){
    STEP(pB0,pB1,pA0,pA1,t,true,true,true);     WAIT_BAR(2); RESC(); ROT();
    STEP(pA0,pA1,pB0,pB1,t+1,true,true,true);   WAIT_BAR(2); RESC(); ROT();
  }
  #undef CMASK
  #define CMASK(P0,P1,t) do{int jb_=(t)-(NT-4); if(jb_>=0)cmask(P0,P1,jb_,qrel,hi);}while(0)
  #define ENDW(tt) do{ if((tt)+3<NT){WAIT_BAR(2);} else if((tt)+2<NT){WAIT_BAR(1);} else {WAIT_BAR(0);} }while(0)
  for(;t+1<NT;t+=2){
    STEP(pB0,pB1,pA0,pA1,t,(t+3<NT),(t+1<NT),(t+1<NT));       ENDW(t);   RESC(); ROT();
    STEP(pA0,pA1,pB0,pB1,t+1,(t+4<NT),(t+2<NT),(t+2<NT));     ENDW(t+1); RESC(); ROT();
  }
  STEP(pB0,pB1,pA0,pA1,NT-1,false,false,false); RESC();
  { float sacc=pB0[0]+pB0[1]; _Pragma("unroll") for(int r=2;r<16;++r)sacc+=pB0[r]; _Pragma("unroll") for(int r=0;r<16;++r)sacc+=pB1[r]; l_reg+=sacc;
    pw0=(u32x4){PKW(pB0,0),PKW(pB0,2),PKW(pB0,4),PKW(pB0,6)};pw1=(u32x4){PKW(pB0,8),PKW(pB0,10),PKW(pB0,12),PKW(pB0,14)};pw2=(u32x4){PKW(pB1,0),PKW(pB1,2),PKW(pB1,4),PKW(pB1,6)};pw3=(u32x4){PKW(pB1,8),PKW(pB1,10),PKW(pB1,12),PKW(pB1,14)};
    SBAR(); pv(o,vb0+sl_cur,PAF(0),PAF(1),PAF(2),PAF(3)); }
  #undef PKW
  #undef PAF
  #undef VFR
  #undef PIN
  #undef MX3
  #undef GAPA
  #undef GAPB
  #undef EX
  #undef VRD
  #undef KRD
  #undef STEP
  #undef ENDW
  {auto rr=__builtin_amdgcn_permlane32_swap(__float_as_uint(l_reg),__float_as_uint(l_reg),false,false);l_reg=__uint_as_float(rr[0])+__uint_as_float(rr[1]);}
  if(hi==0)wsf[32+r32]=l_reg;asm volatile("s_waitcnt lgkmcnt(0)":::"memory");
  float rli[16];
  #pragma unroll
  for(int r=0;r<16;++r)rli[r]=__builtin_amdgcn_rcpf(wsf[32+crow(r,hi)]);
  bf16*Ow=O+(rowbase+q0+wid*QBLK)*PO+h*D;
  { bf16*stg=(bf16*)(shm+LDS_OST)+wid*2048;
    #pragma unroll
    for(int r=0;r<16;++r){const int orow=crow(r,hi);
      #pragma unroll
      for(int d0=0;d0<2;++d0)stg[orow*64+d0*32+r32]=__float2bfloat16(o[d0][r]*rli[r]);}
    asm volatile("s_waitcnt lgkmcnt(0)":::"memory");
    int l2; asm volatile("v_mbcnt_lo_u32_b32 %0, -1, 0\n\tv_mbcnt_hi_u32_b32 %0, -1, %0":"=v"(l2));
    #pragma unroll
    for(int i=0;i<4;++i){const int row=i*8+(l2>>3),ch=l2&7; const u32x4 v=*(const u32x4*)(stg+row*64+ch*8); ATTN_STORE16(Ow+(long)row*PO+ch*8,v);
      float ss=0.f;
      #pragma unroll
      for(int j=0;j<4;++j){const float a=__uint_as_float(v[j]<<16),c=__uint_as_float(v[j]&0xffff0000u);ss+=a*a+c*c;}
      ss+=__shfl_xor(ss,1);ss+=__shfl_xor(ss,2);ss+=__shfl_xor(ss,4);
      if(ch==0)ssqa[(rowbase+q0+wid*QBLK+row)*8+h]=ss;} }
  asm volatile("s_waitcnt lgkmcnt(0)\n\ts_barrier":::"memory");
  #undef DMA_K
  #undef DMA_V
  #undef MMASK
  #undef CMASK
  #undef START
  #undef RESC
  #undef ROT
}
constexpr int ATTN_LDS_BYTES=LDS_BYTES;
#undef SBAR
#undef WAIT_BAR
}


namespace p5 {
constexpr int KLD = 136, SLD = 264;
constexpr int OFF_KL = 0, OFF_S = 2 * 128 * KLD * 2, OFF_REC = OFF_S + 64 * SLD * 4, LDS_NEED = OFF_REC + 64 * 2 * 16 * 4;
static_assert(LDS_NEED <= SCR_BYTES && OFF_S % 16 == 0, "P5 LDS map");

DI unsigned mkkey(float s, unsigned low, unsigned lowmask) { unsigned u = __float_as_uint(s); u ^= (unsigned)((int)u >> 31) | 0x80000000u; return (u & ~lowmask) | low; }
DI float keyval(unsigned key, unsigned lowmask) { unsigned u = (key & ~lowmask) | ((lowmask + 1u) >> 1); return (u & 0x80000000u) ? __uint_as_float(u & 0x7fffffffu) : __uint_as_float(~u); }
DI unsigned umax(unsigned a, unsigned b) { return a > b ? a : b; }
DI unsigned umin(unsigned a, unsigned b) { return a < b ? a : b; }
template <int N> DI void sort_desc(unsigned (&a)[N]) {
#pragma unroll
    for (int k = 2; k <= N; k <<= 1)
#pragma unroll
        for (int j = k >> 1; j > 0; j >>= 1)
#pragma unroll
            for (int i = 0; i < N; ++i) { const int l = i ^ j; if (l > i) { const unsigned x = a[i], y = a[l], mx = umax(x, y), mn = umin(x, y); const bool desc = ((i & k) == 0); a[i] = desc ? mx : mn; a[l] = desc ? mn : mx; } }
}
template <int N> DI void merge_desc(unsigned (&a)[N]) {
#pragma unroll
    for (int j = N >> 1; j > 0; j >>= 1)
#pragma unroll
        for (int i = 0; i < N; ++i) { const int l = i ^ j; if (l > i) { const unsigned x = a[i], y = a[l]; a[i] = umax(x, y); a[l] = umin(x, y); } }
}
template <int XR> DI unsigned dppx(unsigned v) { return (unsigned)__builtin_amdgcn_update_dpp(0, (int)v, XR == 1 ? 0xB1 : XR == 2 ? 0x4E : 0x141, 0xF, 0xF, false); }
template <int XR> DI void xmerge16(unsigned (&a)[16]) {
    unsigned p[16];
#pragma unroll
    for (int i = 0; i < 16; ++i) p[i] = dppx<XR>(a[i]);
#pragma unroll
    for (int i = 0; i < 16; ++i) a[i] = umax(a[i], p[15 - i]);
    merge_desc<16>(a);
}

constexpr int SLD2 = 260;
constexpr int OFF_S2 = 0, OFF_REC2 = 128 * SLD2 * 4, LDS_NEED2 = OFF_REC2 + 128 * 2 * 16 * 4;
static_assert(LDS_NEED2 <= SCR_BYTES && OFF_REC2 % 16 == 0, "P5 LDS map (128-row chunks)");
DI int spos(int c) { return (c >> 7) * 130 + ((c >> 6) & 1) * 65 + (c & 63); }
struct KeyFrags { bf16x8 b[4][2]; };
DI void load_keys(KeyFrags& kf, const bf16_t* K1b, const bf16_t* K2b, int h, int lane, int w) {
    const bf16_t* base = ((w >> 2) ? K2b : K1b) + (size_t)(h * 128 + 32 * (w & 3) + (lane & 15)) * 128 + 8 * (lane >> 4);
#pragma unroll
    for (int ks = 0; ks < 4; ++ks)
#pragma unroll
        for (int nt = 0; nt < 2; ++nt) kf.b[ks][nt] = *(const bf16x8*)(base + (size_t)(16 * nt) * 128 + 32 * ks);
}
DI void top16(unsigned (&a)[16], const unsigned (&b)[16]) {
#pragma unroll
    for (int i = 0; i < 16; ++i) a[i] = umax(a[i], b[15 - i]);
    merge_desc<16>(a);
}
#define P5_LBAR() do { asm volatile("s_waitcnt lgkmcnt(0)" ::: "memory"); __builtin_amdgcn_s_barrier(); asm volatile("" ::: "memory"); } while (0)
DI void chunk128(const Frame& F, int r0, int h, const bf16_t* qry, const float* ssqx, int* eidt, float* gate, const KeyFrags& kf, const float* csrc, unsigned char* cdst, size_t citem0, float csc, const float* ccolg) {
    int tid; asm volatile("v_mov_b32 %0, %1" : "=v"(tid) : "v"(F.tid));
    const int lane = F.lane, w = F.wave;
    LAS float* S = (LAS float*)(F.lds + OFF_S2); LAS unsigned* REC = (LAS unsigned*)(F.lds + OFF_REC2);
    {
        const int half = w >> 2, n0 = 32 * (w & 3), fr = lane & 15, fq = lane >> 4;
#pragma unroll
        for (int mh = 0; mh < 2; ++mh) {
            f32x4 acc[4][2];
#pragma unroll
            for (int m = 0; m < 4; ++m) { acc[m][0] = (f32x4){0.f, 0.f, 0.f, 0.f}; acc[m][1] = (f32x4){0.f, 0.f, 0.f, 0.f}; }
            const bf16_t* qp = qry + (size_t)(r0 + 64 * mh + fr) * 2048 + h * 256 + half * 128 + 8 * fq;
#pragma unroll
            for (int ks = 0; ks < 4; ++ks)
#pragma unroll
                for (int m = 0; m < 4; ++m) { const bf16x8 a = *(const bf16x8*)(qp + (size_t)(16 * m) * 2048 + 32 * ks);
#pragma unroll
                    for (int nt = 0; nt < 2; ++nt) acc[m][nt] = __builtin_amdgcn_mfma_f32_16x16x32_bf16(a, kf.b[ks][nt], acc[m][nt], 0, 0, 0); }
#pragma unroll
            for (int m = 0; m < 4; ++m)
#pragma unroll
                for (int nt = 0; nt < 2; ++nt) { const int pos = spos(half * 128 + n0 + 16 * nt + fr);
#pragma unroll
                    for (int r = 0; r < 4; ++r) S[(64 * mh + 16 * m + 4 * fq + r) * SLD2 + pos] = acc[m][nt][r]; }
        }
    }
    P5_LBAR();
    CvtRegs<4> cvr; cvt8_load<4>(cvr, csrc, citem0, lane);
    const int row = tid >> 2, half = (tid >> 1) & 1, q2 = tid & 1, j4 = tid & 3;
    f32x4 sq0, sq1, sq2, sq3; { const f32x4* sp = (const f32x4*)(ssqx + (size_t)(r0 + row) * 16); sq0 = sp[0]; sq1 = sp[1]; sq2 = sp[2]; sq3 = sp[3]; }
    unsigned a[16];
    {
        unsigned b[16], c[16], d[16];
        const LAS float* sp = S + row * SLD2 + half * 130 + q2 * 65;
#pragma unroll
        for (int i = 0; i < 16; ++i) { a[i] = mkkey(sp[i], 127u - (unsigned)(64 * q2 + i), 127u); b[i] = mkkey(sp[16 + i], 127u - (unsigned)(64 * q2 + 16 + i), 127u);
            c[i] = mkkey(sp[32 + i], 127u - (unsigned)(64 * q2 + 32 + i), 127u); d[i] = mkkey(sp[48 + i], 127u - (unsigned)(64 * q2 + 48 + i), 127u); }
        sort_desc<16>(a); sort_desc<16>(b); top16(a, b);
        sort_desc<16>(c); sort_desc<16>(d); top16(c, d);
        top16(a, c);
    }
    xmerge16<1>(a);
    if (q2 == 0) {
#pragma unroll
        for (int i = 0; i < 16; ++i) REC[(row * 2 + half) * 16 + i] = a[i];
    }
    cvt8_store<4>(cvr, cdst, citem0, lane, csc, ccolg);
    cvt8_load<4>(cvr, csrc, citem0 + 4, lane);
    asm volatile("s_waitcnt lgkmcnt(0)" ::: "memory");
    unsigned t16[16];
#pragma unroll
    for (int e = 0; e < 16; ++e) {
        const int c = 16 * j4 + e; int ci = 0, st = 0;
        if (c >= 16) { ci = 1; st = 16; } if (c >= 24) { ci = 2; st = 24; } if (c >= 29) { ci = 3; st = 29; } if (c >= 33) { ci = 4; st = 33; }
        if (c >= 36) { ci = 5; st = 36; } if (c >= 38) { ci = 6; st = 38; } if (c >= 40) { ci = 7; st = 40; } if (c >= 42) { ci = 8 + (c - 42); st = c; }
        const int cj = c - st;
        unsigned key = 0u;
        if (c < 50) { const float v = keyval(REC[(row * 2) * 16 + ci], 127u) + keyval(REC[(row * 2 + 1) * 16 + cj], 127u); key = mkkey(v, (unsigned)((ci << 4) | cj), 255u); }
        t16[e] = key;
    }
    sort_desc<16>(t16);
    xmerge16<1>(t16); xmerge16<2>(t16);
    unsigned kk[4];
#pragma unroll
    for (int e = 0; e < 4; ++e) kk[e] = (j4 == 0) ? t16[e] : (j4 == 1) ? t16[4 + e] : (j4 == 2) ? t16[8 + e] : t16[12 + e];
    const float ssq = ((sq0[0] + sq0[1]) + (sq0[2] + sq0[3])) + ((sq1[0] + sq1[1]) + (sq1[2] + sq1[3])) + ((sq2[0] + sq2[1]) + (sq2[2] + sq2[3])) + ((sq3[0] + sq3[1]) + (sq3[2] + sq3[3]));
    const float rstd = 1.0f / sqrtf(ssq * (1.f / DM) + EPS);
    const float vmax = keyval(t16[0], 255u);
    float ev[4]; float es = 0.f;
#pragma unroll
    for (int e = 0; e < 4; ++e) { ev[e] = __expf(rstd * (keyval(kk[e], 255u) - vmax)); es += ev[e]; }
    es += __uint_as_float(dppx<1>(__float_as_uint(es))); es += __uint_as_float(dppx<2>(__float_as_uint(es)));
    const float inv = 1.0f / es;
    int* et = eidt + (size_t)(r0 + row) * 128 + (4 * (j4 & 1)) * 16 + 2 * h + (j4 >> 1);
#pragma unroll
    for (int e = 0; e < 4; ++e) { const unsigned cd = kk[e] & 255u;
        et[16 * e] = (int)(127u - (REC[(row * 2) * 16 + (cd >> 4)] & 127u)) * 128 + (int)(127u - (REC[(row * 2 + 1) * 16 + (cd & 15u)] & 127u)); }
    *(f32x4*)(gate + (size_t)(r0 + row) * 128 + h * 16 + 4 * j4) = (f32x4){ev[0] * inv, ev[1] * inv, ev[2] * inv, ev[3] * inv};
    cvt8_store<4>(cvr, cdst, citem0 + 4, lane, csc, ccolg);
    P5_LBAR();
}
}

namespace p5w {
using p5::mkkey; using p5::keyval; using p5::umax; using p5::umin; using p5::sort_desc; using p5::merge_desc; using p5::top16;
constexpr int KPITCH = 272, KHALF = 128 * KPITCH, OFF_REC = 2 * KHALF, REC_WAVE = 32 * 33 * 4;
static_assert(OFF_REC + NWAVES * REC_WAVE <= SCR_BYTES && KHALF % 16 == 0, "P5 (wave-owned rows) LDS map");
DI void keys_to_lds(LAS unsigned char* lds, const bf16_t* K1b, const bf16_t* K2b, int h, int tid_) {
    int tid; asm volatile("v_mov_b32 %0, %1" : "=v"(tid) : "v"(tid_));
    u32x4 v[8];
#pragma unroll
    for (int i = 0; i < 8; ++i) { const int id = tid + 512 * (i & 3); const int row = id >> 4, c = id & 15;
        v[i] = *(const u32x4*)(((i >> 2) ? K2b : K1b) + (size_t)(h * 128 + row) * 128 + 8 * c); }
#pragma unroll
    for (int i = 0; i < 8; ++i) { const int id = tid + 512 * (i & 3); const int row = id >> 4, c = id & 15;
        *(LAS u32x4*)(lds + (i >> 2) * KHALF + row * KPITCH + 16 * c) = v[i]; }
}
DI void sort16_desc(unsigned (&a)[16]) {
#define P5W_CE(i, j) do { const unsigned x_ = a[i], y_ = a[j]; a[i] = umax(x_, y_); a[j] = umin(x_, y_); } while (0)
    P5W_CE(0, 13); P5W_CE(1, 12); P5W_CE(2, 15); P5W_CE(3, 14); P5W_CE(4, 8); P5W_CE(5, 6); P5W_CE(7, 11); P5W_CE(9, 10);
    P5W_CE(0, 5); P5W_CE(1, 7); P5W_CE(2, 9); P5W_CE(3, 4); P5W_CE(6, 13); P5W_CE(8, 14); P5W_CE(10, 15); P5W_CE(11, 12);
    P5W_CE(0, 1); P5W_CE(2, 3); P5W_CE(4, 5); P5W_CE(6, 8); P5W_CE(7, 9); P5W_CE(10, 11); P5W_CE(12, 13); P5W_CE(14, 15);
    P5W_CE(0, 2); P5W_CE(1, 3); P5W_CE(4, 10); P5W_CE(5, 11); P5W_CE(6, 7); P5W_CE(8, 9); P5W_CE(12, 14); P5W_CE(13, 15);
    P5W_CE(1, 2); P5W_CE(3, 12); P5W_CE(4, 6); P5W_CE(5, 7); P5W_CE(8, 10); P5W_CE(9, 11); P5W_CE(13, 14);
    P5W_CE(1, 4); P5W_CE(2, 6); P5W_CE(5, 8); P5W_CE(7, 10); P5W_CE(9, 13); P5W_CE(11, 14);
    P5W_CE(2, 4); P5W_CE(3, 6); P5W_CE(9, 12); P5W_CE(11, 13);
    P5W_CE(3, 5); P5W_CE(6, 8); P5W_CE(7, 9); P5W_CE(10, 12);
    P5W_CE(3, 4); P5W_CE(5, 6); P5W_CE(7, 8); P5W_CE(9, 10); P5W_CE(11, 12);
    P5W_CE(6, 7); P5W_CE(8, 9);
#undef P5W_CE
}
DI void sort10_desc(unsigned (&a)[16]) {
#define P5W_CE(i, j) do { const unsigned x_ = a[i], y_ = a[j]; a[i] = umax(x_, y_); a[j] = umin(x_, y_); } while (0)
    P5W_CE(0, 8); P5W_CE(1, 9); P5W_CE(2, 7); P5W_CE(3, 5); P5W_CE(4, 6);
    P5W_CE(0, 2); P5W_CE(1, 4); P5W_CE(5, 8); P5W_CE(7, 9);
    P5W_CE(0, 3); P5W_CE(2, 4); P5W_CE(5, 7); P5W_CE(6, 9);
    P5W_CE(0, 1); P5W_CE(3, 6); P5W_CE(8, 9);
    P5W_CE(1, 5); P5W_CE(2, 3); P5W_CE(4, 8); P5W_CE(6, 7);
    P5W_CE(1, 2); P5W_CE(3, 5); P5W_CE(4, 6); P5W_CE(7, 8);
    P5W_CE(2, 3); P5W_CE(4, 5); P5W_CE(6, 7);
    P5W_CE(3, 4); P5W_CE(5, 6);
#undef P5W_CE
}
DI unsigned bperm(int addr, unsigned v) { return (unsigned)__builtin_amdgcn_ds_bpermute(addr, (int)v); }
DI void xmerge32(unsigned (&a)[16], int paddr) {
    unsigned p[16];
#pragma unroll
    for (int i = 0; i < 16; ++i) p[i] = bperm(paddr, a[i]);
#pragma unroll
    for (int i = 0; i < 16; ++i) a[i] = umax(a[i], p[15 - i]);
    merge_desc<16>(a);
}
template <class Hook> DI void half_a(unsigned (&k0)[16], unsigned (&k2)[16], unsigned (&k3)[16], const bf16x8 (&bq)[8], const LAS unsigned char* kl, int p4, const Hook& after_first_step) {
    f32x16 acc[4];
#pragma unroll
    for (int mt = 0; mt < 4; ++mt)
#pragma unroll
        for (int r = 0; r < 16; ++r) acc[mt][r] = 0.f;
    bf16x8 ka[2][4];
#pragma unroll
    for (int mt = 0; mt < 4; ++mt) ka[0][mt] = *(const LAS bf16x8*)(kl + (32 * mt) * KPITCH);
#pragma unroll
    for (int ks = 0; ks < 8; ++ks) {
        if (ks < 7) {
#pragma unroll
            for (int mt = 0; mt < 4; ++mt) ka[(ks + 1) & 1][mt] = *(const LAS bf16x8*)(kl + (32 * mt) * KPITCH + 32 * (ks + 1));
        }
#pragma unroll
        for (int mt = 0; mt < 4; ++mt) acc[mt] = __builtin_amdgcn_mfma_f32_32x32x16_bf16(ka[ks & 1][mt], bq[ks], acc[mt], 0, 0, 0);
        __builtin_amdgcn_sched_barrier(0);
        if (ks == 0) { after_first_step(); __builtin_amdgcn_sched_barrier(0); }
    }
    unsigned k1[16];
    unsigned pb; asm volatile("v_xor_b32 %0, 4, %1" : "=v"(pb) : "v"(p4));
#pragma unroll
    for (int r = 0; r < 16; ++r) { const unsigned c = (unsigned)(123 - ((r & 3) + 8 * (r >> 2)));
        k0[r] = mkkey(acc[0][r], pb, 127u) | c; k1[r] = mkkey(acc[1][r], pb, 127u) | (c - 32u); k2[r] = mkkey(acc[2][r], pb, 127u) | (c - 64u); k3[r] = mkkey(acc[3][r], pb, 127u) | (c - 96u); }
    sort16_desc(k0); sort16_desc(k1); top16(k0, k1);
}
DI void half_b(unsigned (&k0)[16], unsigned (&k2)[16], unsigned (&k3)[16], int paddr) {
    sort16_desc(k2); sort16_desc(k3); top16(k2, k3);
    top16(k0, k2);
    xmerge32(k0, paddr);
}
#define P5W_SEG() do { asm volatile("" ::: "memory"); __builtin_amdgcn_sched_barrier(0); } while (0)
DI void unit_rows32(LAS unsigned char* lds, int lane_, int wave, int r0, int h, const bf16_t* qry, const float* ssqx, int* eidt, float* gate,
                    const float* csrc, unsigned char* cdst, size_t citem0, float csc, const float* ccolg) {
    int lane; asm volatile("v_mbcnt_lo_u32_b32 %0, -1, 0\n\tv_mbcnt_hi_u32_b32 %0, -1, %0" : "=v"(lane)); (void)lane_;
    const int qrow = lane & 31, p = lane >> 5, paddr = (lane ^ 32) << 2;
    const bool hi = p != 0;
    const int row = r0 + qrow;
    float rstd;
    { const f32x4* sp = (const f32x4*)(ssqx + (size_t)row * 16); const f32x4 sq0 = sp[0], sq1 = sp[1], sq2 = sp[2], sq3 = sp[3];
      const float ssq = ((sq0[0] + sq0[1]) + (sq0[2] + sq0[3])) + ((sq1[0] + sq1[1]) + (sq1[2] + sq1[3])) + ((sq2[0] + sq2[1]) + (sq2[2] + sq2[3])) + ((sq3[0] + sq3[1]) + (sq3[2] + sq3[3]));
      rstd = 1.0f / sqrtf(ssq * (1.f / DM) + EPS); }
    const bf16_t* qp = qry + (size_t)row * 2048 + h * 256 + 8 * p;
    const LAS unsigned char* kl = lds + qrow * KPITCH + 16 * p;
    unsigned a0[16], a1[16];
    CvtRegs<3> cv3;
    {
        bf16x8 bq[8];
#pragma unroll
        for (int ks = 0; ks < 8; ++ks) bq[ks] = *(const bf16x8*)(qp + 16 * ks);
        unsigned k2[16], k3[16];
        half_a(a0, k2, k3, bq, kl, 4 * p, [&]() { cvt8_load<3>(cv3, csrc, citem0, lane); });
        P5W_SEG();
        cvt8_store<3>(cv3, cdst, citem0, lane, csc, ccolg);
#pragma unroll
        for (int ks = 0; ks < 8; ++ks) bq[ks] = *(const bf16x8*)(qp + 128 + 16 * ks);
        cvt8_load<3>(cv3, csrc, citem0 + 3, lane);
        P5W_SEG();
        half_b(a0, k2, k3, paddr);
        P5W_SEG();
        cvt8_store<3>(cv3, cdst, citem0 + 3, lane, csc, ccolg);
        P5W_SEG();
        half_a(a1, k2, k3, bq, kl + KHALF, 4 * p, [&]() { cvt8_load<3>(cv3, csrc, citem0 + 6, lane); });
        P5W_SEG();
        cvt8_store<3>(cv3, cdst, citem0 + 6, lane, csc, ccolg);
        cvt8_load<3>(cv3, csrc, citem0 + 9, lane);
        P5W_SEG();
        half_b(a1, k2, k3, paddr);
        P5W_SEG();
        cvt8_store<3>(cv3, cdst, citem0 + 9, lane, csc, ccolg);
    }
    CvtRegs<4> cv4; cvt8_load<4>(cv4, csrc, citem0 + 12, lane);
    P5W_SEG();
    LAS unsigned* REC = (LAS unsigned*)(lds + OFF_REC + wave * REC_WAVE) + qrow * 33;
    if (!hi) {
#pragma unroll
        for (int i = 0; i < 16; ++i) REC[i] = a0[i];
    } else {
#pragma unroll
        for (int i = 0; i < 16; ++i) REC[16 + i] = a1[i];
    }
    float f0[16], f1[16];
#pragma unroll
    for (int i = 0; i < 16; ++i) { f0[i] = keyval(a0[i], 127u); f1[i] = keyval(a1[i], 127u); }
    float g1[8]; unsigned cp[8];
#pragma unroll
    for (int k = 0; k < 8; ++k) { g1[k] = hi ? f1[2 * k + 1] : f1[2 * k]; cp[k] = (unsigned)(2 * k) | (unsigned)p; }
    unsigned t[16], u[16];
#pragma unroll
    for (int k = 0; k < 8; ++k) t[k] = mkkey(f0[0] + g1[k], cp[k], 255u);
#pragma unroll
    for (int k = 0; k < 4; ++k) t[8 + k] = mkkey(f0[1] + g1[k], 16u | cp[k], 255u);
    t[12] = mkkey(f0[2] + g1[0], 32u | cp[0], 255u); t[13] = mkkey(f0[2] + g1[1], 32u | cp[1], 255u);
    { const unsigned kx = mkkey(f0[2] + f1[4], 32u | 4u, 255u); t[14] = hi ? 0u : kx; }
    t[15] = mkkey(f0[3] + g1[0], 48u | cp[0], 255u); u[0] = mkkey(f0[3] + g1[1], 48u | cp[1], 255u);
    u[1] = mkkey(f0[4] + g1[0], 64u | cp[0], 255u);
    { const unsigned kx = mkkey(f0[4] + f1[2], 64u | 2u, 255u); u[2] = hi ? 0u : kx; }
    u[3] = mkkey(f0[5] + g1[0], 80u | cp[0], 255u); u[4] = mkkey(f0[6] + g1[0], 96u | cp[0], 255u); u[5] = mkkey(f0[7] + g1[0], 112u | cp[0], 255u);
#pragma unroll
    for (int k = 0; k < 4; ++k) { const float fv = hi ? f0[12 + k] : f0[8 + k]; u[6 + k] = mkkey(fv + f1[0], ((unsigned)(8 + k + 4 * p) << 4), 255u); }
    sort16_desc(t); sort10_desc(u);
#pragma unroll
    for (int k = 10; k < 16; ++k) u[k] = 0u;
    top16(t, u);
    xmerge32(t, paddr);
    P5W_SEG();
    cvt8_store<4>(cv4, cdst, citem0 + 12, lane, csc, ccolg);
    unsigned kk[8];
#pragma unroll
    for (int e = 0; e < 8; ++e) kk[e] = hi ? t[8 + e] : t[e];
    const float vmax = keyval(t[0], 255u);
    float ev[8]; float es = 0.f;
#pragma unroll
    for (int e = 0; e < 8; ++e) { ev[e] = __expf(rstd * (keyval(kk[e], 255u) - vmax)); es += ev[e]; }
    es += __uint_as_float(bperm(paddr, __float_as_uint(es)));
    const float inv = 1.0f / es;
    asm volatile("s_waitcnt lgkmcnt(0)" ::: "memory");
    int* et = eidt + (size_t)row * 128 + 2 * h + p;
#pragma unroll
    for (int e = 0; e < 8; ++e) { const unsigned cd = kk[e] & 255u;
        et[16 * e] = (int)(127u - (REC[cd >> 4] & 127u)) * 128 + (int)(127u - (REC[16 + (cd & 15u)] & 127u)); }
    float* gp = gate + (size_t)row * 128 + h * 16 + 8 * p;
    *(f32x4*)gp = (f32x4){ev[0] * inv, ev[1] * inv, ev[2] * inv, ev[3] * inv};
    *(f32x4*)(gp + 4) = (f32x4){ev[4] * inv, ev[5] * inv, ev[6] * inv, ev[7] * inv};
}
}

namespace p6 {
constexpr float SC_DOWN = 64.0f, SC_UP = 4.0f;
constexpr size_t SLICE = (size_t)NEXP * 128;
DI float gelu_erf(float v) { return 0.5f * v * (1.0f + erff(v * 0.70710678118654752f)); }
DI f32x2_t up8(unsigned w, bool hi) { return hi ? __builtin_amdgcn_cvt_pk_f32_fp8(w, true) : __builtin_amdgcn_cvt_pk_f32_fp8(w, false); }
DI float dot16(const u32x4 v, const f32x2_t (&x)[8]) {
    f32x2_t a = up8(v.x, false) * x[0];
    a = up8(v.x, true) * x[1] + a; a = up8(v.y, false) * x[2] + a; a = up8(v.y, true) * x[3] + a;
    a = up8(v.z, false) * x[4] + a; a = up8(v.z, true) * x[5] + a; a = up8(v.w, false) * x[6] + a; a = up8(v.w, true) * x[7] + a;
    return a.x + a.y;
}
DI void axpy16(f32x2_t (&o)[8], const u32x4 v, float c) {
    o[0] = up8(v.x, false) * c + o[0]; o[1] = up8(v.x, true) * c + o[1]; o[2] = up8(v.y, false) * c + o[2]; o[3] = up8(v.y, true) * c + o[3];
    o[4] = up8(v.z, false) * c + o[4]; o[5] = up8(v.z, true) * c + o[5]; o[6] = up8(v.w, false) * c + o[6]; o[7] = up8(v.w, true) * c + o[7];
}
template <int CTRL> DI float dppf(float v) { return __int_as_float(__builtin_amdgcn_update_dpp(0, __float_as_int(v), CTRL, 0xF, 0xF, false)); }
DI float grp8_sum(float v) { v += dppf<0xB1>(v); v += dppf<0x4E>(v); v += dppf<0x141>(v); return v; }
template <int S> DI int bcast8(int v) { return __builtin_amdgcn_ds_swizzle(v, (S << 5) | 0x18); }
template <int S> DI float bcast8f(float v) { return __int_as_float(__builtin_amdgcn_ds_swizzle(__float_as_int(v), (S << 5) | 0x18)); }
DI float row_rstd(const float* ssqx, int t) {
    const f32x4* sp = (const f32x4*)(ssqx + (size_t)t * 16); const f32x4 s0 = sp[0], s1 = sp[1], s2 = sp[2], s3 = sp[3];
    const float ssq = ((s0[0] + s0[1]) + (s0[2] + s0[3])) + ((s1[0] + s1[1]) + (s1[2] + s1[3])) + ((s2[0] + s2[1]) + (s2[2] + s2[3])) + ((s3[0] + s3[1]) + (s3[2] + s3[3]));
    return 1.0f / sqrtf(ssq * (1.f / DM) + EPS);
}

typedef int v2i_t __attribute__((ext_vector_type(2)));
DI long mk64(unsigned lo, unsigned hi) { return (long)(((unsigned long long)hi << 32) | (unsigned long long)lo); }
typedef int i32x4 __attribute__((ext_vector_type(4)));
struct Ids { i32x4 e0, e1, e2, e3; };
DI Ids ids_lds(const LAS unsigned char* slot, int lane) { Ids d; const LAS i32x4* ep = (const LAS i32x4*)(slot + (lane >> 3) * 64); d.e0 = ep[0]; d.e1 = ep[1]; d.e2 = ep[2]; d.e3 = ep[3]; return d; }
template <int I> DI int id_of(const Ids& d) { return I == 0 ? d.e0.x : I == 1 ? d.e0.y : I == 2 ? d.e0.z : I == 3 ? d.e0.w : I == 4 ? d.e1.x : I == 5 ? d.e1.y : I == 6 ? d.e1.z : I == 7 ? d.e1.w :
                                                   I == 8 ? d.e2.x : I == 9 ? d.e2.y : I == 10 ? d.e2.z : I == 11 ? d.e2.w : I == 12 ? d.e3.x : I == 13 ? d.e3.y : I == 14 ? d.e3.z : d.e3.w; }
template <int I> DI void dma1(LAS unsigned char* img, const unsigned char* slice, const Ids& d, int lane) {
    __builtin_amdgcn_global_load_lds((const unsigned*)(slice + (size_t)id_of<I>(d) * 128 + 16 * ((lane & 7) ^ (lane >> 3))), (LAS unsigned*)(img + I * 1024), 16, 0, 0);
}
DI void dma_all(LAS unsigned char* img, const unsigned char* slice, const Ids& d, int lane) {
    dma1<0>(img, slice, d, lane); dma1<1>(img, slice, d, lane); dma1<2>(img, slice, d, lane); dma1<3>(img, slice, d, lane); dma1<4>(img, slice, d, lane); dma1<5>(img, slice, d, lane); dma1<6>(img, slice, d, lane); dma1<7>(img, slice, d, lane);
    dma1<8>(img, slice, d, lane); dma1<9>(img, slice, d, lane); dma1<10>(img, slice, d, lane); dma1<11>(img, slice, d, lane); dma1<12>(img, slice, d, lane); dma1<13>(img, slice, d, lane); dma1<14>(img, slice, d, lane); dma1<15>(img, slice, d, lane);
}
DI void smalls_dma(LAS unsigned char* slot, const int* eidt, int t, const unsigned char* ahi, const unsigned char* alo, int lane_) {
    int lane; asm volatile("v_mov_b32 %0, %1" : "=v"(lane) : "v"(lane_));
    const unsigned char* src = (lane < 32) ? (const unsigned char*)(eidt + (size_t)t * 128) + 16 * lane : (lane < 40) ? ahi + 16 * (lane - 32) : (lane < 48) ? alo + 16 * (lane - 40) : ahi + 16 * (lane & 7);
    __builtin_amdgcn_global_load_lds((const unsigned*)src, (LAS unsigned*)slot, 16, 0, 0);
}
DI void smalls_dma4(LAS unsigned char* slot, const int* eidt, int t, const unsigned char* ahi, const unsigned char* alo, const unsigned char* ext, int lane_) {
    int lane; asm volatile("v_mov_b32 %0, %1" : "=v"(lane) : "v"(lane_));
    const unsigned char* src = (lane < 32) ? (const unsigned char*)(eidt + (size_t)t * 128) + 16 * lane : (lane < 40) ? ahi + 16 * (lane - 32) : (lane < 48) ? alo + 16 * (lane - 40) : ext + 16 * (lane - 48);
    __builtin_amdgcn_global_load_lds((const unsigned*)src, (LAS unsigned*)slot, 16, 0, 0);
}
DI void split8(float v0, float v1, float v2, float v3, unsigned& hi, unsigned& lo) {
    int h = 0; h = __builtin_amdgcn_cvt_pk_fp8_f32(v0, v1, h, false); h = __builtin_amdgcn_cvt_pk_fp8_f32(v2, v3, h, true);
    const f32x2_t b01 = __builtin_amdgcn_cvt_pk_f32_fp8(h, false), b23 = __builtin_amdgcn_cvt_pk_f32_fp8(h, true);
    int l = 0; l = __builtin_amdgcn_cvt_pk_fp8_f32((v0 - b01.x) * 16.0f, (v1 - b01.y) * 16.0f, l, false); l = __builtin_amdgcn_cvt_pk_fp8_f32((v2 - b23.x) * 16.0f, (v3 - b23.y) * 16.0f, l, true);
    hi = (unsigned)h; lo = (unsigned)l;
}
#define P6_WAITV(N) asm volatile("s_waitcnt vmcnt(" #N ")" ::: "memory")
#define P6_WAITL() asm volatile("s_waitcnt lgkmcnt(0)" ::: "memory")
DI void xq_token(int t, int lane, const bf16_t* x1b, unsigned char* xqh, unsigned char* xql) {
    const u32x4* xp = (const u32x4*)(x1b + (size_t)t * DM + 16 * lane); const u32x4 w0 = xp[0], w1 = xp[1];
    unsigned h0, h1, h2, h3, l0, l1, l2, l3;
    split8(bflo(w0.x), bfhi(w0.x), bflo(w0.y), bfhi(w0.y), h0, l0); split8(bflo(w0.z), bfhi(w0.z), bflo(w0.w), bfhi(w0.w), h1, l1);
    split8(bflo(w1.x), bfhi(w1.x), bflo(w1.y), bfhi(w1.y), h2, l2); split8(bflo(w1.z), bfhi(w1.z), bflo(w1.w), bfhi(w1.w), h3, l3);
    const u32x4 h = (u32x4){h0, h1, h2, h3}, l = (u32x4){l0, l1, l2, l3};
    st16_wt(xqh + (size_t)t * DM + 16 * lane, h); st16_wt(xql + (size_t)t * DM + 16 * lane, l);
}
DI void down_run(int j, int lw, int nlw, int lane, LAS unsigned char* img, LAS unsigned char* sm, LAS unsigned char* rs, const int* eidt, const unsigned char* xqh, const unsigned char* xql, const unsigned char* EDs, bf16_t* part) {
    if (lw >= M_TOK) return;
    const int n = lane & 15, kq = lane >> 4, key = n & 7;
    const int cnt = (M_TOK - 1 - lw) / nlw + 1, tl = lw + (cnt - 1) * nlw;
#define P6_TOK(i) ((lw + (i) * nlw <= tl) ? lw + (i) * nlw : tl)
#define P6_SM(t, slot) smalls_dma(slot, eidt, (t), xqh + (size_t)(t) * DM + 128 * j, xql + (size_t)(t) * DM + 128 * j, lane)
    P6_SM(P6_TOK(0), sm); P6_SM(P6_TOK(1), sm + 1024);
    P6_WAITV(0);
    Ids idn = ids_lds(sm, lane);
    P6_WAITL();
    dma_all(img, EDs, idn, lane);
    for (int i = 0; i < cnt; ++i) {
        const int t = lw + i * nlw;
        LAS unsigned char* cur = sm + (i & 1) * 1024; LAS unsigned char* nxs = sm + ((i + 1) & 1) * 1024;
        long a[4];
        { u32x4 a01 = (u32x4){0u, 0u, 0u, 0u}, a23 = (u32x4){0u, 0u, 0u, 0u};
          if (n < 2) { a01 = *(const LAS u32x4*)(cur + 512 + 128 * n + 32 * kq); a23 = *(const LAS u32x4*)(cur + 512 + 128 * n + 32 * kq + 16); }
          P6_WAITL();
          a[0] = mk64(a01.x, a01.y); a[1] = mk64(a01.z, a01.w); a[2] = mk64(a23.x, a23.y); a[3] = mk64(a23.z, a23.w); }
        { const int t2 = P6_TOK(i + 2); P6_SM(t2, cur); }
        float r[8];
#define P6_GRP(GI) { P6_WAITV(14); \
            const LAS unsigned char* row = img + (16 * (GI) + n) * 128; \
            const u32x4 b01 = *(const LAS u32x4*)(row + 16 * ((2 * kq) ^ key)), b23 = *(const LAS u32x4*)(row + 16 * ((2 * kq + 1) ^ key)); \
            if ((GI) == 0) idn = ids_lds(nxs, lane); \
            P6_WAITL(); \
            dma1<2 * (GI)>(img, EDs, idn, lane); dma1<2 * (GI) + 1>(img, EDs, idn, lane);     \
            f32x4 acc = (f32x4){0.f, 0.f, 0.f, 0.f}; \
            acc = __builtin_amdgcn_mfma_f32_16x16x32_fp8_fp8(a[0], mk64(b01.x, b01.y), acc, 0, 0, 0); \
            acc = __builtin_amdgcn_mfma_f32_16x16x32_fp8_fp8(a[1], mk64(b01.z, b01.w), acc, 0, 0, 0); \
            acc = __builtin_amdgcn_mfma_f32_16x16x32_fp8_fp8(a[2], mk64(b23.x, b23.y), acc, 0, 0, 0); \
            acc = __builtin_amdgcn_mfma_f32_16x16x32_fp8_fp8(a[3], mk64(b23.z, b23.w), acc, 0, 0, 0); \
            r[GI] = acc[0] + acc[1] * (1.0f / 16.0f); }
        P6_GRP(0) P6_GRP(1) P6_GRP(2) P6_GRP(3) P6_GRP(4) P6_GRP(5) P6_GRP(6) P6_GRP(7)
#undef P6_GRP
        if (lane < 16) {
#pragma unroll
            for (int gi = 0; gi < 8; ++gi) *(LAS unsigned short*)(rs + 2 * (16 * gi + n)) = (unsigned short)(cvtpk(r[gi], 0.f) & 0xffffu);
        }
        P6_WAITL();
        const unsigned w = *(const LAS unsigned*)(rs + 4 * lane);
        P6_WAITL();
        *(unsigned*)(part + ((size_t)j * M_TOK + t) * 128 + 2 * lane) = w;
    }
    P6_WAITV(0); P6_WAITL();
#undef P6_SM
}
DI void c_token(int t, int lane, const float* ssqx, const float* gate, const bf16_t* part, unsigned char* cq) {
    const float rstd = row_rstd(ssqx, t);
    const float2 G = *(const float2*)(gate + (size_t)t * 128 + 2 * lane);
    float a0 = 0.f, a1 = 0.f;
#pragma unroll
    for (int jj = 0; jj < 8; ++jj) { const unsigned w = *(const unsigned*)(part + ((size_t)jj * M_TOK + t) * 128 + 2 * lane); a0 += bflo(w); a1 += bfhi(w); }
    const float c0 = G.x * gelu_erf(a0 * rstd * (1.0f / SC_DOWN)) * (128.0f / SC_UP), c1 = G.y * gelu_erf(a1 * rstd * (1.0f / SC_DOWN)) * (128.0f / SC_UP);
    unsigned hi, lo; split8(c0, c1, 0.f, 0.f, hi, lo);
    *(unsigned short*)(cq + (size_t)t * 256 + 2 * lane) = (unsigned short)(hi & 0xffffu); *(unsigned short*)(cq + (size_t)t * 256 + 128 + 2 * lane) = (unsigned short)(lo & 0xffffu);
}
DI void up_run(int j, int lw, int nlw, int lane, LAS unsigned char* img, LAS unsigned char* sm, LAS unsigned char* rs, const int* eidt, const unsigned char* cq, const unsigned char* EUs, bf16_t* delta) {
    if (lw >= M_TOK) return;
    const int n = lane & 15, kq = lane >> 4, r = n >> 1, ch = n & 1;
    const int cnt = (M_TOK - 1 - lw) / nlw + 1, tl = lw + (cnt - 1) * nlw;
#define P6_SM(t, slot) smalls_dma(slot, eidt, (t), cq + (size_t)(t) * 256, cq + (size_t)(t) * 256 + 128, lane)
    P6_SM(P6_TOK(0), sm); P6_SM(P6_TOK(1), sm + 1024);
    P6_WAITV(0);
    Ids idn = ids_lds(sm, lane);
    P6_WAITL();
    dma_all(img, EUs, idn, lane);
    for (int i = 0; i < cnt; ++i) {
        const int t = lw + i * nlw;
        LAS unsigned char* cur = sm + (i & 1) * 1024; LAS unsigned char* nxs = sm + ((i + 1) & 1) * 1024;
        long a[4];
        { u32x2 w[4];
#pragma unroll
          for (int sx = 0; sx < 4; ++sx) { w[sx] = (u32x2){0u, 0u}; if (n < 2) w[sx] = *(const LAS u32x2*)(cur + 512 + 128 * n + 32 * sx + 8 * kq); }
          P6_WAITL();
#pragma unroll
          for (int sx = 0; sx < 4; ++sx) a[sx] = mk64(w[sx].x, w[sx].y); }
        { const int t2 = P6_TOK(i + 2); P6_SM(t2, cur); }
        f32x4 acc[8];
#pragma unroll
        for (int cb = 0; cb < 8; ++cb) acc[cb] = (f32x4){0.f, 0.f, 0.f, 0.f};
#define P6_KS(SX) { P6_WAITV(12); \
            v2i_t b[8]; \
            _Pragma("unroll") for (int cb = 0; cb < 8; ++cb) b[cb] = __builtin_amdgcn_ds_read_tr8_b64_v2i32((LAS v2i_t*)(img + (32 * (SX) + 8 * kq + r) * 128 + 16 * (cb ^ r) + 8 * ch)); \
            if ((SX) == 0) idn = ids_lds(nxs, lane); \
            P6_WAITL(); \
            dma1<4 * (SX)>(img, EUs, idn, lane); dma1<4 * (SX) + 1>(img, EUs, idn, lane); dma1<4 * (SX) + 2>(img, EUs, idn, lane); dma1<4 * (SX) + 3>(img, EUs, idn, lane); \
            _Pragma("unroll") for (int cb = 0; cb < 8; ++cb) acc[cb] = __builtin_amdgcn_mfma_f32_16x16x32_fp8_fp8(a[SX], mk64((unsigned)b[cb].x, (unsigned)b[cb].y), acc[cb], 0, 0, 0); }
        P6_KS(0) P6_KS(1) P6_KS(2) P6_KS(3)
#undef P6_KS
        if (lane < 16) {
#pragma unroll
            for (int cb = 0; cb < 8; ++cb) *(LAS unsigned short*)(rs + 2 * (16 * cb + n)) = (unsigned short)(cvtpk((acc[cb][0] + acc[cb][1] * (1.0f / 16.0f)) * (1.0f / 128.0f), 0.f) & 0xffffu);
        }
        P6_WAITL();
        const unsigned w = *(const LAS unsigned*)(rs + 4 * lane);
        P6_WAITL();
        *(unsigned*)(delta + (size_t)t * DM + 128 * j + 2 * lane) = w;
    }
    P6_WAITV(0); P6_WAITL();
#undef P6_SM
#undef P6_TOK
}
DI int opaque_lane() { int l; asm volatile("v_mbcnt_lo_u32_b32 %0, -1, 0\n\tv_mbcnt_hi_u32_b32 %0, -1, %0" : "=v"(l)); return l; }
#define P6I_T(i) (t0 + (((i) < 64 ? (i) : 63) & 7))
#define P6I_S(i) (((i) < 64 ? (i) : 63) >> 3)
DI void own_down(int t0, LAS unsigned char* img, LAS unsigned char* sm, const int* eidt, const unsigned char* xqh, const unsigned char* xql, const unsigned char* ED, float (&pacc)[8][8]) {
    const int lane = opaque_lane();
    const int n = lane & 15, kq = lane >> 4, key = n & 7;
#define P6I_SM(i, slot) smalls_dma(slot, eidt, P6I_T(i), xqh + (size_t)P6I_T(i) * DM + 128 * P6I_S(i), xql + (size_t)P6I_T(i) * DM + 128 * P6I_S(i), lane)
    P6I_SM(0, sm); P6I_SM(1, sm + 1024);
    P6_WAITV(0);
    Ids idn = ids_lds(sm, lane);
    P6_WAITL();
    dma_all(img, ED, idn, lane);
    for (int s = 0; s < 8; ++s) {
#define P6I_GRP(GI, TOK) { P6_WAITV(14); \
            const LAS unsigned char* row = img + (16 * (GI) + n) * 128; \
            const u32x4 b01 = *(const LAS u32x4*)(row + 16 * ((2 * kq) ^ key)), b23 = *(const LAS u32x4*)(row + 16 * ((2 * kq + 1) ^ key)); \
            if ((GI) == 0) idn = ids_lds(nxs, lane); \
            P6_WAITL(); \
            dma1<2 * (GI)>(img, nsl, idn, lane); dma1<2 * (GI) + 1>(img, nsl, idn, lane); \
            f32x4 acc = (f32x4){0.f, 0.f, 0.f, 0.f}; \
            acc = __builtin_amdgcn_mfma_f32_16x16x32_fp8_fp8(a[0], mk64(b01.x, b01.y), acc, 0, 0, 0); \
            acc = __builtin_amdgcn_mfma_f32_16x16x32_fp8_fp8(a[1], mk64(b01.z, b01.w), acc, 0, 0, 0); \
            acc = __builtin_amdgcn_mfma_f32_16x16x32_fp8_fp8(a[2], mk64(b23.x, b23.y), acc, 0, 0, 0); \
            acc = __builtin_amdgcn_mfma_f32_16x16x32_fp8_fp8(a[3], mk64(b23.z, b23.w), acc, 0, 0, 0); \
            pacc[TOK][GI] += acc[0] + acc[1] * (1.0f / 16.0f); }
#define P6I_ITEM(TOK) { const int i = 8 * s + (TOK); \
            LAS unsigned char* cur = sm + ((TOK) & 1) * 1024; LAS unsigned char* nxs = sm + (((TOK) + 1) & 1) * 1024; \
            long a[4]; \
            { u32x4 a01 = (u32x4){0u, 0u, 0u, 0u}, a23 = (u32x4){0u, 0u, 0u, 0u}; \
              if (n < 2) { a01 = *(const LAS u32x4*)(cur + 512 + 128 * n + 32 * kq); a23 = *(const LAS u32x4*)(cur + 512 + 128 * n + 32 * kq + 16); } \
              P6_WAITL(); \
              a[0] = mk64(a01.x, a01.y); a[1] = mk64(a01.z, a01.w); a[2] = mk64(a23.x, a23.y); a[3] = mk64(a23.z, a23.w); } \
            P6I_SM(i + 2, cur); \
            const unsigned char* nsl = ED + (size_t)P6I_S(i + 1) * SLICE;                   \
            P6I_GRP(0, TOK) P6I_GRP(1, TOK) P6I_GRP(2, TOK) P6I_GRP(3, TOK) P6I_GRP(4, TOK) P6I_GRP(5, TOK) P6I_GRP(6, TOK) P6I_GRP(7, TOK) }
        P6I_ITEM(0) P6I_ITEM(1) P6I_ITEM(2) P6I_ITEM(3) P6I_ITEM(4) P6I_ITEM(5) P6I_ITEM(6) P6I_ITEM(7)
#undef P6I_ITEM
#undef P6I_GRP
    }
    P6_WAITV(0); P6_WAITL();
#undef P6I_SM
}
DI void own_c(int t0, LAS unsigned char* img, const float (&pacc)[8][8], const float* ssqx, const float* gate, unsigned char* cq) {
    const int lane = opaque_lane();
    LAS float* pf = (LAS float*)img;
    if (lane < 16) {
#pragma unroll
        for (int tok = 0; tok < 8; ++tok)
#pragma unroll
            for (int gi = 0; gi < 8; ++gi) pf[tok * 128 + 16 * gi + lane] = pacc[tok][gi];
    }
    const float rl = row_rstd(ssqx, t0 + (lane & 7));
    float2 G[8];
#pragma unroll
    for (int tok = 0; tok < 8; ++tok) G[tok] = *(const float2*)(gate + (size_t)(t0 + tok) * 128 + 2 * lane);
    P6_WAITL();
#pragma unroll
    for (int tok = 0; tok < 8; ++tok) {
        const float rstd = __int_as_float(__builtin_amdgcn_readlane(__float_as_int(rl), tok));
        const f32x2_t d = *(const LAS f32x2_t*)(pf + tok * 128 + 2 * lane);
        const float c0 = G[tok].x * gelu_erf(d.x * rstd * (1.0f / SC_DOWN)) * (128.0f / SC_UP), c1 = G[tok].y * gelu_erf(d.y * rstd * (1.0f / SC_DOWN)) * (128.0f / SC_UP);
        unsigned hi, lo; split8(c0, c1, 0.f, 0.f, hi, lo);
        *(unsigned short*)(cq + (size_t)(t0 + tok) * 256 + 2 * lane) = (unsigned short)(hi & 0xffffu); *(unsigned short*)(cq + (size_t)(t0 + tok) * 256 + 128 + 2 * lane) = (unsigned short)(lo & 0xffffu);
    }
    asm volatile("s_waitcnt vmcnt(0) lgkmcnt(0)" ::: "memory");
}
DI void own_c2(int t0, LAS unsigned char* img, const float (&pacc)[8][8], const float* ssqx, const float* gate, unsigned char* cq, const int* eidt, const unsigned char* EU) {
    const int lane = opaque_lane();
    LAS float* pf = (LAS float*)img;
    if (lane < 16) {
#pragma unroll
        for (int tok = 0; tok < 8; ++tok)
#pragma unroll
            for (int gi = 0; gi < 8; ++gi) pf[tok * 128 + 16 * gi + lane] = pacc[tok][gi];
    }
    Ids idn; { const i32x4* ep = (const i32x4*)(eidt + (size_t)t0 * 128 + (lane >> 3) * 16); idn.e0 = ep[0]; idn.e1 = ep[1]; idn.e2 = ep[2]; idn.e3 = ep[3]; }
    const float rl = row_rstd(ssqx, t0 + (lane & 7));
    float2 G[8];
#pragma unroll
    for (int tok = 0; tok < 8; ++tok) G[tok] = *(const float2*)(gate + (size_t)(t0 + tok) * 128 + 2 * lane);
    P6_WAITL();
    f32x2_t d[8];
#pragma unroll
    for (int tok = 0; tok < 8; ++tok) d[tok] = *(const LAS f32x2_t*)(pf + tok * 128 + 2 * lane);
    P6_WAITL();
    dma_all(img, EU, idn, lane);
#pragma unroll
    for (int tok = 0; tok < 8; ++tok) {
        const float rstd = __int_as_float(__builtin_amdgcn_readlane(__float_as_int(rl), tok));
        const float c0 = G[tok].x * gelu_erf(d[tok].x * rstd * (1.0f / SC_DOWN)) * (128.0f / SC_UP), c1 = G[tok].y * gelu_erf(d[tok].y * rstd * (1.0f / SC_DOWN)) * (128.0f / SC_UP);
        unsigned hi, lo; split8(c0, c1, 0.f, 0.f, hi, lo);
        *(unsigned short*)(cq + (size_t)(t0 + tok) * 256 + 2 * lane) = (unsigned short)(hi & 0xffffu); *(unsigned short*)(cq + (size_t)(t0 + tok) * 256 + 128 + 2 * lane) = (unsigned short)(lo & 0xffffu);
    }
    asm volatile("s_waitcnt vmcnt(0) lgkmcnt(0)" ::: "memory");
}
template <bool PREFILLED> DI void own_up(int t0, LAS unsigned char* img, LAS unsigned char* sm, LAS unsigned char* rs, const int* eidt, const unsigned char* cq, const unsigned char* EU, const bf16_t* x1b, bf16_t* delta) {
    const int lane = opaque_lane();
    const int n = lane & 15, kq = lane >> 4, r = n >> 1, ch = n & 1;
#define P6I_SM(i, slot) smalls_dma4(slot, eidt, P6I_T(i), cq + (size_t)P6I_T(i) * 256, cq + (size_t)P6I_T(i) * 256 + 128, (const unsigned char*)(x1b + (size_t)P6I_T(i) * DM + 128 * P6I_S(i)), lane)
    P6I_SM(0, sm); P6I_SM(1, sm + 1024);
    P6_WAITV(0);
    Ids idn = ids_lds(sm, lane);
    P6_WAITL();
    if (!PREFILLED) dma_all(img, EU, idn, lane);
    for (int i = 0; i < 64; ++i) {
        const int t = t0 + (i & 7), sl = i >> 3;
        LAS unsigned char* cur = sm + (i & 1) * 1024; LAS unsigned char* nxs = sm + ((i + 1) & 1) * 1024;
        long a[4]; unsigned xs;
        { u32x2 w[4];
#pragma unroll
          for (int sx = 0; sx < 4; ++sx) { w[sx] = (u32x2){0u, 0u}; if (n < 2) w[sx] = *(const LAS u32x2*)(cur + 512 + 128 * n + 32 * sx + 8 * kq); }
          xs = *(const LAS unsigned*)(cur + 768 + 4 * lane);
          P6_WAITL();
#pragma unroll
          for (int sx = 0; sx < 4; ++sx) a[sx] = mk64(w[sx].x, w[sx].y); }
        P6I_SM(i + 2, cur);
        const unsigned char* nsl = EU + (size_t)P6I_S(i + 1) * SLICE;
        f32x4 acc[8];
#pragma unroll
        for (int cb = 0; cb < 8; ++cb) acc[cb] = (f32x4){0.f, 0.f, 0.f, 0.f};
#define P6I_KS(SX) { P6_WAITV(12); \
            v2i_t b[8]; \
            _Pragma("unroll") for (int cb = 0; cb < 8; ++cb) b[cb] = __builtin_amdgcn_ds_read_tr8_b64_v2i32((LAS v2i_t*)(img + (32 * (SX) + 8 * kq + r) * 128 + 16 * (cb ^ r) + 8 * ch)); \
            if ((SX) == 0) idn = ids_lds(nxs, lane); \
            P6_WAITL(); \
            dma1<4 * (SX)>(img, nsl, idn, lane); dma1<4 * (SX) + 1>(img, nsl, idn, lane); dma1<4 * (SX) + 2>(img, nsl, idn, lane); dma1<4 * (SX) + 3>(img, nsl, idn, lane); \
            _Pragma("unroll") for (int cb = 0; cb < 8; ++cb) acc[cb] = __builtin_amdgcn_mfma_f32_16x16x32_fp8_fp8(a[SX], mk64((unsigned)b[cb].x, (unsigned)b[cb].y), acc[cb], 0, 0, 0); }
        P6I_KS(0) P6I_KS(1) P6I_KS(2) P6I_KS(3)
#undef P6I_KS
        if (lane < 16) {
#pragma unroll
            for (int cb = 0; cb < 8; ++cb) *(LAS unsigned short*)(rs + 2 * (16 * cb + n)) = (unsigned short)(cvtpk((acc[cb][0] + acc[cb][1] * (1.0f / 16.0f)) * (1.0f / 128.0f), 0.f) & 0xffffu);
        }
        P6_WAITL();
        const unsigned w = *(const LAS unsigned*)(rs + 4 * lane);
        P6_WAITL();
        *(unsigned*)(delta + (size_t)t * DM + 128 * sl + 2 * lane) = cvtpk(bflo(w) + bflo(xs), bfhi(w) + bfhi(xs));
    }
    P6_WAITV(0); P6_WAITL();
#undef P6I_SM
}
#undef P6I_T
#undef P6I_S
DI void final_token(int t, int lane, float* outp, const bf16_t* x1b, const bf16_t* delta, const float* g_fin) {
    f32x4* orow = (f32x4*)(outp + (size_t)t * DM) + lane; const u32x2* xr = (const u32x2*)(x1b + (size_t)t * DM) + lane; const u32x2* dr = (const u32x2*)(delta + (size_t)t * DM) + lane; const f32x4* gr = (const f32x4*)g_fin + lane;
    f32x4 v[4]; float ss = 0.f;
#pragma unroll
    for (int i = 0; i < 4; ++i) { const u32x2 d = dr[64 * i], x = xr[64 * i]; v[i][0] = bflo(x.x) + bflo(d.x); v[i][1] = bfhi(x.x) + bfhi(d.x); v[i][2] = bflo(x.y) + bflo(d.y); v[i][3] = bfhi(x.y) + bfhi(d.y);
        ss += (v[i][0] * v[i][0] + v[i][1] * v[i][1]) + (v[i][2] * v[i][2] + v[i][3] * v[i][3]); }
    const float r2 = 1.0f / sqrtf(wave_sum(ss) * (1.f / DM) + EPS);
#pragma unroll
    for (int i = 0; i < 4; ++i) orow[64 * i] = v[i] * r2 * gr[64 * i];
}
template <int U> DI void final_tokens(int tb, int lane, float* outp, const bf16_t* x1b, const bf16_t* delta, const float* g_fin) {
    u32x2 xr[U][4], dr[U][4];
#pragma unroll
    for (int u = 0; u < U; ++u) { const u32x2* xp = (const u32x2*)(x1b + (size_t)(tb + u) * DM) + lane; const u32x2* dp = (const u32x2*)(delta + (size_t)(tb + u) * DM) + lane;
#pragma unroll
        for (int i = 0; i < 4; ++i) { xr[u][i] = xp[64 * i]; dr[u][i] = dp[64 * i]; } }
    f32x4 g[4];
#pragma unroll
    for (int i = 0; i < 4; ++i) g[i] = *((const f32x4*)g_fin + lane + 64 * i);
#pragma unroll
    for (int u = 0; u < U; ++u) { f32x4 v[4]; float ss = 0.f;
#pragma unroll
        for (int i = 0; i < 4; ++i) { const u32x2 d = dr[u][i], x = xr[u][i]; v[i][0] = bflo(x.x) + bflo(d.x); v[i][1] = bfhi(x.x) + bfhi(d.x); v[i][2] = bflo(x.y) + bflo(d.y); v[i][3] = bfhi(x.y) + bfhi(d.y);
            ss += (v[i][0] * v[i][0] + v[i][1] * v[i][1]) + (v[i][2] * v[i][2] + v[i][3] * v[i][3]); }
        const float r2 = 1.0f / sqrtf(wave_sum(ss) * (1.f / DM) + EPS);
        f32x4* orow = (f32x4*)(outp + (size_t)(tb + u) * DM) + lane;
#pragma unroll
        for (int i = 0; i < 4; ++i) __builtin_nontemporal_store(v[i] * r2 * g[i], orow + 64 * i); }
}
template <int U> DI void final_tokens_y(int tb, int lane, float* outp, const bf16_t* y, const float* g_fin) {
    u32x2 dr[U][4];
#pragma unroll
    for (int u = 0; u < U; ++u) { const u32x2* dp = (const u32x2*)(y + (size_t)(tb + u) * DM) + lane;
#pragma unroll
        for (int i = 0; i < 4; ++i) dr[u][i] = dp[64 * i]; }
    f32x4 g[4];
#pragma unroll
    for (int i = 0; i < 4; ++i) g[i] = *((const f32x4*)g_fin + lane + 64 * i);
#pragma unroll
    for (int u = 0; u < U; ++u) { f32x4 v[4]; float ss = 0.f;
#pragma unroll
        for (int i = 0; i < 4; ++i) { const u32x2 d = dr[u][i]; v[i][0] = bflo(d.x); v[i][1] = bfhi(d.x); v[i][2] = bflo(d.y); v[i][3] = bfhi(d.y);
            ss += (v[i][0] * v[i][0] + v[i][1] * v[i][1]) + (v[i][2] * v[i][2] + v[i][3] * v[i][3]); }
        const float r2 = 1.0f / sqrtf(wave_sum(ss) * (1.f / DM) + EPS);
        f32x4* orow = (f32x4*)(outp + (size_t)(tb + u) * DM) + lane;
#pragma unroll
        for (int i = 0; i < 4; ++i) __builtin_nontemporal_store(v[i] * r2 * g[i], orow + 64 * i); }
}
}

constexpr int N_LAUNCHES = MK_N_LAUNCHES;
constexpr int N_PHASES = 7;

__global__ void __launch_bounds__(NWAVES * 64, 2) hymba_fwd(Args args) {
    extern __shared__ __attribute__((aligned(16))) unsigned char lds_raw[];
    Frame F;
    F.lds = (LAS unsigned char*)lds_raw;
    volatile LAS unsigned* MISC = (volatile LAS unsigned*)(F.lds + MISC_OFF);
    F.tid = threadIdx.x; F.lane = F.tid & 63; F.wave = __builtin_amdgcn_readfirstlane(F.tid >> 6);
    F.G = gridDim.x; { const int bx = blockIdx.x; F.vcu = (F.G % 8 == 0) ? (bx % 8) * (F.G / 8) + bx / 8 : bx; }
    unsigned char* ws = args.ws;
    unsigned* ctl = (unsigned*)(ws + WS_CTL);
    const float* x = args.in[0]; const float* g_mix = args.in[1]; const float* w_in = args.in[2]; const float* conv_w = args.in[3];
    const float* g_conv = args.in[4]; const float* g_attn = args.in[5]; const float* w_out = args.in[6]; const float* g_ffn = args.in[7];
    const float* w_q = args.in[8]; const float* sk1 = args.in[9]; const float* sk2 = args.in[10]; const float* e_down = args.in[11]; const float* e_up = args.in[12];
    const float* g_fin = args.in[13];
    float* out = args.out;
    bf16_t* WinT = (bf16_t*)(ws + WS_WIN); bf16_t* WoutT = (bf16_t*)(ws + WS_WOUT); bf16_t* WqT = (bf16_t*)(ws + WS_WQ);
    bf16_t* K1b = (bf16_t*)(ws + WS_K1); bf16_t* K2b = (bf16_t*)(ws + WS_K2);
    bf16_t* XN = (bf16_t*)(ws + WS_XN); bf16_t* PROJ = (bf16_t*)(ws + WS_PROJ); bf16_t* QRY = (bf16_t*)(ws + WS_QRY); bf16_t* Yb = (bf16_t*)(ws + WS_Y);
    unsigned char* ED8 = ws + WS_ED; unsigned char* EU8 = ws + WS_EU;
    float* KSUM = (float*)(ws + WS_KSUM); float* SSQA = (float*)(ws + WS_SSQA); float* SSQX = (float*)(ws + WS_SSQX);
    float* RMS0 = (float*)(ws + WS_RMS0); bf16_t* IDM = (bf16_t*)(ws + WS_IDM);
    int* EIDX = (int*)(ws + WS_EIDX); float* GATE = (float*)(ws + WS_GATE);

    if (F.tid < 64) MISC[F.tid] = 0u;
    __syncthreads();
    XcdBarrier bar; bar.bar = ctl + CW_BAR; bar.x = 0; bar.st = nullptr;
    if (N_LAUNCHES == 1) bar = xcd_barrier_post(ctl + CW_BAR, MISC + 8);
#define GRID_BAR() do { if (N_LAUNCHES == 1) xcd_barrier(bar); } while (0)
    const int lo = args.ph_lo, hi = args.ph_hi;
#define IN(k) (lo <= (k) && (k) < hi)
#define BOTH(k) (IN(k) && IN((k) + 1))
    const int gw = F.vcu * NWAVES + F.wave, NGW = F.G * NWAVES;

    if (IN(0)) for (int rep = 0; rep < NREP(0); ++rep) {
        LAS float* scr = (LAS float*)(F.lds + F.wave * 16384);
        constexpr int I_IN = (DM / 64) * (DPROJ / 32), I_OUT = (DM / 64) * (DM / 32), I_Q = (DM / 64) * (2048 / 32);
        constexpr int I_SK = 131072 / 512, I_EX = (NEXP * DM) / 512;
        for (int r0 = gw * 4; r0 < M_TOK; r0 += NGW * 4) p0_xn_rows<4>(x, g_mix, XN, RMS0, r0, F.lane);
        for (int n = gw; n < 256; n += NGW) {
            u32x4 z0 = (u32x4){0u, 0u, 0u, 0u}, z1 = z0; const int kk = n - 16 * F.lane;
            if (kk >= 0 && kk < 16) { const unsigned one = (kk & 1) ? 0x3F800000u : 0x00003F80u; const int wi = kk >> 1;
                if (wi < 4) { if (wi == 0) z0.x = one; else if (wi == 1) z0.y = one; else if (wi == 2) z0.z = one; else z0.w = one; }
                else { if (wi == 4) z1.x = one; else if (wi == 5) z1.y = one; else if (wi == 6) z1.z = one; else z1.w = one; } }
            st16_wt(IDM + (size_t)n * DM + 16 * F.lane, z0); st16_wt(IDM + (size_t)n * DM + 16 * F.lane + 8, z1);
        }
        constexpr int NITEMS = I_IN + I_OUT + I_Q + 2 * I_SK;
        const int p0_items = (NGW == NITEMS - I_IN) ? I_IN : NITEMS;
        for (int it = gw; it < p0_items; it += NGW) {
            int r = it;
            if (r < I_IN) { p0_transpose_item(w_in, DM, DPROJ, WinT, g_mix, g_mix, DM, scr, r, F.lane); continue; } r -= I_IN;
            if (r < I_OUT) { p0_transpose_item(w_out, DM, DM, WoutT, g_conv, g_attn, 512, scr, r, F.lane); continue; } r -= I_OUT;
            if (r < I_Q) { p0_transpose_item(w_q, DM, 2048, WqT, g_ffn, g_ffn, DM, scr, r, F.lane); continue; } r -= I_Q;
            if (r < I_SK) { p0_cvt_item(sk1, K1b, (size_t)r, F.lane); continue; } r -= I_SK;
            p0_cvt_item(sk2, K2b, (size_t)r, F.lane);
        }
        if (BOTH(0)) GRID_BAR();
    }
    if (IN(1)) for (int rep = 0; rep < NREP(1); ++rep) {
        pg8::Gemm g{XN, WinT, M_TOK, DPROJ, DM, DM, DM}; pg8::StaticOrder S; S.init(M_TOK, DPROJ, F.G, (int)blockIdx.x);
        pg8::EpiProj E{PROJ, KSUM};
        pg8::gemm_phase<pg8::EpiProj, pg8::StaticOrder, true>(F.lds, g, S, E);
        if (BOTH(1)) GRID_BAR();
    }
    if (IN(2)) for (int rep = 0; rep < NREP(2); ++rep) {
        bool conv_done = false;
        for (int v = F.vcu; v < 256; v += F.G) {
            const int bh = v >> 2, s = v & 3;
            att2::attn_unit<8>(bh >> 3, bh & 7, s, (const att2::bf16*)(PROJ + QOFF), (const att2::bf16*)(PROJ + KOFF), (const att2::bf16*)(PROJ + VOFF), (att2::bf16*)(Yb + 512), KSUM, SSQA, (char*)lds_raw);
            if (!conv_done) { conv_done = true;
                if (NGW * 8 == M_TOK) att::conv_rows8(PROJ, conv_w, Yb, gw * 8, F.lane);
                else for (int r0 = gw * 4; r0 < M_TOK; r0 += NGW * 4) att::conv_rows4(PROJ, conv_w, Yb, r0, F.lane); }
            att2::attn_unit<8>(bh >> 3, bh & 7, 7 - s, (const att2::bf16*)(PROJ + QOFF), (const att2::bf16*)(PROJ + KOFF), (const att2::bf16*)(PROJ + VOFF), (att2::bf16*)(Yb + 512), KSUM, SSQA, (char*)lds_raw);
        }
        if (!conv_done) for (int r0 = gw * 4; r0 < M_TOK; r0 += NGW * 4) att::conv_rows4(PROJ, conv_w, Yb, r0, F.lane);
        __syncthreads();
        { constexpr int J_OUT = (DM / 64) * (DM / 32), J_Q = (DM / 64) * (2048 / 32), J_SK = 131072 / 512;
          if (NGW == J_OUT + J_Q + 2 * J_SK) {
              LAS float* scr2 = (LAS float*)(F.lds + F.wave * 16384); const int r = gw;
              if (r < J_OUT) p0_transpose_item(w_out, DM, DM, WoutT, g_conv, g_attn, 512, scr2, r, F.lane);
              else if (r < J_OUT + J_Q) p0_transpose_item(w_q, DM, 2048, WqT, g_ffn, g_ffn, DM, scr2, r - J_OUT, F.lane);
              else { const int q = r - J_OUT - J_Q; if (q < J_SK) p0_cvt_item(sk1, K1b, (size_t)q, F.lane); else p0_cvt_item(sk2, K2b, (size_t)(q - J_SK), F.lane); }
              __syncthreads(); } }
        if (BOTH(2)) GRID_BAR();
    }
    if (IN(3)) for (int rep = 0; rep < NREP(3); ++rep) {
        pg8::StaticOrder S; S.init(M_TOK, DM, F.G, (int)blockIdx.x);
        pg8::Unit u0;
        if (S.next(0, u0)) {
            if (F.tid < 256) { const f32x4* sp = (const f32x4*)(SSQA + (size_t)(u0.pm * 256 + F.tid) * 8); const f32x4 a = sp[0], b = sp[1];
                const float ms = (((a[0] + a[1]) + (a[2] + a[3])) + ((b[0] + b[1]) + (b[2] + b[3]))) * (1.f / 512.f) + EPS; const float rms = sqrtf(ms);
                LAS float* tab = (LAS float*)(F.lds + TAB_OFF); tab[F.tid] = rms; tab[256 + F.tid] = 1.0f / rms; tab[1536 + F.tid] = RMS0[u0.pm * 256 + F.tid]; }
            else ((LAS f32x4*)(F.lds + TAB_OFF + 2048))[F.tid - 256] = ((const f32x4*)g_ffn)[F.tid - 256];
        }
        __syncthreads();
        pg8::Gemm g{Yb, WoutT, M_TOK, DM, DM, DM, DM, XN, IDM, 4};
        pg8::EpiX1 E{x, out, XN, SSQX, TAB_OFF, ws + WS_XQH, ws + WS_XQL};
        pg8::gemm_phase<pg8::EpiX1, pg8::StaticOrder, false>(F.lds, g, S, E);
        if (BOTH(3)) GRID_BAR();
    }
    if (IN(4)) for (int rep = 0; rep < NREP(4); ++rep) {
        pg8::Gemm g{XN, WqT, M_TOK, 2048, DM, DM, DM}; pg8::HeadOrder S; S.init(M_TOK, 2048, F.G, (int)blockIdx.x);
        pg8::EpiBf16 E{QRY, 2048};
        pg8::gemm_phase<pg8::EpiBf16, pg8::HeadOrder, true>(F.lds, g, S, E);
        asm volatile("s_waitcnt vmcnt(0)" ::: "memory");
        __syncthreads();
    }
    if (IN(5)) for (int rep = 0; rep < NREP(5); ++rep) {
        if (!IN(4)) { }
        pg8::HeadOrder S; S.init(M_TOK, 2048, F.G, (int)blockIdx.x);
        pg8::Unit u5; int cur_h = -1;
        for (int ui = 0; S.next(ui, u5); ++ui) {
            const int h = u5.pn; const int L = ui * F.G + (int)blockIdx.x;
            if (h != cur_h) {
                __syncthreads();
                p5w::keys_to_lds(F.lds, K1b, K2b, h, F.tid);
                __syncthreads();
                cur_h = h;
                if (F.wave >= 4) __builtin_amdgcn_s_sleep(24);
            }
            const int it0 = (L * NWAVES + F.wave) * 16; const bool dn = it0 < (NEXP * DM) / 512;
            p5w::unit_rows32(F.lds, F.lane, F.wave, u5.pm * 256 + 32 * F.wave, h, QRY, SSQX, EIDX, GATE, dn ? e_down : e_up, dn ? ED8 : EU8, (size_t)(dn ? it0 : it0 - (NEXP * DM) / 512), dn ? p6::SC_DOWN : p6::SC_UP, nullptr);
        }
        __syncthreads();
        if (BOTH(5)) GRID_BAR();
    }
    if (IN(6)) {
        bf16_t* DELTA = (bf16_t*)(ws + WS_DELTA); unsigned char* CQ = ws + WS_CQ; const bf16_t* X1S = XN;
        LAS unsigned char* img = F.lds + F.wave * 16384; LAS unsigned char* sm = F.lds + 131072 + F.wave * 2048; LAS unsigned char* rs = F.lds + 147456 + F.wave * 256;
        for (int g = gw; g < M_TOK / 8; g += NGW) {
            const int t0 = 8 * g;
            float pacc[8][8];
#pragma unroll
            for (int a = 0; a < 8; ++a)
#pragma unroll
                for (int b = 0; b < 8; ++b) pacc[a][b] = 0.f;
            p6::own_down(t0, img, sm, EIDX, ws + WS_XQH, ws + WS_XQL, ED8, pacc);
            p6::own_c2(t0, img, pacc, SSQX, GATE, CQ, EIDX, EU8);
            p6::own_up<true>(t0, img, sm, rs, EIDX, CQ, EU8, X1S, DELTA);
            asm volatile("s_waitcnt vmcnt(0)" ::: "memory");
            p6::final_tokens_y<8>(t0, p6::opaque_lane(), out, DELTA, g_fin);
        }
    }
#undef IN
#undef BOTH
#undef GRID_BAR
}

extern "C" void kernel_launch(void* const* d_in, const int* in_sizes, int n_in, void* d_out, int out_size, void* d_ws, size_t ws_size, hipStream_t stream) {
    static int grid = 0;
    if (grid == 0) {
        if (n_in != 14 || in_sizes[0] != M_TOK * DM || out_size != M_TOK * DM || ws_size < WS_END) { fprintf(stderr, "kernel_launch: unexpected problem shape (n_in %d, in0 %d, out %d, ws %zu)\n", n_in, n_in > 0 ? in_sizes[0] : -1, out_size, ws_size); grid = -1; return; }
        int dev = 0, cus = 0;
        if (hipGetDevice(&dev) != hipSuccess || hipDeviceGetAttribute(&cus, hipDeviceAttributeMultiprocessorCount, dev) != hipSuccess) { grid = -1; return; }
        if (hipFuncSetAttribute((const void*)hymba_fwd, hipFuncAttributeMaxDynamicSharedMemorySize, LDS_BYTES) != hipSuccess) { fprintf(stderr, "kernel_launch: hipFuncSetAttribute failed\n"); grid = -1; return; }
        (void)hipGetLastError();
        grid = cus;
        if (grid != 256) fprintf(stderr, "kernel_launch: %d CUs (built for 256)\n", grid);
    }
    if (grid < 0) return;
    if (hipMemsetAsync((char*)d_ws + WS_CTL, 0, CTL_ZERO_BYTES, stream) != hipSuccess) return;
    Args a{};
    for (int i = 0; i < 14; ++i) a.in[i] = (const float*)d_in[i];
    a.out = (float*)d_out; a.ws = (unsigned char*)d_ws;
    if (N_LAUNCHES == 1) {
        a.ph_lo = 0; a.ph_hi = N_PHASES; a.li = 0;
        hipLaunchKernelGGL(hymba_fwd, dim3(grid), dim3(NWAVES * 64), LDS_BYTES, stream, a);
    } else {
        for (int li = 0; li < N_PHASES; ++li) { a.ph_lo = li; a.ph_hi = li + 1; a.li = li; hipLaunchKernelGGL(hymba_fwd, dim3(grid), dim3(NWAVES * 64), LDS_BYTES, stream, a); }
    }
}
```

```cpp
#include <hip/hip_runtime.h>
#include <hip/hip_bf16.h>
#include <cstdio>
#include <cstdint>
#include <cmath>

#ifndef MK_N_LAUNCHES
#define MK_N_LAUNCHES 1
#endif

#ifndef PROBE_REP
#define PROBE_REP 0
#endif
#define NREP(k) (((PROBE_REP >> (k)) & 1) + 1)
#define DI __device__ __forceinline__
#define LAS __attribute__((address_space(3)))
#define GAS __attribute__((address_space(1)))

typedef unsigned short bf16_t;
typedef short bf16x8 __attribute__((ext_vector_type(8)));
typedef float f32x4 __attribute__((ext_vector_type(4)));
typedef float f32x16 __attribute__((ext_vector_type(16)));
typedef unsigned u32x4 __attribute__((ext_vector_type(4)));
typedef unsigned u32x2 __attribute__((ext_vector_type(2)));
typedef float f32x2_t __attribute__((ext_vector_type(2)));
typedef __bf16 bf16x2_t __attribute__((ext_vector_type(2)));

constexpr int M_TOK = 16384, DM = 1024, DPROJ = 3072, SEQ = 2048, NBATCH = 8, NH = 8, HD = 64;
constexpr int KOFF = 2048, VOFF = 2560, QOFF = 1536;
constexpr int NEXP = 16384, PEER_H = 8, PEER_TOPK = 16;
constexpr float EPS = 1e-6f;
constexpr float C2 = 0.125f * 1.4426950408889634f;

DI unsigned cvtpk(float lo, float hi) { f32x2_t v = {lo, hi}; bf16x2_t b = __builtin_convertvector(v, bf16x2_t); return __builtin_bit_cast(unsigned, b); }
DI float bflo(unsigned w) { return __uint_as_float(w << 16); }
DI float bfhi(unsigned w) { return __uint_as_float(w & 0xffff0000u); }
DI void st16_wt(void* p, u32x4 v) { asm volatile("global_store_dwordx4 %0, %1, off sc1\n\ts_nop 1" :: "v"(p), "v"(v) : "memory"); }
DI void st4_wt(void* p, unsigned v) { asm volatile("global_store_dword %0, %1, off sc1" :: "v"(p), "v"(v) : "memory"); }
DI void st8_wt(void* p, u32x2 v) { asm volatile("global_store_dwordx2 %0, %1, off sc1" :: "v"(p), "v"(v) : "memory"); }
DI float wave_sum(float v) {
#pragma unroll
    for (int o = 1; o < 64; o <<= 1) v += __shfl_xor(v, o);
    return v;
}

namespace pg8 {
constexpr int BM = 256, BK = 64, HALF = 128, HTB = HALF * BK * 2, STAGE_BYTES = 8 * HTB, NXCD = 8, WGM = 8;
__host__ __device__ __forceinline__ int lds_byte(int r, int c) { const int st = (r >> 4) * 2 + (c >> 5), rr = r & 15, cc = c & 31, ob = rr * 64 + cc * 2; return st * 1024 + (ob ^ (((ob >> 9) & 1) << 5)); }
__host__ __device__ __forceinline__ void stage_rc(int b, int& R, int& C) { const int st = b / 1024, sb = b % 1024, swz = sb ^ (((sb >> 9) & 1) << 5); R = (st >> 1) * 16 + swz / 64; C = (st & 1) * 32 + (swz % 64) / 2; }
__host__ __device__ __forceinline__ int perm32(int rho) { const int n = rho >> 4, i = rho & 15; return 8 * (i >> 2) + 4 * n + (i & 3); }

struct Unit { int pm, pn; };
struct Gemm { const bf16_t* A; const bf16_t* Bt; int M, N, K, lda, ldb; const bf16_t* XA = nullptr; const bf16_t* XBt = nullptr; int nx = 0; };

struct StaticOrder {
    int nM, nN, nwg, G, c;
    __host__ __device__ void init(int M, int N, int G_, int c_) { nM = M / BM; nN = N / BM; nwg = nM * nN; G = G_; c = c_; }
    __host__ __device__ bool next(int i, Unit& u) const {
        const long L = (long)i * G + c; if (L >= nwg) return false;
        int wgid = (int)L; { const int q = nwg / NXCD, r = nwg % NXCD, xcd = wgid % NXCD, off = wgid / NXCD; wgid = (xcd < r ? xcd * (q + 1) : r * (q + 1) + (xcd - r) * q) + off; }
        const int nig = WGM * nN, gid = wgid / nig, fm = gid * WGM, gsz = (nM - fm) < WGM ? (nM - fm) : WGM;
        u.pm = fm + ((wgid % nig) % gsz); u.pn = (wgid % nig) / gsz; return true;
    }
};

struct HeadOrder {
    StaticOrder S; bool head;
    __host__ __device__ void init(int M, int N, int G_, int c_) { S.init(M, N, G_, c_); head = (G_ == 256 && S.nM == 64 && S.nN == 8); }
    __host__ __device__ bool next(int i, Unit& u) const {
        if (!head) return S.next(i, u);
        if (i >= 2) return false;
        const int xcd = S.c % NXCD, off = S.c / NXCD;
        u.pm = 8 * xcd + 4 * i + (off & 3); u.pn = off >> 2; return true;
    }
};

DI size_t qry_off(int pm, int head, int half, int g, int ks, int qrow, int lh) { return ((((((size_t)(pm * 8 + head) * 2 + half) * 8 + g) * 8 + ks) * 32 + qrow) * 2 + lh) * 8; }
struct EpiBf16 {
    static constexpr bool PERM = true, MID = false;
    bf16_t* O; int ldc;
    DI void mid(f32x4 (&)[2][2][4][2], const Unit&, int, int, LAS unsigned char*, int) const {}
    DI void operator()(const f32x4 (&acc)[2][2][4][2], const Unit& u, int wr, int wc, int fr, int fq, LAS unsigned char*) const {
        const int c = 4 * wc + fq;
#pragma unroll
        for (int ai = 0; ai < 2; ++ai)
#pragma unroll
            for (int m = 0; m < 4; ++m) { const int rl = ai * HALF + wr * 64 + m * 16 + fr;
#pragma unroll
                for (int bj = 0; bj < 2; ++bj) { const f32x4 v0 = acc[ai][bj][m][0], v1 = acc[ai][bj][m][1];
                    u32x4 w; w.x = cvtpk(v0[0], v0[1]); w.y = cvtpk(v0[2], v0[3]); w.z = cvtpk(v1[0], v1[1]); w.w = cvtpk(v1[2], v1[3]);
                    *(u32x4*)(O + qry_off(u.pm, u.pn, bj, rl >> 5, c >> 1, rl & 31, c & 1)) = w; } }
    }
};
struct EpiProj {
    static constexpr bool PERM = true, MID = false;
    bf16_t* O; float* ksum;
    DI void mid(f32x4 (&)[2][2][4][2], const Unit&, int, int, LAS unsigned char*, int) const {}
    DI void operator()(const f32x4 (&acc)[2][2][4][2], const Unit& u, int wr, int wc, int fr, int fq, LAS unsigned char*) const {
        const int row0 = u.pm * BM + wr * 64 + fr, col0 = u.pn * BM + wc * 32 + 8 * fq;
        const float sc = (u.pn == 6 || u.pn == 7) ? C2 : 1.0f;
#pragma unroll
        for (int ai = 0; ai < 2; ++ai)
#pragma unroll
            for (int m = 0; m < 4; ++m) { bf16_t* rowp = O + (size_t)(row0 + ai * HALF + m * 16) * DPROJ + col0;
#pragma unroll
                for (int bj = 0; bj < 2; ++bj) { const f32x4 v0 = acc[ai][bj][m][0] * sc, v1 = acc[ai][bj][m][1] * sc;
                    u32x4 w; w.x = cvtpk(v0[0], v0[1]); w.y = cvtpk(v0[2], v0[3]); w.z = cvtpk(v1[0], v1[1]); w.w = cvtpk(v1[2], v1[3]);
                    st16_wt(rowp + bj * HALF, w); } }
        if (u.pn == 8 || u.pn == 9) {
            float* kd = ksum + (size_t)u.pm * 512 + (u.pn - 8) * 256 + wc * 32 + 8 * fq;
#pragma unroll
            for (int bj = 0; bj < 2; ++bj)
#pragma unroll
                for (int n = 0; n < 2; ++n)
#pragma unroll
                    for (int j = 0; j < 4; ++j) {
                        float s = 0.f;
#pragma unroll
                        for (int ai = 0; ai < 2; ++ai)
#pragma unroll
                            for (int m = 0; m < 4; ++m) s += acc[ai][bj][m][n][j];
                        s += __shfl_xor(s, 1); s += __shfl_xor(s, 2); s += __shfl_xor(s, 4); s += __shfl_xor(s, 8);
                        if (fr == 0) atomicAdd(kd + bj * HALF + 4 * n + j, s);
                    }
        }
    }
};
struct EpiX1 {
    static constexpr bool PERM = true, MID = true;
    const float* x; float* x1; bf16_t* x1b; float* ssqx; int tab_off; unsigned char* xqh; unsigned char* xql;
    static constexpr int T_MID0 = 4, T_MID1 = 12;
    DI void mid(f32x4 (&acc)[2][2][4][2], const Unit&, int wr, int fr, LAS unsigned char* lds, int which) const {
        const LAS float* tabA = (const LAS float*)(lds + tab_off) + (which ? 0 : 1536);
#pragma unroll
        for (int ai = 0; ai < 2; ++ai)
#pragma unroll
            for (int m = 0; m < 4; ++m) { const float f = tabA[ai * HALF + wr * 64 + m * 16 + fr];
#pragma unroll
                for (int bj = 0; bj < 2; ++bj)
#pragma unroll
                    for (int n = 0; n < 2; ++n) acc[ai][bj][m][n] *= f; }
    }
    DI void operator()(const f32x4 (&acc)[2][2][4][2], const Unit& u, int wr, int wc, int fr, int fq, LAS unsigned char* lds) const {
        int tbo = tab_off; asm volatile("" : "+s"(tbo));
        const LAS float* tabB = (const LAS float*)(lds + tbo) + 256; const LAS float* gtab = (const LAS float*)(lds + tbo) + 512;
        const int col0 = u.pn * BM + wc * 32 + 8 * fq;
#pragma unroll
        for (int ai = 0; ai < 2; ++ai) {
#pragma unroll
            for (int m = 0; m < 4; ++m) { const int r = ai * HALF + wr * 64 + m * 16 + fr; const float rs = tabB[r]; const size_t off = (size_t)(u.pm * BM + r) * DM + col0;
                float ss = 0.f;
#pragma unroll
                for (int bj = 0; bj < 2; ++bj) {
                    const f32x4 v0 = acc[ai][bj][m][0] * rs, v1 = acc[ai][bj][m][1] * rs;
                    u32x4 w; w.x = cvtpk(v0[0], v0[1]); w.y = cvtpk(v0[2], v0[3]); w.z = cvtpk(v1[0], v1[1]); w.w = cvtpk(v1[2], v1[3]);
                    st16_wt(x1b + off + bj * HALF, w);
                    { const f32x4 ga = *(const LAS f32x4*)(gtab + col0 + bj * HALF), gb = *(const LAS f32x4*)(gtab + col0 + bj * HALF + 4);
                      const f32x2_t u01 = (f32x2_t){bflo(w.x) * ga[0], bfhi(w.x) * ga[1]}, u23 = (f32x2_t){bflo(w.y) * ga[2], bfhi(w.y) * ga[3]}, u45 = (f32x2_t){bflo(w.z) * gb[0], bfhi(w.z) * gb[1]}, u67 = (f32x2_t){bflo(w.w) * gb[2], bfhi(w.w) * gb[3]};
                      int h0 = 0, h1 = 0; h0 = __builtin_amdgcn_cvt_pk_fp8_f32(u01.x, u01.y, h0, false); h0 = __builtin_amdgcn_cvt_pk_fp8_f32(u23.x, u23.y, h0, true); h1 = __builtin_amdgcn_cvt_pk_fp8_f32(u45.x, u45.y, h1, false); h1 = __builtin_amdgcn_cvt_pk_fp8_f32(u67.x, u67.y, h1, true);
                      const f32x2_t b01 = __builtin_amdgcn_cvt_pk_f32_fp8(h0, false), b23 = __builtin_amdgcn_cvt_pk_f32_fp8(h0, true), b45 = __builtin_amdgcn_cvt_pk_f32_fp8(h1, false), b67 = __builtin_amdgcn_cvt_pk_f32_fp8(h1, true);
                      int l0 = 0, l1 = 0; l0 = __builtin_amdgcn_cvt_pk_fp8_f32((u01.x - b01.x) * 16.f, (u01.y - b01.y) * 16.f, l0, false); l0 = __builtin_amdgcn_cvt_pk_fp8_f32((u23.x - b23.x) * 16.f, (u23.y - b23.y) * 16.f, l0, true);
                      l1 = __builtin_amdgcn_cvt_pk_fp8_f32((u45.x - b45.x) * 16.f, (u45.y - b45.y) * 16.f, l1, false); l1 = __builtin_amdgcn_cvt_pk_fp8_f32((u67.x - b67.x) * 16.f, (u67.y - b67.y) * 16.f, l1, true);
                      u32x2 qh, ql; qh.x = (unsigned)h0; qh.y = (unsigned)h1; ql.x = (unsigned)l0; ql.y = (unsigned)l1;
                      *(u32x2*)(xqh + off + bj * HALF) = qh; *(u32x2*)(xql + off + bj * HALF) = ql; }
                    ss += ((v0[0] * v0[0] + v0[1] * v0[1]) + (v0[2] * v0[2] + v0[3] * v0[3])) + ((v1[0] * v1[0] + v1[1] * v1[1]) + (v1[2] * v1[2] + v1[3] * v1[3])); }
                ss += __shfl_xor(ss, 16); ss += __shfl_xor(ss, 32);
                if (fq == 0) ssqx[(size_t)(u.pm * BM + r) * 16 + u.pn * 4 + wc] = ss; }
        }
    }
};

DI const char* pg8_sgpr_ptr(const char* p) { const unsigned long long v = (unsigned long long)p; const unsigned lo = __builtin_amdgcn_readfirstlane((unsigned)v), hi = __builtin_amdgcn_readfirstlane((unsigned)(v >> 32)); return (const char*)(((unsigned long long)hi << 32) | lo); }
template <class Epi, class Sched, bool ALIGN_EPI>
DI void gemm_phase(LAS unsigned char* lds, const Gemm g, const Sched& S, const Epi& E) {
    const int tid = threadIdx.x, wid = __builtin_amdgcn_readfirstlane(tid >> 6), lane = tid & 63, wr = wid >> 2, wc = wid & 3, fr = lane & 15, fq = lane >> 4;
    const int K = g.K, nx = g.nx, nt = K / BK + nx;
    unsigned voffA[2], voffB[2];
#pragma unroll
    for (int i = 0; i < 2; ++i) { int R, C; stage_rc(tid * 16 + i * 8192, R, C); const int Rb = Epi::PERM ? ((R & ~31) + perm32(R & 31)) : R;
        voffA[i] = (unsigned)(R * g.lda + C) * 2u; voffB[i] = (unsigned)(Rb * g.ldb + C) * 2u; }
    const size_t kstep = (size_t)(BK * 2);
    const size_t hstepA = (size_t)HALF * g.lda * 2, hstepB = (size_t)HALF * g.ldb * 2;
    const size_t tstepA = 2 * hstepA, tstepB = 2 * hstepB;
    const unsigned ldsw = (unsigned)wid * 1024u;
    const int aoff = lds_byte(wr * 64 + fr, fq * 8), boff = lds_byte(wc * 32 + fr, fq * 8);
#define PG8_SA(b, h) (((b) * 2 + (h)) * HTB)
#define PG8_SB(b, h) ((4 + (b) * 2 + (h)) * HTB)
#define PG8_STAGE(bufoff, gbase, voff) do { _Pragma("unroll") for (int _i = 0; _i < 2; ++_i) \
        __builtin_amdgcn_global_load_lds((const unsigned*)((const char*)(gbase) + (voff)[_i]), (LAS unsigned*)(lds + (bufoff) + ldsw + _i * 8192), 16, 0, 0); } while (0)
#define PG8_LDA(dst, b, h) do { _Pragma("unroll") for (int m = 0; m < 4; ++m) _Pragma("unroll") for (int k = 0; k < 2; ++k) dst[m][k] = *(const LAS bf16x8*)(lds + PG8_SA(b, h) + aoff + m * 2048 + k * 1024); } while (0)
#define PG8_LDB(dst, b, h) do { _Pragma("unroll") for (int n = 0; n < 2; ++n) _Pragma("unroll") for (int k = 0; k < 2; ++k) dst[n][k] = *(const LAS bf16x8*)(lds + PG8_SB(b, h) + boff + n * 2048 + k * 1024); } while (0)
#define PG8_MMA(ai, bj, At, Bt) do { __builtin_amdgcn_s_setprio(1); _Pragma("unroll") for (int m = 0; m < 4; ++m) _Pragma("unroll") for (int n = 0; n < 2; ++n) _Pragma("unroll") for (int k = 0; k < 2; ++k) \
        acc[ai][bj][m][n] = __builtin_amdgcn_mfma_f32_16x16x32_bf16(Bt[n][k], At[m][k], acc[ai][bj][m][n], 0, 0, 0); __builtin_amdgcn_s_setprio(0); } while (0)
#define PG8_WAIT_V(n) asm volatile("s_waitcnt vmcnt(" #n ")" ::: "memory")
#define PG8_WAIT_L(n) asm volatile("s_waitcnt lgkmcnt(" #n ")" ::: "memory")
#define PG8_BAR __builtin_amdgcn_s_barrier()
#define PG8_SCHED __builtin_amdgcn_sched_barrier(0)
    Unit cur, nxt; int ui = 0;
    if (!S.next(0, cur)) return;
    f32x4 acc[2][2][4][2];
#pragma unroll
    for (int a = 0; a < 2; ++a)
#pragma unroll
        for (int b = 0; b < 2; ++b)
#pragma unroll
            for (int m = 0; m < 4; ++m)
#pragma unroll
                for (int n = 0; n < 2; ++n) acc[a][b][m][n] = (f32x4){0.f, 0.f, 0.f, 0.f};
    bf16x8 At[4][2], B0[2][2], B1[2][2];
    const char* cA = (const char*)g.A + (size_t)cur.pm * tstepA; const char* cB = (const char*)g.Bt + (size_t)cur.pn * tstepB;
    const char* xB = (const char*)g.XBt;
    const char* xA = (const char*)g.XA + (size_t)cur.pm * tstepA + (size_t)cur.pn * (BM * 2);
#define PG8_SP(p) pg8_sgpr_ptr(p)
#define PG8_TA(t) PG8_SP((t) < nx ? xA + (size_t)(t) * kstep : cA + (size_t)((t) - nx) * kstep)
#define PG8_TB(t) PG8_SP((t) < nx ? xB + (size_t)(t) * kstep : cB + (size_t)((t) - nx) * kstep)
    { const char* a0 = PG8_TA(0); const char* b0 = PG8_TB(0); const char* a1p = PG8_TA(1); const char* b1p = PG8_TB(1);
    PG8_STAGE(PG8_SB(0, 0), b0, voffB); PG8_STAGE(PG8_SB(0, 1), b0 + hstepB, voffB); PG8_STAGE(PG8_SA(0, 0), a0, voffA); PG8_STAGE(PG8_SA(0, 1), a0 + hstepA, voffA);
    if (wr == 1) PG8_BAR;
    PG8_WAIT_V(2); PG8_BAR;
    PG8_STAGE(PG8_SB(1, 0), b1p, voffB); PG8_STAGE(PG8_SA(1, 0), a1p, voffA); PG8_STAGE(PG8_SB(1, 1), b1p + hstepB, voffB); }
    PG8_WAIT_V(6); PG8_BAR;
    for (;;) {
        const bool has_next = S.next(ui + 1, nxt);
        const char* nA = has_next ? (const char*)g.A + (size_t)nxt.pm * tstepA : cA; const char* nB = has_next ? (const char*)g.Bt + (size_t)nxt.pn * tstepB : cB;
        const char* nxA = has_next ? (const char*)g.XA + (size_t)nxt.pm * tstepA + (size_t)nxt.pn * (BM * 2) : xA;
        const char* n0A = nx ? nxA : nA; const char* n0B = nx ? xB : nB;
        for (int t = 0; t < nt; t += 2) {
            const bool last = (t == nt - 2);
            if constexpr (Epi::MID) { if (t == Epi::T_MID0) E.mid(acc, cur, wr, fr, lds, 0); if (t == Epi::T_MID1) E.mid(acc, cur, wr, fr, lds, 1); }
            const char* a1 = PG8_TA(t + 1);
            const char* a2 = PG8_SP(last ? n0A : PG8_TA(t + 2)); const char* b2 = PG8_SP(last ? n0B : PG8_TB(t + 2));
            const char* a3 = PG8_SP(last ? n0A + kstep : PG8_TA(t + 3)); const char* b3 = PG8_SP(last ? n0B + kstep : PG8_TB(t + 3));
            PG8_LDB(B0, 0, 0); PG8_LDB(B1, 0, 1); PG8_SCHED; PG8_LDA(At, 0, 0); PG8_STAGE(PG8_SA(1, 1), a1 + hstepA, voffA);
            PG8_WAIT_V(8); PG8_WAIT_L(0); PG8_BAR; PG8_MMA(0, 0, At, B0); PG8_MMA(0, 1, At, B1); PG8_BAR; PG8_SCHED;
            PG8_LDA(At, 0, 1); PG8_STAGE(PG8_SB(0, 0), b2, voffB); PG8_STAGE(PG8_SB(0, 1), b2 + hstepB, voffB); PG8_STAGE(PG8_SA(0, 0), a2, voffA);
            PG8_WAIT_V(8); PG8_WAIT_L(0); PG8_BAR; PG8_MMA(1, 0, At, B0); PG8_MMA(1, 1, At, B1); PG8_BAR; PG8_SCHED;
            PG8_LDB(B0, 1, 0); PG8_LDB(B1, 1, 1); PG8_SCHED; PG8_LDA(At, 1, 0); PG8_STAGE(PG8_SA(0, 1), a2 + hstepA, voffA);
            PG8_WAIT_V(8); PG8_WAIT_L(0); PG8_BAR; PG8_MMA(0, 0, At, B0); PG8_MMA(0, 1, At, B1); PG8_BAR; PG8_SCHED;
            PG8_LDA(At, 1, 1); PG8_STAGE(PG8_SB(1, 0), b3, voffB); PG8_STAGE(PG8_SB(1, 1), b3 + hstepB, voffB); PG8_STAGE(PG8_SA(1, 0), a3, voffA);
            PG8_WAIT_V(8); PG8_WAIT_L(0); PG8_BAR; PG8_MMA(1, 0, At, B0); PG8_MMA(1, 1, At, B1); PG8_BAR; PG8_SCHED;
        }
        if constexpr (ALIGN_EPI) { if (wr == 0) PG8_BAR; }
        E(acc, cur, wr, wc, fr, fq, lds);
        if (!has_next) break;
#pragma unroll
        for (int a = 0; a < 2; ++a)
#pragma unroll
            for (int b = 0; b < 2; ++b)
#pragma unroll
                for (int m = 0; m < 4; ++m)
#pragma unroll
                    for (int n = 0; n < 2; ++n) acc[a][b][m][n] = (f32x4){0.f, 0.f, 0.f, 0.f};
        cur = nxt; cA = nA; cB = nB; xA = nxA; ++ui;
        if constexpr (ALIGN_EPI) { if (wr == 1) PG8_BAR; }
    }
    PG8_WAIT_V(0);
    if constexpr (!ALIGN_EPI) { if (wr == 0) PG8_BAR; }
    PG8_BAR;
#undef PG8_SA
#undef PG8_SB
#undef PG8_STAGE
#undef PG8_LDA
#undef PG8_LDB
#undef PG8_MMA
#undef PG8_WAIT_V
#undef PG8_WAIT_L
#undef PG8_BAR
#undef PG8_SCHED
}
}

constexpr size_t MiB = 1u << 20;
constexpr size_t WS_CTL = 0, CTL_ZERO_BYTES = 1 * MiB;
constexpr size_t WS_KSUM = 512 * 1024;
constexpr size_t WS_RMS0 = 768 * 1024;
constexpr size_t WS_IDM = 15 * MiB;
constexpr size_t WS_K1 = 1 * MiB, WS_K2 = WS_K1 + 256 * 1024;
constexpr size_t WS_SSQA = WS_K1 + 512 * 1024;
constexpr size_t WS_WIN = 2 * MiB, WS_WOUT = 8 * MiB, WS_WQ = 10 * MiB;
constexpr size_t WS_SSQX = 14 * MiB;
constexpr size_t WS_XN = 16 * MiB;
constexpr size_t WS_PROJ = 48 * MiB;
constexpr size_t WS_QRY = 48 * MiB;
constexpr size_t WS_EIDX = 112 * MiB, WS_GATE = 120 * MiB;
constexpr size_t WS_Y = 144 * MiB;
constexpr size_t WS_XQH = 128 * MiB, WS_XQL = 240 * MiB;
constexpr size_t WS_CQ = 48 * MiB;
constexpr size_t WS_DELTA = 144 * MiB;
constexpr size_t WS_ED = 176 * MiB, WS_EU = 208 * MiB, WS_END = 256 * MiB;
constexpr int CW_BAR = 4096;

constexpr int SCR_BYTES = 159744;
constexpr int TAB_OFF = 131072;
constexpr int MISC_OFF = SCR_BYTES;
constexpr int LDS_BYTES = 163840;
constexpr int NWAVES = 8;

#define XB_TMO      128
#define XB_XCNT(j)  (256  + 64 * (j))
#define XB_XSUB(j)  (1280 + 64 * (j))
#define XB_XGEN(j)  (2304 + 64 * (j))
#define XB_TOP      3328
#define XB_TOPGEN   3392
#define XCD_BAR_WORDS 3456
#define XB_SPIN_CAP (1u << 18)
DI unsigned xb_ld(unsigned* p)              { return __hip_atomic_load(p, __ATOMIC_RELAXED, __HIP_MEMORY_SCOPE_AGENT); }
DI unsigned xb_add(unsigned* p, unsigned v) { return __hip_atomic_fetch_add(p, v, __ATOMIC_RELAXED, __HIP_MEMORY_SCOPE_AGENT); }
DI unsigned xb_xcc_id() { return (unsigned)__builtin_amdgcn_s_getreg((3 << 11) | 20) & 0xFu; }
#define XB_SPIN(cond, bar) do { unsigned _sp = 0; while (cond) { __builtin_amdgcn_s_sleep(1); \
    if ((++_sp & 255u) == 0u) { if (xb_ld(&(bar)[XB_TMO])) break; if (_sp > XB_SPIN_CAP) { atomicAdd(&(bar)[XB_TMO], 1u); break; } } } } while (0)
struct XcdBarrier { unsigned* bar; unsigned x; volatile LAS unsigned* st; };
DI XcdBarrier xcd_barrier_post(unsigned* bar, volatile LAS unsigned* st) {
    XcdBarrier b; b.bar = bar; b.x = xb_xcc_id(); b.st = st;
    if (threadIdx.x == 0) st[3] = xb_add(&bar[XB_XCNT(b.x)], 1u);
    return b;
}
DI void xcd_barrier_complete(unsigned* bar, unsigned x, unsigned& nloc, unsigned& nx, unsigned& ord) {
    const unsigned G = gridDim.x * gridDim.y * gridDim.z;
    unsigned sum, cnt, mine, below, sp = 0u;
    for (;;) {
        sum = 0u; cnt = 0u; mine = 0u; below = 0u;
#pragma unroll
        for (unsigned j = 0; j < 16; ++j) { const unsigned c = xb_ld(&bar[XB_XCNT(j)]); sum += c; cnt += (c > 0u) ? 1u : 0u; mine = (j == x) ? c : mine; below += (c > 0u && j < x) ? 1u : 0u; }
        if (sum == G) break;
        __builtin_amdgcn_s_sleep(1);
        if ((++sp & 255u) == 0u) { if (xb_ld(&bar[XB_TMO])) break; if (sp > XB_SPIN_CAP) { atomicAdd(&bar[XB_TMO], 1u); break; } }
    }
    nloc = mine > 0u ? mine : 1u; nx = cnt > 0u ? cnt : 1u; ord = below;
}
DI void xcd_barrier(const XcdBarrier& b) {
    asm volatile("s_waitcnt vmcnt(0)" ::: "memory");
    __syncthreads();
    if (threadIdx.x == 0) {
        unsigned* bar = b.bar;
        __builtin_amdgcn_s_waitcnt(0);
        unsigned nloc = b.st[0], nx = b.st[1];
        if (nloc == 0u) { unsigned ord; xcd_barrier_complete(bar, b.x, nloc, nx, ord); b.st[0] = nloc; b.st[1] = nx; b.st[2] = ord; }
        const unsigned old = xb_add(&bar[XB_XSUB(b.x)], 1u);
        const unsigned gen = old / nloc;
        if (old + 1u == (gen + 1u) * nloc) {
            __builtin_amdgcn_fence(__ATOMIC_RELEASE, "agent");
            asm volatile("s_waitcnt vmcnt(0)" ::: "memory");
            const unsigned og = xb_add(&bar[XB_TOP], 1u);
            const unsigned tg = og / nx;
            if (og + 1u == (tg + 1u) * nx) xb_add(&bar[XB_TOPGEN], 1u);
            else XB_SPIN(xb_ld(&bar[XB_TOPGEN]) == tg, bar);
            __builtin_amdgcn_fence(__ATOMIC_ACQUIRE, "agent");
            asm volatile("s_waitcnt vmcnt(0)" ::: "memory");
        } else {
            XB_SPIN(xb_ld(&bar[XB_TOPGEN]) == gen, bar);
            __builtin_amdgcn_fence(__ATOMIC_ACQUIRE, "agent");
            asm volatile("s_waitcnt vmcnt(0)" ::: "memory");
        }
    }
    __syncthreads();
}

struct Frame {
    LAS unsigned char* lds;
    int tid, lane, wave, vcu, G;
};
struct Args { const float* in[14]; float* out; unsigned char* ws; int ph_lo, ph_hi, li, pad; };

DI void p0_transpose_item(const float* W, int K, int N, bf16_t* WT, const float* sc_lo, const float* sc_hi, int split, LAS float* scr, int item, int lane) {
    const int nblk = N / 32, kb = item / nblk, nb = item % nblk, k0 = 64 * kb, n0 = 32 * nb;
#pragma unroll 16
    for (int i = 0; i < 32; ++i) { const int kk = 2 * i + (lane >> 5); const int k = k0 + kk;
        float s = 1.0f; if (sc_lo) s = (k < split) ? sc_lo[k] : sc_hi[k - split];
        scr[kk * 33 + (lane & 31)] = W[(size_t)k * N + n0 + (lane & 31)] * s; }
    asm volatile("s_waitcnt lgkmcnt(0)" ::: "memory");
    const int c = lane & 7;
#pragma unroll
    for (int j = 0; j < 4; ++j) { const int n = (lane >> 3) + 8 * j; const LAS float* s = scr + (8 * c) * 33 + n;
        u32x4 o; o.x = cvtpk(s[0 * 33], s[1 * 33]); o.y = cvtpk(s[2 * 33], s[3 * 33]); o.z = cvtpk(s[4 * 33], s[5 * 33]); o.w = cvtpk(s[6 * 33], s[7 * 33]);
        st16_wt(WT + (size_t)(n0 + n) * K + k0 + 8 * c, o); }
    asm volatile("s_waitcnt lgkmcnt(0)" ::: "memory");
}
DI void p0_cvt_item(const float* src, bf16_t* dst, size_t item, int lane) {
    const f32x4* s = (const f32x4*)(src + item * 512) + 2 * lane;
    const f32x4 a = s[0], b = s[1];
    u32x4 o; o.x = cvtpk(a[0], a[1]); o.y = cvtpk(a[2], a[3]); o.z = cvtpk(b[0], b[1]); o.w = cvtpk(b[2], b[3]);
    *((u32x4*)(dst + item * 512) + lane) = o;
}
DI void p0_cvt8_item(const float* src, unsigned char* dst, size_t item, int lane, float sc) {
    const f32x4* s = (const f32x4*)(src + item * 512) + 2 * lane;
    const f32x4 a = s[0] * sc, b = s[1] * sc;
    int w0 = 0, w1 = 0;
    w0 = __builtin_amdgcn_cvt_pk_fp8_f32(a[0], a[1], w0, false); w0 = __builtin_amdgcn_cvt_pk_fp8_f32(a[2], a[3], w0, true);
    w1 = __builtin_amdgcn_cvt_pk_fp8_f32(b[0], b[1], w1, false); w1 = __builtin_amdgcn_cvt_pk_fp8_f32(b[2], b[3], w1, true);
    u32x2 o; o.x = (unsigned)w0; o.y = (unsigned)w1;
    *((u32x2*)(dst + item * 512) + lane) = o;
}
template <int U> struct CvtRegs { f32x4 a[U][2]; };
template <int U> DI void cvt8_load(CvtRegs<U>& r, const float* src, size_t item0, int lane) {
#pragma unroll
    for (int u = 0; u < U; ++u) { const f32x4* s = (const f32x4*)(src + (item0 + u) * 512) + 2 * lane; r.a[u][0] = __builtin_nontemporal_load(s); r.a[u][1] = __builtin_nontemporal_load(s + 1); }
}
template <int U> DI void cvt8_store(const CvtRegs<U>& r, unsigned char* dst, size_t item0, int lane, float sc, const float* colg) {
#pragma unroll
    for (int u = 0; u < U; ++u) { const size_t it = item0 + u; const int e = (int)(it >> 1), hh = (int)(it & 1), col = 512 * hh + 8 * lane;
        f32x4 x = r.a[u][0] * sc, y = r.a[u][1] * sc;
        if (colg) { x = x * *(const f32x4*)(colg + col); y = y * *(const f32x4*)(colg + col + 4); }
        int w0 = 0, w1 = 0;
        w0 = __builtin_amdgcn_cvt_pk_fp8_f32(x[0], x[1], w0, false); w0 = __builtin_amdgcn_cvt_pk_fp8_f32(x[2], x[3], w0, true);
        w1 = __builtin_amdgcn_cvt_pk_fp8_f32(y[0], y[1], w1, false); w1 = __builtin_amdgcn_cvt_pk_fp8_f32(y[2], y[3], w1, true);
        u32x2 o; o.x = (unsigned)w0; o.y = (unsigned)w1;
        *(u32x2*)(dst + (size_t)(col >> 7) * ((size_t)NEXP * 128) + (size_t)e * 128 + (col & 127)) = o; }
}
template <int U> DI void p0_xn_rows(const float* x, const float* g, bf16_t* xn, float* rms0, int row0, int lane) {
    f32x4 v[U][4];
#pragma unroll
    for (int u = 0; u < U; ++u)
#pragma unroll
        for (int j = 0; j < 4; ++j) v[u][j] = __builtin_nontemporal_load((const f32x4*)(x + (size_t)(row0 + u) * DM) + lane + 64 * j);
    f32x4 gg[4];
#pragma unroll
    for (int j = 0; j < 4; ++j) gg[j] = *((const f32x4*)g + lane + 64 * j);
#pragma unroll
    for (int u = 0; u < U; ++u) { float s = 0.f;
#pragma unroll
        for (int j = 0; j < 4; ++j) s += (v[u][j][0] * v[u][j][0] + v[u][j][1] * v[u][j][1]) + (v[u][j][2] * v[u][j][2] + v[u][j][3] * v[u][j][3]);
        const float rstd = 1.0f / sqrtf(wave_sum(s) * (1.f / DM) + EPS);
        u32x2* o8 = (u32x2*)(xn + (size_t)(row0 + u) * DM) + lane;
#pragma unroll
        for (int j = 0; j < 4; ++j) { u32x2 w; w.x = cvtpk(v[u][j][0] * rstd, v[u][j][1] * rstd); w.y = cvtpk(v[u][j][2] * rstd, v[u][j][3] * rstd); st8_wt(o8 + 64 * j, w); }
        if (lane == 0) st4_wt(rms0 + row0 + u, __float_as_uint(1.0f / rstd)); }
}
DI void p0_xn_row(const float* xrow, const float* g, bf16_t* orow, int lane) {
    const f32x4* xr = (const f32x4*)xrow + lane; const f32x4* gr = (const f32x4*)g + lane;
    f32x4 v[4]; float s = 0.f;
#pragma unroll
    for (int j = 0; j < 4; ++j) { v[j] = xr[64 * j]; s += (v[j][0] * v[j][0] + v[j][1] * v[j][1]) + (v[j][2] * v[j][2] + v[j][3] * v[j][3]); }
    const float rstd = 1.0f / sqrtf(wave_sum(s) * (1.f / DM) + EPS);
    u32x2* o8 = (u32x2*)orow + lane;
#pragma unroll
    for (int j = 0; j < 4; ++j) { const f32x4 gg = gr[64 * j]; u32x2 w; w.x = cvtpk(v[j][0] * rstd * gg[0], v[j][1] * rstd * gg[1]); w.y = cvtpk(v[j][2] * rstd * gg[2], v[j][3] * rstd * gg[3]); o8[64 * j] = w; }
}

namespace att {
DI void conv_rows4(const bf16_t* proj, const float* cw, bf16_t* Y, int r0, int lane) {
    const int ch = 8 * lane; const bool head = (r0 & (SEQ - 1)) == 0;
    const bf16_t* pr = proj + (size_t)r0 * DPROJ + ch;
    u32x4 bg[4], cg[6], hc[6];
#pragma unroll
    for (int i = 0; i < 4; ++i) bg[i] = *(const u32x4*)(pr + (size_t)i * DPROJ);
#pragma unroll
    for (int q = 0; q < 6; ++q) { cg[q] = (u32x4){0u, 0u, 0u, 0u}; hc[q] = (u32x4){0u, 0u, 0u, 0u};
        if (q >= 2 || !head) { cg[q] = *(const u32x4*)(pr + ((ptrdiff_t)q - 2) * DPROJ + 512); hc[q] = *(const u32x4*)(pr + ((ptrdiff_t)q - 2) * DPROJ + 1024); } }
    f32x4 w[3][2];
#pragma unroll
    for (int k = 0; k < 3; ++k) { w[k][0] = *(const f32x4*)(cw + k * 512 + ch); w[k][1] = *(const f32x4*)(cw + k * 512 + ch + 4); }
    float u[6][8];
#pragma unroll
    for (int q = 0; q < 6; ++q)
#pragma unroll
        for (int j = 0; j < 4; ++j) { u[q][2 * j] = bflo(cg[q][j]) * bflo(hc[q][j]); u[q][2 * j + 1] = bfhi(cg[q][j]) * bfhi(hc[q][j]); }
#pragma unroll
    for (int i = 0; i < 4; ++i) {
        float acc[8]; float ss = 0.f;
#pragma unroll
        for (int e = 0; e < 8; ++e) { float a = 0.f;
#pragma unroll
            for (int k = 0; k < 3; ++k) a += w[k][e >> 2][e & 3] * u[i + k][e];
            const float b = (e & 1) ? bfhi(bg[i][e >> 1]) : bflo(bg[i][e >> 1]);
            acc[e] = a * b; ss += acc[e] * acc[e]; }
        const float rstd = 1.0f / sqrtf(wave_sum(ss) * (1.f / 512.f) + EPS);
        u32x4 o; o.x = cvtpk(acc[0] * rstd, acc[1] * rstd); o.y = cvtpk(acc[2] * rstd, acc[3] * rstd); o.z = cvtpk(acc[4] * rstd, acc[5] * rstd); o.w = cvtpk(acc[6] * rstd, acc[7] * rstd);
        st16_wt(Y + (size_t)(r0 + i) * DM + ch, o);
    }
}
DI void conv_rows8(const bf16_t* proj, const float* cw, bf16_t* Y, int r0, int lane_) {
    int lane; asm volatile("v_mbcnt_lo_u32_b32 %0, -1, 0\n\tv_mbcnt_hi_u32_b32 %0, -1, %0" : "=v"(lane)); (void)lane_;
    const int ch = 8 * lane; const bool head = (r0 & (SEQ - 1)) == 0;
    const bf16_t* pr = proj + (size_t)r0 * DPROJ + ch;
    u32x4 bg[8], cg[10], hc[10];
#pragma unroll
    for (int i = 0; i < 8; ++i) bg[i] = *(const u32x4*)(pr + (size_t)i * DPROJ);
#pragma unroll
    for (int q = 0; q < 10; ++q) { cg[q] = (u32x4){0u, 0u, 0u, 0u}; hc[q] = (u32x4){0u, 0u, 0u, 0u};
        if (q >= 2 || !head) { cg[q] = *(const u32x4*)(pr + ((ptrdiff_t)q - 2) * DPROJ + 512); hc[q] = *(const u32x4*)(pr + ((ptrdiff_t)q - 2) * DPROJ + 1024); } }
    f32x4 w[3][2];
#pragma unroll
    for (int k = 0; k < 3; ++k) { w[k][0] = *(const f32x4*)(cw + k * 512 + ch); w[k][1] = *(const f32x4*)(cw + k * 512 + ch + 4); }
#pragma unroll
    for (int i = 0; i < 8; ++i) {
        float acc[8]; float ss = 0.f;
#pragma unroll
        for (int e = 0; e < 8; ++e) { float a = 0.f;
#pragma unroll
            for (int k = 0; k < 3; ++k) { const unsigned cw_ = cg[i + k][e >> 1], hw_ = hc[i + k][e >> 1]; const float uu = (e & 1) ? bfhi(cw_) * bfhi(hw_) : bflo(cw_) * bflo(hw_); a += w[k][e >> 2][e & 3] * uu; }
            const float b = (e & 1) ? bfhi(bg[i][e >> 1]) : bflo(bg[i][e >> 1]);
            acc[e] = a * b; ss += acc[e] * acc[e]; }
        const float rstd = 1.0f / sqrtf(wave_sum(ss) * (1.f / 512.f) + EPS);
        u32x4 o; o.x = cvtpk(acc[0] * rstd, acc[1] * rstd); o.y = cvtpk(acc[2] * rstd, acc[3] * rstd); o.z = cvtpk(acc[4] * rstd, acc[5] * rstd); o.w = cvtpk(acc[6] * rstd, acc[7] * rstd);
        st16_wt(Y + (size_t)(r0 + i) * DM + ch, o);
        __builtin_amdgcn_sched_barrier(0);
    }
}
}

namespace att2 {
using bf16=__hip_bfloat16;
using bf16x8=__attribute__((ext_vector_type(8)))short;
using s16x4=__attribute__((ext_vector_type(4)))short;
using f32x16=__attribute__((ext_vector_type(16)))float;
using u32x4=__attribute__((ext_vector_type(4)))unsigned;
constexpr int BATCH=8,NHEAD=8,SEQ=2048,D=64,PQ=3072,PO=1024;
constexpr int NW=8,QBLK=32,QB=QBLK*NW,KVBLK=64,NQB=SEQ/QB;
__device__ __forceinline__ int crow(int r,int hi){return (r&3)+8*(r>>2)+4*hi;}
#define SBAR() __builtin_amdgcn_sched_barrier(0)
__device__ __forceinline__ void cmask(f32x16&p0,f32x16&p1,int jb,int qrel,int hi){
  const float NEG=-INFINITY; int kb=64*jb+4*hi;
  #pragma unroll
  for(int r=0;r<16;++r){int kv=kb+(r&3)+8*(r>>2); if(kv>qrel)p0[r]=NEG; if(kv+32>qrel)p1[r]=NEG;}
}

constexpr int NSLOT=3, SLOTB=8192;
constexpr int LDS_K=0, LDS_V=NSLOT*SLOTB, LDS_WS=2*NSLOT*SLOTB, LDS_OST=LDS_WS+NW*64*4, LDS_KM=LDS_OST+NW*4096, LDS_BYTES=LDS_KM+2048;
constexpr float C2=0.125f*1.4426950408889634f;
__device__ __forceinline__ void glds16(const void*gsrc,unsigned lds_dst){unsigned keep;
  asm volatile("s_mov_b32 %0, m0\n\ts_mov_b32 m0, %2\n\ts_nop 0\n\tglobal_load_lds_dwordx4 %1, off\n\ts_mov_b32 m0, %0":"=&s"(keep):"v"(gsrc),"s"(lds_dst):"memory");}
__device__ __forceinline__ float max3f(float a,float b,float c){float r;asm("v_max3_f32 %0, %1, %2, %3":"=v"(r):"v"(a),"v"(b),"v"(c));return r;}
__device__ __forceinline__ float max2f(float a,float b){float r;asm("v_max_f32_e32 %0, %1, %2":"=v"(r):"v"(a),"v"(b));return r;}
__device__ __forceinline__ float fadd_s(float a,float b){float r;asm("v_add_f32_e32 %0, %1, %2":"=v"(r):"v"(a),"v"(b));return r;}
__device__ __forceinline__ float fsub_s(float a,float b){float r;asm("v_sub_f32_e32 %0, %1, %2":"=v"(r):"v"(a),"v"(b));return r;}
typedef float f32x2_t __attribute__((ext_vector_type(2))); typedef __bf16 bf16x2_t __attribute__((ext_vector_type(2)));
__device__ __forceinline__ unsigned cvtpk_s(float lo,float hi){f32x2_t v={lo,hi};bf16x2_t b=__builtin_convertvector(v,bf16x2_t);return __builtin_bit_cast(unsigned,b);}
#define WAIT_BAR(N) asm volatile("s_waitcnt vmcnt(" #N ") lgkmcnt(0)\n\ts_barrier":::"memory")

__device__ __forceinline__ void qkt(f32x16&p0,f32x16&p1,const char*Kslot,const bf16x8*qr,const f32x16&negm,int r32,int hi){
  const char*kb=Kslot+hi*1024+r32*16;
  #pragma unroll
  for(int d0=0;d0<4;++d0){
    const bf16x8 b0=*reinterpret_cast<const bf16x8*>(kb+d0*2048);
    const bf16x8 b1=*reinterpret_cast<const bf16x8*>(kb+d0*2048+512);
    if(d0==0){p0=__builtin_amdgcn_mfma_f32_32x32x16_bf16(b0,qr[0],negm,0,0,0);p1=__builtin_amdgcn_mfma_f32_32x32x16_bf16(b1,qr[0],negm,0,0,0);}
    else{p0=__builtin_amdgcn_mfma_f32_32x32x16_bf16(b0,qr[d0],p0,0,0,0);p1=__builtin_amdgcn_mfma_f32_32x32x16_bf16(b1,qr[d0],p1,0,0,0);}}
}
typedef __attribute__((address_space(3))) const char* lds_cptr;
typedef short v4i16_t __attribute__((ext_vector_type(4)));
__device__ __forceinline__ void kload8(bf16x8*kf,lds_cptr kp){
  kf[0]=*(const __attribute__((address_space(3))) bf16x8*)(kp);      kf[1]=*(const __attribute__((address_space(3))) bf16x8*)(kp+512);
  kf[2]=*(const __attribute__((address_space(3))) bf16x8*)(kp+2048); kf[3]=*(const __attribute__((address_space(3))) bf16x8*)(kp+2560);
  kf[4]=*(const __attribute__((address_space(3))) bf16x8*)(kp+4096); kf[5]=*(const __attribute__((address_space(3))) bf16x8*)(kp+4608);
  kf[6]=*(const __attribute__((address_space(3))) bf16x8*)(kp+6144); kf[7]=*(const __attribute__((address_space(3))) bf16x8*)(kp+6656);
}
__device__ __forceinline__ void kload2(bf16x8*kf,lds_cptr kp,int j){ kf[2*j]=*(const __attribute__((address_space(3))) bf16x8*)(kp+j*2048); kf[2*j+1]=*(const __attribute__((address_space(3))) bf16x8*)(kp+j*2048+512); }
__device__ __forceinline__ s16x4 vtr(lds_cptr p){ return __builtin_bit_cast(s16x4,__builtin_amdgcn_ds_read_tr16_b64_v4i16((__attribute__((address_space(3))) v4i16_t*)p)); }
__device__ __forceinline__ float rowmax(const f32x16&p0,const f32x16&p1){
  float a=max3f(p0[0],p0[1],p1[0]),b=max3f(p0[2],p0[3],p1[1]);a=max3f(a,p1[2],p1[3]);
  #pragma unroll
  for(int r=4;r<16;r+=4){a=max3f(a,p0[r],p0[r+1]);b=max3f(b,p0[r+2],p0[r+3]);a=max3f(a,p1[r],p1[r+1]);b=max3f(b,p1[r+2],p1[r+3]);}
  const float m=max2f(a,b);
  auto rr=__builtin_amdgcn_permlane32_swap(__float_as_uint(m),__float_as_uint(m),false,false);
  return max2f(__uint_as_float(rr[0]),__uint_as_float(rr[1]));
}
__device__ __forceinline__ void pv(f32x16*o,int vb,bf16x8 pa0,bf16x8 pa1,bf16x8 pa2,bf16x8 pa3){
  #pragma unroll
  for(int d0=0;d0<2;++d0){s16x4 lo[4],hi[4];
    #pragma unroll
    for(int ks=0;ks<4;++ks){
      asm volatile("ds_read_b64_tr_b16 %0,%1 offset:%c2":"=&v"(lo[ks]):"v"(vb),"i"(d0*4096+ks*1024):"memory");
      asm volatile("ds_read_b64_tr_b16 %0,%1 offset:%c2":"=&v"(hi[ks]):"v"(vb),"i"(d0*4096+ks*1024+512):"memory");}
    asm volatile("s_waitcnt lgkmcnt(0)":::"memory");SBAR();
    #define PK(k) (bf16x8){lo[k][0],lo[k][1],lo[k][2],lo[k][3],hi[k][0],hi[k][1],hi[k][2],hi[k][3]}
    o[d0]=__builtin_amdgcn_mfma_f32_32x32x16_bf16(pa0,PK(0),o[d0],0,0,0);
    o[d0]=__builtin_amdgcn_mfma_f32_32x32x16_bf16(pa1,PK(1),o[d0],0,0,0);
    o[d0]=__builtin_amdgcn_mfma_f32_32x32x16_bf16(pa2,PK(2),o[d0],0,0,0);
    o[d0]=__builtin_amdgcn_mfma_f32_32x32x16_bf16(pa3,PK(3),o[d0],0,0,0);
    #undef PK
  }
}

#ifndef ATTN_STORE16
#define ATTN_STORE16(p,v) st16_wt((void*)(p),(v))
#endif
template<int THRL> __device__ __forceinline__ void attn_unit(int b,int h,int qb,const bf16*Q,const bf16*__restrict__ K,const bf16*__restrict__ V,bf16*O,const float*ksum,float*ssqa,char*shm){
  int lane; asm volatile("v_mbcnt_lo_u32_b32 %0, -1, 0\n\tv_mbcnt_hi_u32_b32 %0, -1, %0":"=v"(lane));     const int tid=threadIdx.x,r32=lane&31,hi=lane>>5; const int wid=__builtin_amdgcn_readfirstlane(tid>>6);
  const long rowbase=(long)b*SEQ; const int q0=qb*QB;
  const bf16*Qw=Q+(rowbase+q0+wid*QBLK)*PQ+h*D;
  const bf16*Kh=K+rowbase*PQ+h*D,*Vh=V+rowbase*PQ+h*D;
  const unsigned lds0=(unsigned)(uintptr_t)shm;
  float*wsf=(float*)(shm+LDS_WS)+wid*64;
  const bf16*ksrc=Kh+(long)lane*PQ+wid*8;
  const bf16*vsrc=Vh+(long)(16*(wid&3)+(lane>>2))*PQ+(wid>>2)*32+(lane&3)*8;
  const unsigned kdst=lds0+LDS_K+wid*1024, vdst=lds0+LDS_V+wid*1024;
  #define DMA_K(t,slot) glds16(ksrc+(long)(t)*KVBLK*PQ,(unsigned)__builtin_amdgcn_readfirstlane(kdst+(slot)))
  #define DMA_V(t,slot) glds16(vsrc+(long)(t)*KVBLK*PQ,(unsigned)__builtin_amdgcn_readfirstlane(vdst+(slot)))
  const int vb0=(int)(lds0+LDS_V)+((lane>>4)&1)*32+(lane&3)*8+(4*hi+((lane&15)>>2))*64;
  const char*Kbase=shm+LDS_K; bf16x8 kf[8];
  const lds_cptr shm3=(lds_cptr)shm; const lds_cptr kp0=shm3+LDS_K+hi*1024+r32*16; const lds_cptr vp0=shm3+LDS_V+((lane>>4)&1)*32+(lane&3)*8+(4*hi+((lane&15)>>2))*64;
  const int NT=(q0+QB)/KVBLK;
  DMA_K(0,0);DMA_V(0,0);DMA_K(1,SLOTB);
  bf16x8 qr[4];
  #pragma unroll
  for(int d0=0;d0<4;++d0)qr[d0]=*reinterpret_cast<const bf16x8*>(&Qw[(long)r32*PQ+d0*16+hi*8]);
  unsigned selmask=(1u<<qb)-1u;
  { __attribute__((address_space(3))) float*km=(__attribute__((address_space(3))) float*)(shm+LDS_KM);
    if(tid<64*qb)km[tid]=ksum[(long)(b*8+(tid>>6))*512+h*64+(tid&63)];
    __syncthreads();
    if(qb>3){ float gt[7];
      #pragma unroll
      for(int n=0;n<7;++n){ float a=-3.0e38f;
        if(n<qb){ a=0.f;
          #pragma unroll
          for(int s=0;s<4;++s)
            #pragma unroll
            for(int j=0;j<8;++j)a+=__uint_as_float(((unsigned)(unsigned short)qr[s][j])<<16)*km[n*64+16*s+8*hi+j];
          a+=__shfl_xor(a,32); }
        gt[n]=a; }
      selmask=0u;
      #pragma unroll
      for(int n=0;n<7;++n){ int cnt=0;
        #pragma unroll
        for(int m2=0;m2<7;++m2)if(m2!=n)cnt+=(gt[m2]>gt[n]||(gt[m2]==gt[n]&&m2<n))?1:0;
        if(cnt<3&&n<qb)selmask|=1u<<n; } }
    __syncthreads(); }
  #define MMASK(P0,P1,t) do{ const int blk_=(t)>>2; if(blk_<qb&&!((selmask>>blk_)&1u)){ _Pragma("unroll") for(int r=0;r<16;++r){P0[r]=-1.0e30f;P1[r]=-1.0e30f;} } }while(0)
  float mhat=0.f,l_reg=0.f;f32x16 o[2];o[0]=f32x16{};o[1]=f32x16{};const f32x16 negm=f32x16{};
  const int qrel=wid*QBLK+r32;
  #define CMASK(P0,P1,t) do{int jb_=(t)-(NT-4); if(jb_>=0)cmask(P0,P1,jb_,qrel,hi);}while(0)
  bool resc=false;
  #define START(P0,P1) do{ const float rm=max2f(rowmax(P0,P1),-1000.0f); resc=false; \
    { const float dl=rm; mhat=fadd_s(mhat,dl); \
      _Pragma("unroll") for(int r=0;r<16;++r){P0[r]=fsub_s(P0[r],dl);P1[r]=fsub_s(P1[r],dl);} \
      } \
    _Pragma("unroll") for(int r=0;r<16;++r)P0[r]=__builtin_amdgcn_exp2f(P0[r]); }while(0)
  #define RESC() do{ if(resc){ asm volatile("s_waitcnt lgkmcnt(0)":::"memory"); \
      _Pragma("unroll") for(int d_=0;d_<2;++d_) _Pragma("unroll") for(int r=0;r<16;++r)o[d_][r]*=wsf[crow(r,hi)]; } }while(0)
  f32x16 pA0,pA1,pB0,pB1;
  int sl_prev=0,sl_cur=0,sl_next=SLOTB;
  #define ROT() do{sl_prev=sl_cur;sl_cur=sl_next;sl_next=(sl_next==(NSLOT-1)*SLOTB)?0:sl_next+SLOTB;}while(0)
  DMA_K(2,2*SLOTB);
  WAIT_BAR(3);
  qkt(pA0,pA1,Kbase,qr,negm,r32,hi);asm volatile("s_nop 15\n\ts_nop 7":"+v"(pA0),"+v"(pA1));CMASK(pA0,pA1,0);MMASK(pA0,pA1,0);
  START(pA0,pA1);
  _Pragma("unroll") for(int r=0;r<16;++r)pA1[r]=__builtin_amdgcn_exp2f(pA1[r]);
  WAIT_BAR(0);
  DMA_K(3,0);DMA_V(1,SLOTB);
  ROT();
  kload8(kf,kp0+sl_cur);
  WAIT_BAR(2);
  s16x4 vlo[8],vhi[8]; u32x4 pw0,pw1,pw2,pw3;
  #define PKW(P,B) cvtpk_s(P[B],P[B+1])
  #define PAF(k) __builtin_bit_cast(bf16x8,pw##k)
  #define VFR(i) (bf16x8){vlo[i][0],vlo[i][1],vlo[i][2],vlo[i][3],vhi[i][0],vhi[i][1],vhi[i][2],vhi[i][3]}
  #define PIN(x) asm volatile("":"+v"(x))
  #define MX3(a,b,c) __builtin_fmaxf(__builtin_fmaxf((a),(b)),(c))
  #define GAPA(MF,A0,A1,A2,A3,W0,W1,PW) do{ MF; sacc+=A0; sacc+=A1; sacc+=A2; sacc+=A3; PIN(sacc); W0; W1; PIN(PW); SBAR(); }while(0)
  #define EX(v) __builtin_amdgcn_exp2f(v)
  #define GAPB(MF,X,B) do{ MF; X[B]=EX(X[B]); X[B+1]=EX(X[B+1]); X[B+2]=EX(X[B+2]); X[B+3]=EX(X[B+3]); PIN(X); SBAR(); }while(0)
  #define VRD(i) do{ vlo[i]=vtr(vp_+(((i)>>2)*4096+((i)&3)*1024)); vhi[i]=vtr(vp_+(((i)>>2)*4096+((i)&3)*1024+512)); }while(0)
  #define KRD(G,j) do{ if(G){ kload2(kf,kp0+sl_next,j); SBAR(); } }while(0)
  #define STEP(C0,C1,P0,P1,t,GK,GV,GL) do{ SBAR(); \
    const lds_cptr vp_=vp0+sl_prev; \
    VRD(0); SBAR(); float sacc=(P0[0]+P0[1]); \
    GAPA(C0=__builtin_amdgcn_mfma_f32_32x32x16_bf16(kf[0],qr[0],negm,0,0,0), P0[2],P0[3],P0[4],P0[5],     pw0[0]=PKW(P0,0), pw0[1]=PKW(P0,2), pw0); \
    VRD(4); SBAR(); GAPA(C1=__builtin_amdgcn_mfma_f32_32x32x16_bf16(kf[1],qr[0],negm,0,0,0), P0[6],P0[7],P0[8],P0[9],     pw0[2]=PKW(P0,4), pw0[3]=PKW(P0,6), pw0); \
    VRD(1); SBAR(); GAPA(C0=__builtin_amdgcn_mfma_f32_32x32x16_bf16(kf[2],qr[1],C0,0,0,0),   P0[10],P0[11],P0[12],P0[13], pw1[0]=PKW(P0,8), pw1[1]=PKW(P0,10), pw1); \
    VRD(5); SBAR(); GAPA(C1=__builtin_amdgcn_mfma_f32_32x32x16_bf16(kf[3],qr[1],C1,0,0,0),   P0[14],P0[15],P1[0],P1[1],   pw1[2]=PKW(P0,12),pw1[3]=PKW(P0,14), pw1); \
    VRD(2); SBAR(); GAPA(C0=__builtin_amdgcn_mfma_f32_32x32x16_bf16(kf[4],qr[2],C0,0,0,0),   P1[2],P1[3],P1[4],P1[5],     pw2[0]=PKW(P1,0), pw2[1]=PKW(P1,2), pw2); \
    VRD(6); SBAR(); GAPA(C1=__builtin_amdgcn_mfma_f32_32x32x16_bf16(kf[5],qr[2],C1,0,0,0),   P1[6],P1[7],P1[8],P1[9],     pw2[2]=PKW(P1,4), pw2[3]=PKW(P1,6), pw2); \
    VRD(3); SBAR(); GAPA(C0=__builtin_amdgcn_mfma_f32_32x32x16_bf16(kf[6],qr[3],C0,0,0,0),   P1[10],P1[11],P1[12],P1[13], pw3[0]=PKW(P1,8), pw3[1]=PKW(P1,10), pw3); \
    VRD(7); SBAR(); GAPA(C1=__builtin_amdgcn_mfma_f32_32x32x16_bf16(kf[7],qr[3],C1,0,0,0),   P1[14],P1[15],0.f,0.f,       pw3[2]=PKW(P1,12),pw3[3]=PKW(P1,14), pw3); \
    l_reg+=sacc; \
    if(GK){DMA_K((t)+3,sl_cur);} if(GV){DMA_V((t)+1,sl_next);} \
    { const int blk_=(t)>>2; const float ms_=(blk_<qb&&!((selmask>>blk_)&1u))?1.0e30f:mhat;     \
      _Pragma("unroll") for(int r=0;r<16;++r){C0[r]-=ms_;C1[r]-=ms_;} } \
    CMASK(C0,C1,t); \
    { float a=MX3(C0[0],C0[1],C1[0]),b=MX3(C0[2],C0[3],C1[1]); a=MX3(a,C1[2],C1[3]); \
      _Pragma("unroll") for(int r=4;r<16;r+=4){a=MX3(a,C0[r],C0[r+1]);b=MX3(b,C0[r+2],C0[r+3]);a=MX3(a,C1[r],C1[r+1]);b=MX3(b,C1[r+2],C1[r+3]);} \
      float rm=__builtin_fmaxf(a,b); { auto rr=__builtin_amdgcn_permlane32_swap(__float_as_uint(rm),__float_as_uint(rm),false,false); rm=__builtin_fmaxf(__uint_as_float(rr[0]),__uint_as_float(rr[1])); } \
      resc=false; \
      if(__builtin_expect(__any(rm>(float)THRL),0)){ const float dl=__builtin_fmaxf(rm,0.f); mhat+=dl; \
        _Pragma("unroll") for(int r=0;r<16;++r){C0[r]-=dl;C1[r]-=dl;} \
        \
        const float f=__builtin_amdgcn_exp2f(-dl); l_reg*=f; if(hi==0)wsf[r32]=f; resc=true; } } \
    SBAR(); \
    GAPB(o[0]=__builtin_amdgcn_mfma_f32_32x32x16_bf16(PAF(0),VFR(0),o[0],0,0,0), C0,0); \
    GAPB(o[1]=__builtin_amdgcn_mfma_f32_32x32x16_bf16(PAF(0),VFR(4),o[1],0,0,0), C0,4); \
    KRD(GL,0); GAPB(o[0]=__builtin_amdgcn_mfma_f32_32x32x16_bf16(PAF(1),VFR(1),o[0],0,0,0), C0,8); \
    KRD(GL,1); GAPB(o[1]=__builtin_amdgcn_mfma_f32_32x32x16_bf16(PAF(1),VFR(5),o[1],0,0,0), C0,12); \
    KRD(GL,2); GAPB(o[0]=__builtin_amdgcn_mfma_f32_32x32x16_bf16(PAF(2),VFR(2),o[0],0,0,0), C1,0); \
    KRD(GL,3); GAPB(o[1]=__builtin_amdgcn_mfma_f32_32x32x16_bf16(PAF(2),VFR(6),o[1],0,0,0), C1,4); \
    GAPB(o[0]=__builtin_amdgcn_mfma_f32_32x32x16_bf16(PAF(3),VFR(3),o[0],0,0,0), C1,8); \
    GAPB(o[1]=__builtin_amdgcn_mfma_f32_32x32x16_bf16(PAF(3),VFR(7),o[1],0,0,0), C1,12); \
    }while(0)
  int t=1;
  #undef CMASK
  #define CMASK(P0,P1,t) do{}while(0)
  for(;t+5<NT;t+=2){
    STEP(pB0,pB1,pA0,pA1,t,true,true,true);     WAIT_BAR(2); RESC(); ROT();
    STEP(pA0,pA1,pB0,pB1,t+1,true,true,true);   WAIT_BAR(2); RESC(); ROT();
  }
  #undef CMASK
  #define CMASK(P0,P1,t) do{int jb_=(t)-(NT-4); if(jb_>=0)cmask(P0,P1,jb_,qrel,hi);}while(0)
  #define ENDW(tt) do{ if((tt)+3<NT){WAIT_BAR(2);} else if((tt)+2<NT){WAIT_BAR(1);} else {WAIT_BAR(0);} }while(0)
  for(;t+1<NT;t+=2){
    STEP(pB0,pB1,pA0,pA1,t,(t+3<NT),(t+1<NT),(t+1<NT));       ENDW(t);   RESC(); ROT();
    STEP(pA0,pA1,pB0,pB1,t+1,(t+4<NT),(t+2<NT),(t+2<NT));     ENDW(t+1); RESC(); ROT();
  }
  STEP(pB0,pB1,pA0,pA1,NT-1,false,false,false); RESC();
  { float sacc=pB0[0]+pB0[1]; _Pragma("unroll") for(int r=2;r<16;++r)sacc+=pB0[r]; _Pragma("unroll") for(int r=0;r<16;++r)sacc+=pB1[r]; l_reg+=sacc;
    pw0=(u32x4){PKW(pB0,0),PKW(pB0,2),PKW(pB0,4),PKW(pB0,6)};pw1=(u32x4){PKW(pB0,8),PKW(pB0,10),PKW(pB0,12),PKW(pB0,14)};pw2=(u32x4){PKW(pB1,0),PKW(pB1,2),PKW(pB1,4),PKW(pB1,6)};pw3=(u32x4){PKW(pB1,8),PKW(pB1,10),PKW(pB1,12),PKW(pB1,14)};
    SBAR(); pv(o,vb0+sl_cur,PAF(0),PAF(1),PAF(2),PAF(3)); }
  #undef PKW
  #undef PAF
  #undef VFR
  #undef PIN
  #undef MX3
  #undef GAPA
  #undef GAPB
  #undef EX
  #undef VRD
  #undef KRD
  #undef STEP
  #undef ENDW
  {auto rr=__builtin_amdgcn_permlane32_swap(__float_as_uint(l_reg),__float_as_uint(l_reg),false,false);l_reg=__uint_as_float(rr[0])+__uint_as_float(rr[1]);}
  if(hi==0)wsf[32+r32]=l_reg;asm volatile("s_waitcnt lgkmcnt(0)":::"memory");
  float rli[16];
  #pragma unroll
  for(int r=0;r<16;++r)rli[r]=__builtin_amdgcn_rcpf(wsf[32+crow(r,hi)]);
  bf16*Ow=O+(rowbase+q0+wid*QBLK)*PO+h*D;
  { bf16*stg=(bf16*)(shm+LDS_OST)+wid*2048;
    #pragma unroll
    for(int r=0;r<16;++r){const int orow=crow(r,hi);
      #pragma unroll
      for(int d0=0;d0<2;++d0)stg[orow*64+d0*32+r32]=__float2bfloat16(o[d0][r]*rli[r]);}
    asm volatile("s_waitcnt lgkmcnt(0)":::"memory");
    int l2; asm volatile("v_mbcnt_lo_u32_b32 %0, -1, 0\n\tv_mbcnt_hi_u32_b32 %0, -1, %0":"=v"(l2));
    #pragma unroll
    for(int i=0;i<4;++i){const int row=i*8+(l2>>3),ch=l2&7; const u32x4 v=*(const u32x4*)(stg+row*64+ch*8); ATTN_STORE16(Ow+(long)row*PO+ch*8,v);
      float ss=0.f;
      #pragma unroll
      for(int j=0;j<4;++j){const float a=__uint_as_float(v[j]<<16),c=__uint_as_float(v[j]&0xffff0000u);ss+=a*a+c*c;}
      ss+=__shfl_xor(ss,1);ss+=__shfl_xor(ss,2);ss+=__shfl_xor(ss,4);
      if(ch==0)ssqa[(rowbase+q0+wid*QBLK+row)*8+h]=ss;} }
  asm volatile("s_waitcnt lgkmcnt(0)\n\ts_barrier":::"memory");
  #undef DMA_K
  #undef DMA_V
  #undef MMASK
  #undef CMASK
  #undef START
  #undef RESC
  #undef ROT
}
constexpr int ATTN_LDS_BYTES=LDS_BYTES;
#undef SBAR
#undef WAIT_BAR
}


namespace p5 {
constexpr int KLD = 136, SLD = 264;
constexpr int OFF_KL = 0, OFF_S = 2 * 128 * KLD * 2, OFF_REC = OFF_S + 64 * SLD * 4, LDS_NEED = OFF_REC + 64 * 2 * 16 * 4;
static_assert(LDS_NEED <= SCR_BYTES && OFF_S % 16 == 0, "P5 LDS map");

DI unsigned mkkey(float s, unsigned low, unsigned lowmask) { unsigned u = __float_as_uint(s); u ^= (unsigned)((int)u >> 31) | 0x80000000u; return (u & ~lowmask) | low; }
DI float keyval(unsigned key, unsigned lowmask) { unsigned u = (key & ~lowmask) | ((lowmask + 1u) >> 1); return (u & 0x80000000u) ? __uint_as_float(u & 0x7fffffffu) : __uint_as_float(~u); }
DI unsigned umax(unsigned a, unsigned b) { return a > b ? a : b; }
DI unsigned umin(unsigned a, unsigned b) { return a < b ? a : b; }
template <int N> DI void sort_desc(unsigned (&a)[N]) {
#pragma unroll
    for (int k = 2; k <= N; k <<= 1)
#pragma unroll
        for (int j = k >> 1; j > 0; j >>= 1)
#pragma unroll
            for (int i = 0; i < N; ++i) { const int l = i ^ j; if (l > i) { const unsigned x = a[i], y = a[l], mx = umax(x, y), mn = umin(x, y); const bool desc = ((i & k) == 0); a[i] = desc ? mx : mn; a[l] = desc ? mn : mx; } }
}
template <int N> DI void merge_desc(unsigned (&a)[N]) {
#pragma unroll
    for (int j = N >> 1; j > 0; j >>= 1)
#pragma unroll
        for (int i = 0; i < N; ++i) { const int l = i ^ j; if (l > i) { const unsigned x = a[i], y = a[l]; a[i] = umax(x, y); a[l] = umin(x, y); } }
}
template <int XR> DI unsigned dppx(unsigned v) { return (unsigned)__builtin_amdgcn_update_dpp(0, (int)v, XR == 1 ? 0xB1 : XR == 2 ? 0x4E : 0x141, 0xF, 0xF, false); }
template <int XR> DI void xmerge16(unsigned (&a)[16]) {
    unsigned p[16];
#pragma unroll
    for (int i = 0; i < 16; ++i) p[i] = dppx<XR>(a[i]);
#pragma unroll
    for (int i = 0; i < 16; ++i) a[i] = umax(a[i], p[15 - i]);
    merge_desc<16>(a);
}

constexpr int SLD2 = 260;
constexpr int OFF_S2 = 0, OFF_REC2 = 128 * SLD2 * 4, LDS_NEED2 = OFF_REC2 + 128 * 2 * 16 * 4;
static_assert(LDS_NEED2 <= SCR_BYTES && OFF_REC2 % 16 == 0, "P5 LDS map (128-row chunks)");
DI int spos(int c) { return (c >> 7) * 130 + ((c >> 6) & 1) * 65 + (c & 63); }
struct KeyFrags { bf16x8 b[4][2]; };
DI void load_keys(KeyFrags& kf, const bf16_t* K1b, const bf16_t* K2b, int h, int lane, int w) {
    const bf16_t* base = ((w >> 2) ? K2b : K1b) + (size_t)(h * 128 + 32 * (w & 3) + (lane & 15)) * 128 + 8 * (lane >> 4);
#pragma unroll
    for (int ks = 0; ks < 4; ++ks)
#pragma unroll
        for (int nt = 0; nt < 2; ++nt) kf.b[ks][nt] = *(const bf16x8*)(base + (size_t)(16 * nt) * 128 + 32 * ks);
}
DI void top16(unsigned (&a)[16], const unsigned (&b)[16]) {
#pragma unroll
    for (int i = 0; i < 16; ++i) a[i] = umax(a[i], b[15 - i]);
    merge_desc<16>(a);
}
#define P5_LBAR() do { asm volatile("s_waitcnt lgkmcnt(0)" ::: "memory"); __builtin_amdgcn_s_barrier(); asm volatile("" ::: "memory"); } while (0)
DI void chunk128(const Frame& F, int r0, int h, const bf16_t* qry, const float* ssqx, int* eidt, float* gate, const KeyFrags& kf, const float* csrc, unsigned char* cdst, size_t citem0, float csc, const float* ccolg) {
    int tid; asm volatile("v_mov_b32 %0, %1" : "=v"(tid) : "v"(F.tid));
    const int lane = F.lane, w = F.wave;
    LAS float* S = (LAS float*)(F.lds + OFF_S2); LAS unsigned* REC = (LAS unsigned*)(F.lds + OFF_REC2);
    {
        const int half = w >> 2, n0 = 32 * (w & 3), fr = lane & 15, fq = lane >> 4;
#pragma unroll
        for (int mh = 0; mh < 2; ++mh) {
            f32x4 acc[4][2];
#pragma unroll
            for (int m = 0; m < 4; ++m) { acc[m][0] = (f32x4){0.f, 0.f, 0.f, 0.f}; acc[m][1] = (f32x4){0.f, 0.f, 0.f, 0.f}; }
            const bf16_t* qp = qry + (size_t)(r0 + 64 * mh + fr) * 2048 + h * 256 + half * 128 + 8 * fq;
#pragma unroll
            for (int ks = 0; ks < 4; ++ks)
#pragma unroll
                for (int m = 0; m < 4; ++m) { const bf16x8 a = *(const bf16x8*)(qp + (size_t)(16 * m) * 2048 + 32 * ks);
#pragma unroll
                    for (int nt = 0; nt < 2; ++nt) acc[m][nt] = __builtin_amdgcn_mfma_f32_16x16x32_bf16(a, kf.b[ks][nt], acc[m][nt], 0, 0, 0); }
#pragma unroll
            for (int m = 0; m < 4; ++m)
#pragma unroll
                for (int nt = 0; nt < 2; ++nt) { const int pos = spos(half * 128 + n0 + 16 * nt + fr);
#pragma unroll
                    for (int r = 0; r < 4; ++r) S[(64 * mh + 16 * m + 4 * fq + r) * SLD2 + pos] = acc[m][nt][r]; }
        }
    }
    P5_LBAR();
    CvtRegs<4> cvr; cvt8_load<4>(cvr, csrc, citem0, lane);
    const int row = tid >> 2, half = (tid >> 1) & 1, q2 = tid & 1, j4 = tid & 3;
    f32x4 sq0, sq1, sq2, sq3; { const f32x4* sp = (const f32x4*)(ssqx + (size_t)(r0 + row) * 16); sq0 = sp[0]; sq1 = sp[1]; sq2 = sp[2]; sq3 = sp[3]; }
    unsigned a[16];
    {
        unsigned b[16], c[16], d[16];
        const LAS float* sp = S + row * SLD2 + half * 130 + q2 * 65;
#pragma unroll
        for (int i = 0; i < 16; ++i) { a[i] = mkkey(sp[i], 127u - (unsigned)(64 * q2 + i), 127u); b[i] = mkkey(sp[16 + i], 127u - (unsigned)(64 * q2 + 16 + i), 127u);
            c[i] = mkkey(sp[32 + i], 127u - (unsigned)(64 * q2 + 32 + i), 127u); d[i] = mkkey(sp[48 + i], 127u - (unsigned)(64 * q2 + 48 + i), 127u); }
        sort_desc<16>(a); sort_desc<16>(b); top16(a, b);
        sort_desc<16>(c); sort_desc<16>(d); top16(c, d);
        top16(a, c);
    }
    xmerge16<1>(a);
    if (q2 == 0) {
#pragma unroll
        for (int i = 0; i < 16; ++i) REC[(row * 2 + half) * 16 + i] = a[i];
    }
    cvt8_store<4>(cvr, cdst, citem0, lane, csc, ccolg);
    cvt8_load<4>(cvr, csrc, citem0 + 4, lane);
    asm volatile("s_waitcnt lgkmcnt(0)" ::: "memory");
    unsigned t16[16];
#pragma unroll
    for (int e = 0; e < 16; ++e) {
        const int c = 16 * j4 + e; int ci = 0, st = 0;
        if (c >= 16) { ci = 1; st = 16; } if (c >= 24) { ci = 2; st = 24; } if (c >= 29) { ci = 3; st = 29; } if (c >= 33) { ci = 4; st = 33; }
        if (c >= 36) { ci = 5; st = 36; } if (c >= 38) { ci = 6; st = 38; } if (c >= 40) { ci = 7; st = 40; } if (c >= 42) { ci = 8 + (c - 42); st = c; }
        const int cj = c - st;
        unsigned key = 0u;
        if (c < 50) { const float v = keyval(REC[(row * 2) * 16 + ci], 127u) + keyval(REC[(row * 2 + 1) * 16 + cj], 127u); key = mkkey(v, (unsigned)((ci << 4) | cj), 255u); }
        t16[e] = key;
    }
    sort_desc<16>(t16);
    xmerge16<1>(t16); xmerge16<2>(t16);
    unsigned kk[4];
#pragma unroll
    for (int e = 0; e < 4; ++e) kk[e] = (j4 == 0) ? t16[e] : (j4 == 1) ? t16[4 + e] : (j4 == 2) ? t16[8 + e] : t16[12 + e];
    const float ssq = ((sq0[0] + sq0[1]) + (sq0[2] + sq0[3])) + ((sq1[0] + sq1[1]) + (sq1[2] + sq1[3])) + ((sq2[0] + sq2[1]) + (sq2[2] + sq2[3])) + ((sq3[0] + sq3[1]) + (sq3[2] + sq3[3]));
    const float rstd = 1.0f / sqrtf(ssq * (1.f / DM) + EPS);
    const float vmax = keyval(t16[0], 255u);
    float ev[4]; float es = 0.f;
#pragma unroll
    for (int e = 0; e < 4; ++e) { ev[e] = __expf(rstd * (keyval(kk[e], 255u) - vmax)); es += ev[e]; }
    es += __uint_as_float(dppx<1>(__float_as_uint(es))); es += __uint_as_float(dppx<2>(__float_as_uint(es)));
    const float inv = 1.0f / es;
    int* et = eidt + (size_t)(r0 + row) * 128 + (4 * (j4 & 1)) * 16 + 2 * h + (j4 >> 1);
#pragma unroll
    for (int e = 0; e < 4; ++e) { const unsigned cd = kk[e] & 255u;
        et[16 * e] = (int)(127u - (REC[(row * 2) * 16 + (cd >> 4)] & 127u)) * 128 + (int)(127u - (REC[(row * 2 + 1) * 16 + (cd & 15u)] & 127u)); }
    *(f32x4*)(gate + (size_t)(r0 + row) * 128 + h * 16 + 4 * j4) = (f32x4){ev[0] * inv, ev[1] * inv, ev[2] * inv, ev[3] * inv};
    cvt8_store<4>(cvr, cdst, citem0 + 4, lane, csc, ccolg);
    P5_LBAR();
}
}

namespace p5w {
using p5::mkkey; using p5::keyval; using p5::umax; using p5::umin; using p5::sort_desc; using p5::merge_desc; using p5::top16;
constexpr int KPITCH = 272, KHALF = 128 * KPITCH, OFF_REC = 2 * KHALF, REC_WAVE = 32 * 33 * 4;
static_assert(OFF_REC + NWAVES * REC_WAVE <= SCR_BYTES && KHALF % 16 == 0, "P5 (wave-owned rows) LDS map");
DI void keys_to_lds(LAS unsigned char* lds, const bf16_t* K1b, const bf16_t* K2b, int h, int tid_) {
    int tid; asm volatile("v_mov_b32 %0, %1" : "=v"(tid) : "v"(tid_));
    u32x4 v[8];
#pragma unroll
    for (int i = 0; i < 8; ++i) { const int id = tid + 512 * (i & 3); const int row = id >> 4, c = id & 15;
        v[i] = *(const u32x4*)(((i >> 2) ? K2b : K1b) + (size_t)(h * 128 + row) * 128 + 8 * c); }
#pragma unroll
    for (int i = 0; i < 8; ++i) { const int id = tid + 512 * (i & 3); const int row = id >> 4, c = id & 15;
        *(LAS u32x4*)(lds + (i >> 2) * KHALF + row * KPITCH + 16 * c) = v[i]; }
}
DI void sort16_desc(unsigned (&a)[16]) {
#define P5W_CE(i, j) do { const unsigned x_ = a[i], y_ = a[j]; a[i] = umax(x_, y_); a[j] = umin(x_, y_); } while (0)
    P5W_CE(0, 13); P5W_CE(1, 12); P5W_CE(2, 15); P5W_CE(3, 14); P5W_CE(4, 8); P5W_CE(5, 6); P5W_CE(7, 11); P5W_CE(9, 10);
    P5W_CE(0, 5); P5W_CE(1, 7); P5W_CE(2, 9); P5W_CE(3, 4); P5W_CE(6, 13); P5W_CE(8, 14); P5W_CE(10, 15); P5W_CE(11, 12);
    P5W_CE(0, 1); P5W_CE(2, 3); P5W_CE(4, 5); P5W_CE(6, 8); P5W_CE(7, 9); P5W_CE(10, 11); P5W_CE(12, 13); P5W_CE(14, 15);
    P5W_CE(0, 2); P5W_CE(1, 3); P5W_CE(4, 10); P5W_CE(5, 11); P5W_CE(6, 7); P5W_CE(8, 9); P5W_CE(12, 14); P5W_CE(13, 15);
    P5W_CE(1, 2); P5W_CE(3, 12); P5W_CE(4, 6); P5W_CE(5, 7); P5W_CE(8, 10); P5W_CE(9, 11); P5W_CE(13, 14);
    P5W_CE(1, 4); P5W_CE(2, 6); P5W_CE(5, 8); P5W_CE(7, 10); P5W_CE(9, 13); P5W_CE(11, 14);
    P5W_CE(2, 4); P5W_CE(3, 6); P5W_CE(9, 12); P5W_CE(11, 13);
    P5W_CE(3, 5); P5W_CE(6, 8); P5W_CE(7, 9); P5W_CE(10, 12);
    P5W_CE(3, 4); P5W_CE(5, 6); P5W_CE(7, 8); P5W_CE(9, 10); P5W_CE(11, 12);
    P5W_CE(6, 7); P5W_CE(8, 9);
#undef P5W_CE
}
DI void sort10_desc(unsigned (&a)[16]) {
#define P5W_CE(i, j) do { const unsigned x_ = a[i], y_ = a[j]; a[i] = umax(x_, y_); a[j] = umin(x_, y_); } while (0)
    P5W_CE(0, 8); P5W_CE(1, 9); P5W_CE(2, 7); P5W_CE(3, 5); P5W_CE(4, 6);
    P5W_CE(0, 2); P5W_CE(1, 4); P5W_CE(5, 8); P5W_CE(7, 9);
    P5W_CE(0, 3); P5W_CE(2, 4); P5W_CE(5, 7); P5W_CE(6, 9);
    P5W_CE(0, 1); P5W_CE(3, 6); P5W_CE(8, 9);
    P5W_CE(1, 5); P5W_CE(2, 3); P5W_CE(4, 8); P5W_CE(6, 7);
    P5W_CE(1, 2); P5W_CE(3, 5); P5W_CE(4, 6); P5W_CE(7, 8);
    P5W_CE(2, 3); P5W_CE(4, 5); P5W_CE(6, 7);
    P5W_CE(3, 4); P5W_CE(5, 6);
#undef P5W_CE
}
DI unsigned bperm(int addr, unsigned v) { return (unsigned)__builtin_amdgcn_ds_bpermute(addr, (int)v); }
DI void xmerge32(unsigned (&a)[16], int paddr) {
    unsigned p[16];
#pragma unroll
    for (int i = 0; i < 16; ++i) p[i] = bperm(paddr, a[i]);
#pragma unroll
    for (int i = 0; i < 16; ++i) a[i] = umax(a[i], p[15 - i]);
    merge_desc<16>(a);
}
template <class Hook> DI void half_a(unsigned (&k0)[16], unsigned (&k2)[16], unsigned (&k3)[16], const bf16x8 (&bq)[8], const LAS unsigned char* kl, int p4, const Hook& after_first_step) {
    f32x16 acc[4];
#pragma unroll
    for (int mt = 0; mt < 4; ++mt)
#pragma unroll
        for (int r = 0; r < 16; ++r) acc[mt][r] = 0.f;
    bf16x8 ka[2][4];
#pragma unroll
    for (int mt = 0; mt < 4; ++mt) ka[0][mt] = *(const LAS bf16x8*)(kl + (32 * mt) * KPITCH);
#pragma unroll
    for (int ks = 0; ks < 8; ++ks) {
        if (ks < 7) {
#pragma unroll
            for (int mt = 0; mt < 4; ++mt) ka[(ks + 1) & 1][mt] = *(const LAS bf16x8*)(kl + (32 * mt) * KPITCH + 32 * (ks + 1));
        }
#pragma unroll
        for (int mt = 0; mt < 4; ++mt) acc[mt] = __builtin_amdgcn_mfma_f32_32x32x16_bf16(ka[ks & 1][mt], bq[ks], acc[mt], 0, 0, 0);
        __builtin_amdgcn_sched_barrier(0);
        if (ks == 0) { after_first_step(); __builtin_amdgcn_sched_barrier(0); }
    }
    unsigned k1[16];
    unsigned pb; asm volatile("v_xor_b32 %0, 4, %1" : "=v"(pb) : "v"(p4));
#pragma unroll
    for (int r = 0; r < 16; ++r) { const unsigned c = (unsigned)(123 - ((r & 3) + 8 * (r >> 2)));
        k0[r] = mkkey(acc[0][r], pb, 127u) | c; k1[r] = mkkey(acc[1][r], pb, 127u) | (c - 32u); k2[r] = mkkey(acc[2][r], pb, 127u) | (c - 64u); k3[r] = mkkey(acc[3][r], pb, 127u) | (c - 96u); }
    sort16_desc(k0); sort16_desc(k1); top16(k0, k1);
}
DI void half_b(unsigned (&k0)[16], unsigned (&k2)[16], unsigned (&k3)[16], int paddr) {
    sort16_desc(k2); sort16_desc(k3); top16(k2, k3);
    top16(k0, k2);
    xmerge32(k0, paddr);
}
#define P5W_SEG() do { asm volatile("" ::: "memory"); __builtin_amdgcn_sched_barrier(0); } while (0)
DI void unit_rows32(LAS unsigned char* lds, int lane_, int wave, int r0, int h, const bf16_t* qry, const float* ssqx, int* eidt, float* gate,
                    const float* csrc, unsigned char* cdst, size_t citem0, float csc, const float* ccolg) {
    int lane; asm volatile("v_mbcnt_lo_u32_b32 %0, -1, 0\n\tv_mbcnt_hi_u32_b32 %0, -1, %0" : "=v"(lane)); (void)lane_;
    const int qrow = lane & 31, p = lane >> 5, paddr = (lane ^ 32) << 2;
    const bool hi = p != 0;
    const int row = r0 + qrow;
    float rstd;
    { const f32x4* sp = (const f32x4*)(ssqx + (size_t)row * 16); const f32x4 sq0 = sp[0], sq1 = sp[1], sq2 = sp[2], sq3 = sp[3];
      const float ssq = ((sq0[0] + sq0[1]) + (sq0[2] + sq0[3])) + ((sq1[0] + sq1[1]) + (sq1[2] + sq1[3])) + ((sq2[0] + sq2[1]) + (sq2[2] + sq2[3])) + ((sq3[0] + sq3[1]) + (sq3[2] + sq3[3]));
      rstd = 1.0f / sqrtf(ssq * (1.f / DM) + EPS); }
    const bf16_t* qp = qry + pg8::qry_off(r0 >> 8, h, 0, (r0 & 255) >> 5, 0, qrow, p);
    const LAS unsigned char* kl = lds + qrow * KPITCH + 16 * p;
    unsigned a0[16], a1[16];
    CvtRegs<3> cv3;
    {
        bf16x8 bq[8];
#pragma unroll
        for (int ks = 0; ks < 8; ++ks) bq[ks] = *(const bf16x8*)(qp + 512 * ks);
        unsigned k2[16], k3[16];
        half_a(a0, k2, k3, bq, kl, 4 * p, [&]() { cvt8_load<3>(cv3, csrc, citem0, lane); });
        P5W_SEG();
        cvt8_store<3>(cv3, cdst, citem0, lane, csc, ccolg);
#pragma unroll
        for (int ks = 0; ks < 8; ++ks) bq[ks] = *(const bf16x8*)(qp + 32768 + 512 * ks);
        cvt8_load<3>(cv3, csrc, citem0 + 3, lane);
        P5W_SEG();
        half_b(a0, k2, k3, paddr);
        P5W_SEG();
        cvt8_store<3>(cv3, cdst, citem0 + 3, lane, csc, ccolg);
        P5W_SEG();
        half_a(a1, k2, k3, bq, kl + KHALF, 4 * p, [&]() { cvt8_load<3>(cv3, csrc, citem0 + 6, lane); });
        P5W_SEG();
        cvt8_store<3>(cv3, cdst, citem0 + 6, lane, csc, ccolg);
        cvt8_load<3>(cv3, csrc, citem0 + 9, lane);
        P5W_SEG();
        half_b(a1, k2, k3, paddr);
        P5W_SEG();
        cvt8_store<3>(cv3, cdst, citem0 + 9, lane, csc, ccolg);
    }
    CvtRegs<4> cv4; cvt8_load<4>(cv4, csrc, citem0 + 12, lane);
    P5W_SEG();
    LAS unsigned* REC = (LAS unsigned*)(lds + OFF_REC + wave * REC_WAVE) + qrow * 33;
    if (!hi) {
#pragma unroll
        for (int i = 0; i < 16; ++i) REC[i] = a0[i];
    } else {
#pragma unroll
        for (int i = 0; i < 16; ++i) REC[16 + i] = a1[i];
    }
    float f0[16], f1[16];
#pragma unroll
    for (int i = 0; i < 16; ++i) { f0[i] = keyval(a0[i], 127u); f1[i] = keyval(a1[i], 127u); }
    float g1[8]; unsigned cp[8];
#pragma unroll
    for (int k = 0; k < 8; ++k) { g1[k] = hi ? f1[2 * k + 1] : f1[2 * k]; cp[k] = (unsigned)(2 * k) | (unsigned)p; }
    unsigned t[16], u[16];
#pragma unroll
    for (int k = 0; k < 8; ++k) t[k] = mkkey(f0[0] + g1[k], cp[k], 255u);
#pragma unroll
    for (int k = 0; k < 4; ++k) t[8 + k] = mkkey(f0[1] + g1[k], 16u | cp[k], 255u);
    t[12] = mkkey(f0[2] + g1[0], 32u | cp[0], 255u); t[13] = mkkey(f0[2] + g1[1], 32u | cp[1], 255u);
    { const unsigned kx = mkkey(f0[2] + f1[4], 32u | 4u, 255u); t[14] = hi ? 0u : kx; }
    t[15] = mkkey(f0[3] + g1[0], 48u | cp[0], 255u); u[0] = mkkey(f0[3] + g1[1], 48u | cp[1], 255u);
    u[1] = mkkey(f0[4] + g1[0], 64u | cp[0], 255u);
    { const unsigned kx = mkkey(f0[4] + f1[2], 64u | 2u, 255u); u[2] = hi ? 0u : kx; }
    u[3] = mkkey(f0[5] + g1[0], 80u | cp[0], 255u); u[4] = mkkey(f0[6] + g1[0], 96u | cp[0], 255u); u[5] = mkkey(f0[7] + g1[0], 112u | cp[0], 255u);
#pragma unroll
    for (int k = 0; k < 4; ++k) { const float fv = hi ? f0[12 + k] : f0[8 + k]; u[6 + k] = mkkey(fv + f1[0], ((unsigned)(8 + k + 4 * p) << 4), 255u); }
    sort16_desc(t); sort10_desc(u);
#pragma unroll
    for (int k = 10; k < 16; ++k) u[k] = 0u;
    top16(t, u);
    xmerge32(t, paddr);
    P5W_SEG();
    cvt8_store<4>(cv4, cdst, citem0 + 12, lane, csc, ccolg);
    unsigned kk[8];
#pragma unroll
    for (int e = 0; e < 8; ++e) kk[e] = hi ? t[8 + e] : t[e];
    const float vmax = keyval(t[0], 255u);
    float ev[8]; float es = 0.f;
#pragma unroll
    for (int e = 0; e < 8; ++e) { ev[e] = __expf(rstd * (keyval(kk[e], 255u) - vmax)); es += ev[e]; }
    es += __uint_as_float(bperm(paddr, __float_as_uint(es)));
    const float inv = 1.0f / es;
    asm volatile("s_waitcnt lgkmcnt(0)" ::: "memory");
    int* et = eidt + (size_t)row * 128 + 2 * h + p;
#pragma unroll
    for (int e = 0; e < 8; ++e) { const unsigned cd = kk[e] & 255u;
        et[16 * e] = (int)(127u - (REC[cd >> 4] & 127u)) * 128 + (int)(127u - (REC[16 + (cd & 15u)] & 127u)); }
    float* gp = gate + (size_t)row * 128 + h * 16 + 8 * p;
    *(f32x4*)gp = (f32x4){ev[0] * inv, ev[1] * inv, ev[2] * inv, ev[3] * inv};
    *(f32x4*)(gp + 4) = (f32x4){ev[4] * inv, ev[5] * inv, ev[6] * inv, ev[7] * inv};
}
}

namespace p6 {
constexpr float SC_DOWN = 64.0f, SC_UP = 4.0f;
constexpr size_t SLICE = (size_t)NEXP * 128;
DI float gelu_erf(float v) { return 0.5f * v * (1.0f + erff(v * 0.70710678118654752f)); }
DI f32x2_t up8(unsigned w, bool hi) { return hi ? __builtin_amdgcn_cvt_pk_f32_fp8(w, true) : __builtin_amdgcn_cvt_pk_f32_fp8(w, false); }
DI float dot16(const u32x4 v, const f32x2_t (&x)[8]) {
    f32x2_t a = up8(v.x, false) * x[0];
    a = up8(v.x, true) * x[1] + a; a = up8(v.y, false) * x[2] + a; a = up8(v.y, true) * x[3] + a;
    a = up8(v.z, false) * x[4] + a; a = up8(v.z, true) * x[5] + a; a = up8(v.w, false) * x[6] + a; a = up8(v.w, true) * x[7] + a;
    return a.x + a.y;
}
DI void axpy16(f32x2_t (&o)[8], const u32x4 v, float c) {
    o[0] = up8(v.x, false) * c + o[0]; o[1] = up8(v.x, true) * c + o[1]; o[2] = up8(v.y, false) * c + o[2]; o[3] = up8(v.y, true) * c + o[3];
    o[4] = up8(v.z, false) * c + o[4]; o[5] = up8(v.z, true) * c + o[5]; o[6] = up8(v.w, false) * c + o[6]; o[7] = up8(v.w, true) * c + o[7];
}
template <int CTRL> DI float dppf(float v) { return __int_as_float(__builtin_amdgcn_update_dpp(0, __float_as_int(v), CTRL, 0xF, 0xF, false)); }
DI float grp8_sum(float v) { v += dppf<0xB1>(v); v += dppf<0x4E>(v); v += dppf<0x141>(v); return v; }
template <int S> DI int bcast8(int v) { return __builtin_amdgcn_ds_swizzle(v, (S << 5) | 0x18); }
template <int S> DI float bcast8f(float v) { return __int_as_float(__builtin_amdgcn_ds_swizzle(__float_as_int(v), (S << 5) | 0x18)); }
DI float row_rstd(const float* ssqx, int t) {
    const f32x4* sp = (const f32x4*)(ssqx + (size_t)t * 16); const f32x4 s0 = sp[0], s1 = sp[1], s2 = sp[2], s3 = sp[3];
    const float ssq = ((s0[0] + s0[1]) + (s0[2] + s0[3])) + ((s1[0] + s1[1]) + (s1[2] + s1[3])) + ((s2[0] + s2[1]) + (s2[2] + s2[3])) + ((s3[0] + s3[1]) + (s3[2] + s3[3]));
    return 1.0f / sqrtf(ssq * (1.f / DM) + EPS);
}

typedef int v2i_t __attribute__((ext_vector_type(2)));
DI long mk64(unsigned lo, unsigned hi) { return (long)(((unsigned long long)hi << 32) | (unsigned long long)lo); }
typedef int i32x4 __attribute__((ext_vector_type(4)));
struct Ids { i32x4 e0, e1, e2, e3; };
DI Ids ids_lds(const LAS unsigned char* slot, int lane) { Ids d; const LAS i32x4* ep = (const LAS i32x4*)(slot + (lane >> 3) * 64); d.e0 = ep[0]; d.e1 = ep[1]; d.e2 = ep[2]; d.e3 = ep[3]; return d; }
template <int I> DI int id_of(const Ids& d) { return I == 0 ? d.e0.x : I == 1 ? d.e0.y : I == 2 ? d.e0.z : I == 3 ? d.e0.w : I == 4 ? d.e1.x : I == 5 ? d.e1.y : I == 6 ? d.e1.z : I == 7 ? d.e1.w :
                                                   I == 8 ? d.e2.x : I == 9 ? d.e2.y : I == 10 ? d.e2.z : I == 11 ? d.e2.w : I == 12 ? d.e3.x : I == 13 ? d.e3.y : I == 14 ? d.e3.z : d.e3.w; }
template <int I> DI void dma1(LAS unsigned char* img, const unsigned char* slice, const Ids& d, int lane) {
    __builtin_amdgcn_global_load_lds((const unsigned*)(slice + (size_t)id_of<I>(d) * 128 + 16 * ((lane & 7) ^ (lane >> 3))), (LAS unsigned*)(img + I * 1024), 16, 0, 0);
}
DI void dma_all(LAS unsigned char* img, const unsigned char* slice, const Ids& d, int lane) {
    dma1<0>(img, slice, d, lane); dma1<1>(img, slice, d, lane); dma1<2>(img, slice, d, lane); dma1<3>(img, slice, d, lane); dma1<4>(img, slice, d, lane); dma1<5>(img, slice, d, lane); dma1<6>(img, slice, d, lane); dma1<7>(img, slice, d, lane);
    dma1<8>(img, slice, d, lane); dma1<9>(img, slice, d, lane); dma1<10>(img, slice, d, lane); dma1<11>(img, slice, d, lane); dma1<12>(img, slice, d, lane); dma1<13>(img, slice, d, lane); dma1<14>(img, slice, d, lane); dma1<15>(img, slice, d, lane);
}
DI void smalls_dma(LAS unsigned char* slot, const int* eidt, int t, const unsigned char* ahi, const unsigned char* alo, int lane_) {
    int lane; asm volatile("v_mov_b32 %0, %1" : "=v"(lane) : "v"(lane_));
    const unsigned char* src = (lane < 32) ? (const unsigned char*)(eidt + (size_t)t * 128) + 16 * lane : (lane < 40) ? ahi + 16 * (lane - 32) : (lane < 48) ? alo + 16 * (lane - 40) : ahi + 16 * (lane & 7);
    __builtin_amdgcn_global_load_lds((const unsigned*)src, (LAS unsigned*)slot, 16, 0, 0);
}
DI void smalls_dma4(LAS unsigned char* slot, const int* eidt, int t, const unsigned char* ahi, const unsigned char* alo, const unsigned char* ext, int lane_) {
    int lane; asm volatile("v_mov_b32 %0, %1" : "=v"(lane) : "v"(lane_));
    const unsigned char* src = (lane < 32) ? (const unsigned char*)(eidt + (size_t)t * 128) + 16 * lane : (lane < 40) ? ahi + 16 * (lane - 32) : (lane < 48) ? alo + 16 * (lane - 40) : ext + 16 * (lane - 48);
    __builtin_amdgcn_global_load_lds((const unsigned*)src, (LAS unsigned*)slot, 16, 0, 0);
}
template <bool EXT> DI void smalls_dma_n(LAS unsigned char* slot, const unsigned char* ahi, const unsigned char* alo, const unsigned char* ext, int lane_) {
    int lane; asm volatile("v_mov_b32 %0, %1" : "=v"(lane) : "v"(lane_));
    if (lane < (EXT ? 32 : 16)) { const unsigned char* src = (lane < 8) ? ahi + 16 * lane : (lane < 16) ? alo + 16 * (lane - 8) : ext + 16 * (lane - 16);
        __builtin_amdgcn_global_load_lds((const unsigned*)src, (LAS unsigned*)slot, 16, 0, 0); }
}
DI void ids_build(LAS unsigned char* idl, const int* eidt, int t0, int lane) {
    int2 v[8];
#pragma unroll
    for (int tok = 0; tok < 8; ++tok) v[tok] = *(const int2*)(eidt + (size_t)(t0 + tok) * 128 + 2 * lane);
#pragma unroll
    for (int tok = 0; tok < 8; ++tok) *(LAS unsigned*)(idl + tok * 256 + 4 * lane) = (unsigned)v[tok].x | ((unsigned)v[tok].y << 16);
    asm volatile("s_waitcnt lgkmcnt(0)" ::: "memory");
}
DI Ids ids_tab(const LAS unsigned char* idt, int lane) {
    const LAS u32x4* q = (const LAS u32x4*)(idt + (lane >> 3) * 32); const u32x4 a = q[0], b = q[1]; Ids d;
    d.e0 = (i32x4){(int)(a.x & 0xffffu), (int)(a.x >> 16), (int)(a.y & 0xffffu), (int)(a.y >> 16)}; d.e1 = (i32x4){(int)(a.z & 0xffffu), (int)(a.z >> 16), (int)(a.w & 0xffffu), (int)(a.w >> 16)};
    d.e2 = (i32x4){(int)(b.x & 0xffffu), (int)(b.x >> 16), (int)(b.y & 0xffffu), (int)(b.y >> 16)}; d.e3 = (i32x4){(int)(b.z & 0xffffu), (int)(b.z >> 16), (int)(b.w & 0xffffu), (int)(b.w >> 16)};
    return d;
}
DI void split8(float v0, float v1, float v2, float v3, unsigned& hi, unsigned& lo) {
    int h = 0; h = __builtin_amdgcn_cvt_pk_fp8_f32(v0, v1, h, false); h = __builtin_amdgcn_cvt_pk_fp8_f32(v2, v3, h, true);
    const f32x2_t b01 = __builtin_amdgcn_cvt_pk_f32_fp8(h, false), b23 = __builtin_amdgcn_cvt_pk_f32_fp8(h, true);
    int l = 0; l = __builtin_amdgcn_cvt_pk_fp8_f32((v0 - b01.x) * 16.0f, (v1 - b01.y) * 16.0f, l, false); l = __builtin_amdgcn_cvt_pk_fp8_f32((v2 - b23.x) * 16.0f, (v3 - b23.y) * 16.0f, l, true);
    hi = (unsigned)h; lo = (unsigned)l;
}
#define P6_WAITV(N) asm volatile("s_waitcnt vmcnt(" #N ")" ::: "memory")
#define P6_WAITL() asm volatile("s_waitcnt lgkmcnt(0)" ::: "memory")
DI void xq_token(int t, int lane, const bf16_t* x1b, unsigned char* xqh, unsigned char* xql) {
    const u32x4* xp = (const u32x4*)(x1b + (size_t)t * DM + 16 * lane); const u32x4 w0 = xp[0], w1 = xp[1];
    unsigned h0, h1, h2, h3, l0, l1, l2, l3;
    split8(bflo(w0.x), bfhi(w0.x), bflo(w0.y), bfhi(w0.y), h0, l0); split8(bflo(w0.z), bfhi(w0.z), bflo(w0.w), bfhi(w0.w), h1, l1);
    split8(bflo(w1.x), bfhi(w1.x), bflo(w1.y), bfhi(w1.y), h2, l2); split8(bflo(w1.z), bfhi(w1.z), bflo(w1.w), bfhi(w1.w), h3, l3);
    const u32x4 h = (u32x4){h0, h1, h2, h3}, l = (u32x4){l0, l1, l2, l3};
    st16_wt(xqh + (size_t)t * DM + 16 * lane, h); st16_wt(xql + (size_t)t * DM + 16 * lane, l);
}
DI void down_run(int j, int lw, int nlw, int lane, LAS unsigned char* img, LAS unsigned char* sm, LAS unsigned char* rs, const int* eidt, const unsigned char* xqh, const unsigned char* xql, const unsigned char* EDs, bf16_t* part) {
    if (lw >= M_TOK) return;
    const int n = lane & 15, kq = lane >> 4, key = n & 7;
    const int cnt = (M_TOK - 1 - lw) / nlw + 1, tl = lw + (cnt - 1) * nlw;
#define P6_TOK(i) ((lw + (i) * nlw <= tl) ? lw + (i) * nlw : tl)
#define P6_SM(t, slot) smalls_dma(slot, eidt, (t), xqh + (size_t)(t) * DM + 128 * j, xql + (size_t)(t) * DM + 128 * j, lane)
    P6_SM(P6_TOK(0), sm); P6_SM(P6_TOK(1), sm + 1024);
    P6_WAITV(0);
    Ids idn = ids_lds(sm, lane);
    P6_WAITL();
    dma_all(img, EDs, idn, lane);
    for (int i = 0; i < cnt; ++i) {
        const int t = lw + i * nlw;
        LAS unsigned char* cur = sm + (i & 1) * 1024; LAS unsigned char* nxs = sm + ((i + 1) & 1) * 1024;
        long a[4];
        { u32x4 a01 = (u32x4){0u, 0u, 0u, 0u}, a23 = (u32x4){0u, 0u, 0u, 0u};
          if (n < 2) { a01 = *(const LAS u32x4*)(cur + 512 + 128 * n + 32 * kq); a23 = *(const LAS u32x4*)(cur + 512 + 128 * n + 32 * kq + 16); }
          P6_WAITL();
          a[0] = mk64(a01.x, a01.y); a[1] = mk64(a01.z, a01.w); a[2] = mk64(a23.x, a23.y); a[3] = mk64(a23.z, a23.w); }
        { const int t2 = P6_TOK(i + 2); P6_SM(t2, cur); }
        float r[8];
#define P6_GRP(GI) { P6_WAITV(14); \
            const LAS unsigned char* row = img + (16 * (GI) + n) * 128; \
            const u32x4 b01 = *(const LAS u32x4*)(row + 16 * ((2 * kq) ^ key)), b23 = *(const LAS u32x4*)(row + 16 * ((2 * kq + 1) ^ key)); \
            if ((GI) == 0) idn = ids_lds(nxs, lane); \
            P6_WAITL(); \
            dma1<2 * (GI)>(img, EDs, idn, lane); dma1<2 * (GI) + 1>(img, EDs, idn, lane);     \
            f32x4 acc = (f32x4){0.f, 0.f, 0.f, 0.f}; \
            acc = __builtin_amdgcn_mfma_f32_16x16x32_fp8_fp8(a[0], mk64(b01.x, b01.y), acc, 0, 0, 0); \
            acc = __builtin_amdgcn_mfma_f32_16x16x32_fp8_fp8(a[1], mk64(b01.z, b01.w), acc, 0, 0, 0); \
            acc = __builtin_amdgcn_mfma_f32_16x16x32_fp8_fp8(a[2], mk64(b23.x, b23.y), acc, 0, 0, 0); \
            acc = __builtin_amdgcn_mfma_f32_16x16x32_fp8_fp8(a[3], mk64(b23.z, b23.w), acc, 0, 0, 0); \
            r[GI] = acc[0] + acc[1] * (1.0f / 16.0f); }
        P6_GRP(0) P6_GRP(1) P6_GRP(2) P6_GRP(3) P6_GRP(4) P6_GRP(5) P6_GRP(6) P6_GRP(7)
#undef P6_GRP
        if (lane < 16) {
#pragma unroll
            for (int gi = 0; gi < 8; ++gi) *(LAS unsigned short*)(rs + 2 * (16 * gi + n)) = (unsigned short)(cvtpk(r[gi], 0.f) & 0xffffu);
        }
        P6_WAITL();
        const unsigned w = *(const LAS unsigned*)(rs + 4 * lane);
        P6_WAITL();
        *(unsigned*)(part + ((size_t)j * M_TOK + t) * 128 + 2 * lane) = w;
    }
    P6_WAITV(0); P6_WAITL();
#undef P6_SM
}
DI void c_token(int t, int lane, const float* ssqx, const float* gate, const bf16_t* part, unsigned char* cq) {
    const float rstd = row_rstd(ssqx, t);
    const float2 G = *(const float2*)(gate + (size_t)t * 128 + 2 * lane);
    float a0 = 0.f, a1 = 0.f;
#pragma unroll
    for (int jj = 0; jj < 8; ++jj) { const unsigned w = *(const unsigned*)(part + ((size_t)jj * M_TOK + t) * 128 + 2 * lane); a0 += bflo(w); a1 += bfhi(w); }
    const float c0 = G.x * gelu_erf(a0 * rstd * (1.0f / SC_DOWN)) * (128.0f / SC_UP), c1 = G.y * gelu_erf(a1 * rstd * (1.0f / SC_DOWN)) * (128.0f / SC_UP);
    unsigned hi, lo; split8(c0, c1, 0.f, 0.f, hi, lo);
    *(unsigned short*)(cq + (size_t)t * 256 + 2 * lane) = (unsigned short)(hi & 0xffffu); *(unsigned short*)(cq + (size_t)t * 256 + 128 + 2 * lane) = (unsigned short)(lo & 0xffffu);
}
DI void up_run(int j, int lw, int nlw, int lane, LAS unsigned char* img, LAS unsigned char* sm, LAS unsigned char* rs, const int* eidt, const unsigned char* cq, const unsigned char* EUs, bf16_t* delta) {
    if (lw >= M_TOK) return;
    const int n = lane & 15, kq = lane >> 4, r = n >> 1, ch = n & 1;
    const int cnt = (M_TOK - 1 - lw) / nlw + 1, tl = lw + (cnt - 1) * nlw;
#define P6_SM(t, slot) smalls_dma(slot, eidt, (t), cq + (size_t)(t) * 256, cq + (size_t)(t) * 256 + 128, lane)
    P6_SM(P6_TOK(0), sm); P6_SM(P6_TOK(1), sm + 1024);
    P6_WAITV(0);
    Ids idn = ids_lds(sm, lane);
    P6_WAITL();
    dma_all(img, EUs, idn, lane);
    for (int i = 0; i < cnt; ++i) {
        const int t = lw + i * nlw;
        LAS unsigned char* cur = sm + (i & 1) * 1024; LAS unsigned char* nxs = sm + ((i + 1) & 1) * 1024;
        long a[4];
        { u32x2 w[4];
#pragma unroll
          for (int sx = 0; sx < 4; ++sx) { w[sx] = (u32x2){0u, 0u}; if (n < 2) w[sx] = *(const LAS u32x2*)(cur + 512 + 128 * n + 32 * sx + 8 * kq); }
          P6_WAITL();
#pragma unroll
          for (int sx = 0; sx < 4; ++sx) a[sx] = mk64(w[sx].x, w[sx].y); }
        { const int t2 = P6_TOK(i + 2); P6_SM(t2, cur); }
        f32x4 acc[8];
#pragma unroll
        for (int cb = 0; cb < 8; ++cb) acc[cb] = (f32x4){0.f, 0.f, 0.f, 0.f};
#define P6_KS(SX) { P6_WAITV(12); \
            v2i_t b[8]; \
            _Pragma("unroll") for (int cb = 0; cb < 8; ++cb) b[cb] = __builtin_amdgcn_ds_read_tr8_b64_v2i32((LAS v2i_t*)(img + (32 * (SX) + 8 * kq + r) * 128 + 16 * (cb ^ r) + 8 * ch)); \
            if ((SX) == 0) idn = ids_lds(nxs, lane); \
            P6_WAITL(); \
            dma1<4 * (SX)>(img, EUs, idn, lane); dma1<4 * (SX) + 1>(img, EUs, idn, lane); dma1<4 * (SX) + 2>(img, EUs, idn, lane); dma1<4 * (SX) + 3>(img, EUs, idn, lane); \
            _Pragma("unroll") for (int cb = 0; cb < 8; ++cb) acc[cb] = __builtin_amdgcn_mfma_f32_16x16x32_fp8_fp8(a[SX], mk64((unsigned)b[cb].x, (unsigned)b[cb].y), acc[cb], 0, 0, 0); }
        P6_KS(0) P6_KS(1) P6_KS(2) P6_KS(3)
#undef P6_KS
        if (lane < 16) {
#pragma unroll
            for (int cb = 0; cb < 8; ++cb) *(LAS unsigned short*)(rs + 2 * (16 * cb + n)) = (unsigned short)(cvtpk((acc[cb][0] + acc[cb][1] * (1.0f / 16.0f)) * (1.0f / 128.0f), 0.f) & 0xffffu);
        }
        P6_WAITL();
        const unsigned w = *(const LAS unsigned*)(rs + 4 * lane);
        P6_WAITL();
        *(unsigned*)(delta + (size_t)t * DM + 128 * j + 2 * lane) = w;
    }
    P6_WAITV(0); P6_WAITL();
#undef P6_SM
#undef P6_TOK
}
DI int opaque_lane() { int l; asm volatile("v_mbcnt_lo_u32_b32 %0, -1, 0\n\tv_mbcnt_hi_u32_b32 %0, -1, %0" : "=v"(l)); return l; }
#define P6I_T(i) (t0 + (((i) < 64 ? (i) : 63) & 7))
#define P6I_S(i) (((i) < 64 ? (i) : 63) >> 3)
DI void own_down(int t0, LAS unsigned char* img, LAS unsigned char* sm, const int* eidt, const unsigned char* xqh, const unsigned char* xql, const unsigned char* ED, float (&pacc)[8][8], LAS unsigned char* idl) {
    const int lane = opaque_lane();
    const int n = lane & 15, kq = lane >> 4, key = n & 7;
#define P6I_SM(i, slot) smalls_dma_n<false>(slot, xqh + (size_t)P6I_T(i) * DM + 128 * P6I_S(i), xql + (size_t)P6I_T(i) * DM + 128 * P6I_S(i), nullptr, lane)
    P6I_SM(0, sm); P6I_SM(1, sm + 512);
    ids_build(idl, eidt, t0, lane);
    P6_WAITV(0);
    Ids idn = ids_tab(idl, lane);
    P6_WAITL();
    dma_all(img, ED, idn, lane);
    for (int s = 0; s < 8; ++s) {
#define P6I_GRP(GI, TOK) { P6_WAITV(14); \
            const LAS unsigned char* row = img + (16 * (GI) + n) * 128; \
            const u32x4 b01 = *(const LAS u32x4*)(row + 16 * ((2 * kq) ^ key)), b23 = *(const LAS u32x4*)(row + 16 * ((2 * kq + 1) ^ key)); \
            if ((GI) == 0) idn = ids_tab(idl + (((TOK) + 1) & 7) * 256, lane); \
            P6_WAITL(); \
            dma1<2 * (GI)>(img, nsl, idn, lane); dma1<2 * (GI) + 1>(img, nsl, idn, lane); \
            f32x4 acc = (f32x4){0.f, 0.f, 0.f, 0.f}; \
            acc = __builtin_amdgcn_mfma_f32_16x16x32_fp8_fp8(a[0], mk64(b01.x, b01.y), acc, 0, 0, 0); \
            acc = __builtin_amdgcn_mfma_f32_16x16x32_fp8_fp8(a[1], mk64(b01.z, b01.w), acc, 0, 0, 0); \
            acc = __builtin_amdgcn_mfma_f32_16x16x32_fp8_fp8(a[2], mk64(b23.x, b23.y), acc, 0, 0, 0); \
            acc = __builtin_amdgcn_mfma_f32_16x16x32_fp8_fp8(a[3], mk64(b23.z, b23.w), acc, 0, 0, 0); \
            pacc[TOK][GI] += acc[0] + acc[1] * (1.0f / 16.0f); }
#define P6I_ITEM(TOK) { const int i = 8 * s + (TOK); \
            LAS unsigned char* cur = sm + ((TOK) & 1) * 512; \
            long a[4]; \
            { u32x4 a01 = (u32x4){0u, 0u, 0u, 0u}, a23 = (u32x4){0u, 0u, 0u, 0u}; \
              if (n < 2) { a01 = *(const LAS u32x4*)(cur + 128 * n + 32 * kq); a23 = *(const LAS u32x4*)(cur + 128 * n + 32 * kq + 16); } \
              P6_WAITL(); \
              a[0] = mk64(a01.x, a01.y); a[1] = mk64(a01.z, a01.w); a[2] = mk64(a23.x, a23.y); a[3] = mk64(a23.z, a23.w); } \
            P6I_SM(i + 2, cur); \
            const unsigned char* nsl = ED + (size_t)P6I_S(i + 1) * SLICE;                   \
            P6I_GRP(0, TOK) P6I_GRP(1, TOK) P6I_GRP(2, TOK) P6I_GRP(3, TOK) P6I_GRP(4, TOK) P6I_GRP(5, TOK) P6I_GRP(6, TOK) P6I_GRP(7, TOK) }
        P6I_ITEM(0) P6I_ITEM(1) P6I_ITEM(2) P6I_ITEM(3) P6I_ITEM(4) P6I_ITEM(5) P6I_ITEM(6) P6I_ITEM(7)
#undef P6I_ITEM
#undef P6I_GRP
    }
    P6_WAITV(0); P6_WAITL();
#undef P6I_SM
}
DI void own_c(int t0, LAS unsigned char* img, const float (&pacc)[8][8], const float* ssqx, const float* gate, unsigned char* cq) {
    const int lane = opaque_lane();
    LAS float* pf = (LAS float*)img;
    if (lane < 16) {
#pragma unroll
        for (int tok = 0; tok < 8; ++tok)
#pragma unroll
            for (int gi = 0; gi < 8; ++gi) pf[tok * 128 + 16 * gi + lane] = pacc[tok][gi];
    }
    const float rl = row_rstd(ssqx, t0 + (lane & 7));
    float2 G[8];
#pragma unroll
    for (int tok = 0; tok < 8; ++tok) G[tok] = *(const float2*)(gate + (size_t)(t0 + tok) * 128 + 2 * lane);
    P6_WAITL();
#pragma unroll
    for (int tok = 0; tok < 8; ++tok) {
        const float rstd = __int_as_float(__builtin_amdgcn_readlane(__float_as_int(rl), tok));
        const f32x2_t d = *(const LAS f32x2_t*)(pf + tok * 128 + 2 * lane);
        const float c0 = G[tok].x * gelu_erf(d.x * rstd * (1.0f / SC_DOWN)) * (128.0f / SC_UP), c1 = G[tok].y * gelu_erf(d.y * rstd * (1.0f / SC_DOWN)) * (128.0f / SC_UP);
        unsigned hi, lo; split8(c0, c1, 0.f, 0.f, hi, lo);
        *(unsigned short*)(cq + (size_t)(t0 + tok) * 256 + 2 * lane) = (unsigned short)(hi & 0xffffu); *(unsigned short*)(cq + (size_t)(t0 + tok) * 256 + 128 + 2 * lane) = (unsigned short)(lo & 0xffffu);
    }
    asm volatile("s_waitcnt vmcnt(0) lgkmcnt(0)" ::: "memory");
}
DI void own_c2(int t0, LAS unsigned char* img, const float (&pacc)[8][8], const float* ssqx, const float* gate, unsigned char* cq, const LAS unsigned char* idl, const unsigned char* EU) {
    const int lane = opaque_lane();
    LAS float* pf = (LAS float*)img;
    if (lane < 16) {
#pragma unroll
        for (int tok = 0; tok < 8; ++tok)
#pragma unroll
            for (int gi = 0; gi < 8; ++gi) pf[tok * 128 + 16 * gi + lane] = pacc[tok][gi];
    }
    const Ids idn = ids_tab(idl, lane);
    const float rl = row_rstd(ssqx, t0 + (lane & 7));
    float2 G[8];
#pragma unroll
    for (int tok = 0; tok < 8; ++tok) G[tok] = *(const float2*)(gate + (size_t)(t0 + tok) * 128 + 2 * lane);
    P6_WAITL();
    f32x2_t d[8];
#pragma unroll
    for (int tok = 0; tok < 8; ++tok) d[tok] = *(const LAS f32x2_t*)(pf + tok * 128 + 2 * lane);
    P6_WAITL();
    dma_all(img, EU, idn, lane);
#pragma unroll
    for (int tok = 0; tok < 8; ++tok) {
        const float rstd = __int_as_float(__builtin_amdgcn_readlane(__float_as_int(rl), tok));
        const float c0 = G[tok].x * gelu_erf(d[tok].x * rstd * (1.0f / SC_DOWN)) * (128.0f / SC_UP), c1 = G[tok].y * gelu_erf(d[tok].y * rstd * (1.0f / SC_DOWN)) * (128.0f / SC_UP);
        unsigned hi, lo; split8(c0, c1, 0.f, 0.f, hi, lo);
        *(unsigned short*)(cq + (size_t)(t0 + tok) * 256 + 2 * lane) = (unsigned short)(hi & 0xffffu); *(unsigned short*)(cq + (size_t)(t0 + tok) * 256 + 128 + 2 * lane) = (unsigned short)(lo & 0xffffu);
    }
    asm volatile("s_waitcnt vmcnt(0) lgkmcnt(0)" ::: "memory");
}
template <bool PREFILLED> DI void own_up(int t0, LAS unsigned char* img, LAS unsigned char* sm, LAS unsigned char* rs, const int* eidt, const unsigned char* cq, const unsigned char* EU, const bf16_t* x1b, bf16_t* delta, const LAS unsigned char* idl) {
    const int lane = opaque_lane();
    const int n = lane & 15, kq = lane >> 4, r = n >> 1, ch = n & 1;
#define P6I_SM(i, slot) smalls_dma_n<true>(slot, cq + (size_t)P6I_T(i) * 256, cq + (size_t)P6I_T(i) * 256 + 128, (const unsigned char*)(x1b + (size_t)P6I_T(i) * DM + 128 * P6I_S(i)), lane)
    P6I_SM(0, sm); P6I_SM(1, sm + 512);
    P6_WAITV(0);
    Ids idn = ids_tab(idl, lane);
    P6_WAITL();
    if (!PREFILLED) dma_all(img, EU, idn, lane);
    for (int i = 0; i < 64; ++i) {
        const int t = t0 + (i & 7), sl = i >> 3;
        LAS unsigned char* cur = sm + (i & 1) * 512; const LAS unsigned char* nxid = idl + ((i + 1) & 7) * 256;
        long a[4]; unsigned xs;
        { u32x2 w[4];
#pragma unroll
          for (int sx = 0; sx < 4; ++sx) { w[sx] = (u32x2){0u, 0u}; if (n < 2) w[sx] = *(const LAS u32x2*)(cur + 128 * n + 32 * sx + 8 * kq); }
          xs = *(const LAS unsigned*)(cur + 256 + 4 * lane);
          P6_WAITL();
#pragma unroll
          for (int sx = 0; sx < 4; ++sx) a[sx] = mk64(w[sx].x, w[sx].y); }
        P6I_SM(i + 2, cur);
        const unsigned char* nsl = EU + (size_t)P6I_S(i + 1) * SLICE;
        f32x4 acc[8];
#pragma unroll
        for (int cb = 0; cb < 8; ++cb) acc[cb] = (f32x4){0.f, 0.f, 0.f, 0.f};
#define P6I_KS(SX) { P6_WAITV(12); \
            v2i_t b[8]; \
            _Pragma("unroll") for (int cb = 0; cb < 8; ++cb) b[cb] = __builtin_amdgcn_ds_read_tr8_b64_v2i32((LAS v2i_t*)(img + (32 * (SX) + 8 * kq + r) * 128 + 16 * (cb ^ r) + 8 * ch)); \
            if ((SX) == 0) idn = ids_tab(nxid, lane); \
            P6_WAITL(); \
            dma1<4 * (SX)>(img, nsl, idn, lane); dma1<4 * (SX) + 1>(img, nsl, idn, lane); dma1<4 * (SX) + 2>(img, nsl, idn, lane); dma1<4 * (SX) + 3>(img, nsl, idn, lane); \
            _Pragma("unroll") for (int cb = 0; cb < 8; ++cb) acc[cb] = __builtin_amdgcn_mfma_f32_16x16x32_fp8_fp8(a[SX], mk64((unsigned)b[cb].x, (unsigned)b[cb].y), acc[cb], 0, 0, 0); }
        P6I_KS(0) P6I_KS(1) P6I_KS(2) P6I_KS(3)
#undef P6I_KS
        if (lane < 16) {
#pragma unroll
            for (int cb = 0; cb < 8; ++cb) *(LAS unsigned short*)(rs + 2 * (16 * cb + n)) = (unsigned short)(cvtpk((acc[cb][0] + acc[cb][1] * (1.0f / 16.0f)) * (1.0f / 128.0f), 0.f) & 0xffffu);
        }
        P6_WAITL();
        const unsigned w = *(const LAS unsigned*)(rs + 4 * lane);
        P6_WAITL();
        *(unsigned*)(delta + (size_t)t * DM + 128 * sl + 2 * lane) = cvtpk(bflo(w) + bflo(xs), bfhi(w) + bfhi(xs));
    }
    P6_WAITV(0); P6_WAITL();
#undef P6I_SM
}
#undef P6I_T
#undef P6I_S
DI void final_token(int t, int lane, float* outp, const bf16_t* x1b, const bf16_t* delta, const float* g_fin) {
    f32x4* orow = (f32x4*)(outp + (size_t)t * DM) + lane; const u32x2* xr = (const u32x2*)(x1b + (size_t)t * DM) + lane; const u32x2* dr = (const u32x2*)(delta + (size_t)t * DM) + lane; const f32x4* gr = (const f32x4*)g_fin + lane;
    f32x4 v[4]; float ss = 0.f;
#pragma unroll
    for (int i = 0; i < 4; ++i) { const u32x2 d = dr[64 * i], x = xr[64 * i]; v[i][0] = bflo(x.x) + bflo(d.x); v[i][1] = bfhi(x.x) + bfhi(d.x); v[i][2] = bflo(x.y) + bflo(d.y); v[i][3] = bfhi(x.y) + bfhi(d.y);
        ss += (v[i][0] * v[i][0] + v[i][1] * v[i][1]) + (v[i][2] * v[i][2] + v[i][3] * v[i][3]); }
    const float r2 = 1.0f / sqrtf(wave_sum(ss) * (1.f / DM) + EPS);
#pragma unroll
    for (int i = 0; i < 4; ++i) orow[64 * i] = v[i] * r2 * gr[64 * i];
}
template <int U> DI void final_tokens(int tb, int lane, float* outp, const bf16_t* x1b, const bf16_t* delta, const float* g_fin) {
    u32x2 xr[U][4], dr[U][4];
#pragma unroll
    for (int u = 0; u < U; ++u) { const u32x2* xp = (const u32x2*)(x1b + (size_t)(tb + u) * DM) + lane; const u32x2* dp = (const u32x2*)(delta + (size_t)(tb + u) * DM) + lane;
#pragma unroll
        for (int i = 0; i < 4; ++i) { xr[u][i] = xp[64 * i]; dr[u][i] = dp[64 * i]; } }
    f32x4 g[4];
#pragma unroll
    for (int i = 0; i < 4; ++i) g[i] = *((const f32x4*)g_fin + lane + 64 * i);
#pragma unroll
    for (int u = 0; u < U; ++u) { f32x4 v[4]; float ss = 0.f;
#pragma unroll
        for (int i = 0; i < 4; ++i) { const u32x2 d = dr[u][i], x = xr[u][i]; v[i][0] = bflo(x.x) + bflo(d.x); v[i][1] = bfhi(x.x) + bfhi(d.x); v[i][2] = bflo(x.y) + bflo(d.y); v[i][3] = bfhi(x.y) + bfhi(d.y);
            ss += (v[i][0] * v[i][0] + v[i][1] * v[i][1]) + (v[i][2] * v[i][2] + v[i][3] * v[i][3]); }
        const float r2 = 1.0f / sqrtf(wave_sum(ss) * (1.f / DM) + EPS);
        f32x4* orow = (f32x4*)(outp + (size_t)(tb + u) * DM) + lane;
#pragma unroll
        for (int i = 0; i < 4; ++i) __builtin_nontemporal_store(v[i] * r2 * g[i], orow + 64 * i); }
}
template <int U> DI void final_tokens_y(int tb, int lane, float* outp, const bf16_t* y, const float* g_fin) {
    u32x2 dr[U][4];
#pragma unroll
    for (int u = 0; u < U; ++u) { const u32x2* dp = (const u32x2*)(y + (size_t)(tb + u) * DM) + lane;
#pragma unroll
        for (int i = 0; i < 4; ++i) dr[u][i] = dp[64 * i]; }
    f32x4 g[4];
#pragma unroll
    for (int i = 0; i < 4; ++i) g[i] = *((const f32x4*)g_fin + lane + 64 * i);
#pragma unroll
    for (int u = 0; u < U; ++u) { f32x4 v[4]; float ss = 0.f;
#pragma unroll
        for (int i = 0; i < 4; ++i) { const u32x2 d = dr[u][i]; v[i][0] = bflo(d.x); v[i][1] = bfhi(d.x); v[i][2] = bflo(d.y); v[i][3] = bfhi(d.y);
            ss += (v[i][0] * v[i][0] + v[i][1] * v[i][1]) + (v[i][2] * v[i][2] + v[i][3] * v[i][3]); }
        const float r2 = 1.0f / sqrtf(wave_sum(ss) * (1.f / DM) + EPS);
        f32x4* orow = (f32x4*)(outp + (size_t)(tb + u) * DM) + lane;
#pragma unroll
        for (int i = 0; i < 4; ++i) __builtin_nontemporal_store(v[i] * r2 * g[i], orow + 64 * i); }
}
}

DI void side_issue(LAS unsigned char* reg, const float* W, int N, int item, bool tr) {
    int lane; asm volatile("v_mbcnt_lo_u32_b32 %0, -1, 0\n\tv_mbcnt_hi_u32_b32 %0, -1, %0" : "=v"(lane));
    if (tr) { const int nblk = N / 32, kb = item / nblk, nb = item % nblk, k0 = 64 * kb, n0 = 32 * nb;
        const float* wp = W + (size_t)(k0 + (lane >> 5)) * N + n0 + (lane & 31);
#pragma unroll 4
        for (int i = 0; i < 32; ++i) __builtin_amdgcn_global_load_lds((const unsigned*)(wp + (size_t)(2 * i) * N), (LAS unsigned*)(reg + i * 256), 4, 0, 0); }
    else { const float* wp = W + (size_t)item * 512 + lane;
#pragma unroll
        for (int i = 0; i < 8; ++i) __builtin_amdgcn_global_load_lds((const unsigned*)(wp + 64 * i), (LAS unsigned*)(reg + i * 256), 4, 0, 0); }
}
DI void side_finish_tr(const LAS unsigned char* reg, int K, int N, bf16_t* WT, const float* sc_lo, const float* sc_hi, int split, int item) {
    int lane; asm volatile("v_mbcnt_lo_u32_b32 %0, -1, 0\n\tv_mbcnt_hi_u32_b32 %0, -1, %0" : "=v"(lane));
    const int nblk = N / 32, kb = item / nblk, nb = item % nblk, k0 = 64 * kb, n0 = 32 * nb, c = lane & 7;
    const int k = k0 + 8 * c; const float* g = (k < split) ? sc_lo + k : sc_hi + (k - split);
    const f32x4 g0 = *(const f32x4*)g, g1 = *(const f32x4*)(g + 4);
    const LAS float* t = (const LAS float*)reg;
#pragma unroll
    for (int j = 0; j < 4; ++j) { const int n = (lane >> 3) + 8 * j; const LAS float* q = t + (8 * c) * 32 + n;
        u32x4 o; o.x = cvtpk(q[0 * 32] * g0[0], q[1 * 32] * g0[1]); o.y = cvtpk(q[2 * 32] * g0[2], q[3 * 32] * g0[3]); o.z = cvtpk(q[4 * 32] * g1[0], q[5 * 32] * g1[1]); o.w = cvtpk(q[6 * 32] * g1[2], q[7 * 32] * g1[3]);
        st16_wt(WT + (size_t)(n0 + n) * K + k0 + 8 * c, o); }
}
DI void side_finish_cvt(const LAS unsigned char* reg, bf16_t* dst, int item) {
    int lane; asm volatile("v_mbcnt_lo_u32_b32 %0, -1, 0\n\tv_mbcnt_hi_u32_b32 %0, -1, %0" : "=v"(lane));
    const LAS f32x4* t = (const LAS f32x4*)reg + 2 * lane; const f32x4 a = t[0], b = t[1];
    u32x4 o; o.x = cvtpk(a[0], a[1]); o.y = cvtpk(a[2], a[3]); o.z = cvtpk(b[0], b[1]); o.w = cvtpk(b[2], b[3]);
    *((u32x4*)(dst + (size_t)item * 512) + lane) = o;
}

constexpr int N_LAUNCHES = MK_N_LAUNCHES;
constexpr int N_PHASES = 7;

__global__ void __launch_bounds__(NWAVES * 64, 2) hymba_fwd(Args args) {
    extern __shared__ __attribute__((aligned(16))) unsigned char lds_raw[];
    Frame F;
    F.lds = (LAS unsigned char*)lds_raw;
    volatile LAS unsigned* MISC = (volatile LAS unsigned*)(F.lds + MISC_OFF);
    F.tid = threadIdx.x; F.lane = F.tid & 63; F.wave = __builtin_amdgcn_readfirstlane(F.tid >> 6);
    F.G = gridDim.x; { const int bx = blockIdx.x; F.vcu = (F.G % 8 == 0) ? (bx % 8) * (F.G / 8) + bx / 8 : bx; }
    unsigned char* ws = args.ws;
    unsigned* ctl = (unsigned*)(ws + WS_CTL);
    const float* x = args.in[0]; const float* g_mix = args.in[1]; const float* w_in = args.in[2]; const float* conv_w = args.in[3];
    const float* g_conv = args.in[4]; const float* g_attn = args.in[5]; const float* w_out = args.in[6]; const float* g_ffn = args.in[7];
    const float* w_q = args.in[8]; const float* sk1 = args.in[9]; const float* sk2 = args.in[10]; const float* e_down = args.in[11]; const float* e_up = args.in[12];
    const float* g_fin = args.in[13];
    float* out = args.out;
    bf16_t* WinT = (bf16_t*)(ws + WS_WIN); bf16_t* WoutT = (bf16_t*)(ws + WS_WOUT); bf16_t* WqT = (bf16_t*)(ws + WS_WQ);
    bf16_t* K1b = (bf16_t*)(ws + WS_K1); bf16_t* K2b = (bf16_t*)(ws + WS_K2);
    bf16_t* XN = (bf16_t*)(ws + WS_XN); bf16_t* PROJ = (bf16_t*)(ws + WS_PROJ); bf16_t* QRY = (bf16_t*)(ws + WS_QRY); bf16_t* Yb = (bf16_t*)(ws + WS_Y);
    unsigned char* ED8 = ws + WS_ED; unsigned char* EU8 = ws + WS_EU;
    float* KSUM = (float*)(ws + WS_KSUM); float* SSQA = (float*)(ws + WS_SSQA); float* SSQX = (float*)(ws + WS_SSQX);
    float* RMS0 = (float*)(ws + WS_RMS0); bf16_t* IDM = (bf16_t*)(ws + WS_IDM);
    int* EIDX = (int*)(ws + WS_EIDX); float* GATE = (float*)(ws + WS_GATE);

    if (F.tid < 64) MISC[F.tid] = 0u;
    __syncthreads();
    XcdBarrier bar; bar.bar = ctl + CW_BAR; bar.x = 0; bar.st = nullptr;
    if (N_LAUNCHES == 1) bar = xcd_barrier_post(ctl + CW_BAR, MISC + 8);
#define GRID_BAR() do { if (N_LAUNCHES == 1) xcd_barrier(bar); } while (0)
    const int lo = args.ph_lo, hi = args.ph_hi;
#define IN(k) (lo <= (k) && (k) < hi)
#define BOTH(k) (IN(k) && IN((k) + 1))
    const int gw = F.vcu * NWAVES + F.wave, NGW = F.G * NWAVES;

    if (IN(0)) for (int rep = 0; rep < NREP(0); ++rep) {
        LAS float* scr = (LAS float*)(F.lds + F.wave * 16384);
        constexpr int I_IN = (DM / 64) * (DPROJ / 32), I_OUT = (DM / 64) * (DM / 32), I_Q = (DM / 64) * (2048 / 32);
        constexpr int I_SK = 131072 / 512, I_EX = (NEXP * DM) / 512;
        constexpr int NITEMS0 = I_IN + I_OUT + I_Q + 2 * I_SK;
        const bool p0_lds = (NGW == NITEMS0 - I_IN) && NGW >= I_IN;
        LAS unsigned char* p0_reg = F.lds + F.wave * 16384;
        if (p0_lds && gw < I_IN) side_issue(p0_reg, w_in, DPROJ, gw, true);
        for (int r0 = gw * 4; r0 < M_TOK; r0 += NGW * 4) p0_xn_rows<4>(x, g_mix, XN, RMS0, r0, F.lane);
        for (int n = gw; n < 256; n += NGW) {
            u32x4 z0 = (u32x4){0u, 0u, 0u, 0u}, z1 = z0; const int kk = n - 16 * F.lane;
            if (kk >= 0 && kk < 16) { const unsigned one = (kk & 1) ? 0x3F800000u : 0x00003F80u; const int wi = kk >> 1;
                if (wi < 4) { if (wi == 0) z0.x = one; else if (wi == 1) z0.y = one; else if (wi == 2) z0.z = one; else z0.w = one; }
                else { if (wi == 4) z1.x = one; else if (wi == 5) z1.y = one; else if (wi == 6) z1.z = one; else z1.w = one; } }
            st16_wt(IDM + (size_t)n * DM + 16 * F.lane, z0); st16_wt(IDM + (size_t)n * DM + 16 * F.lane + 8, z1);
        }
        constexpr int NITEMS = I_IN + I_OUT + I_Q + 2 * I_SK;
        const int p0_items = (NGW == NITEMS - I_IN) ? I_IN : NITEMS;
        if (p0_lds) { if (gw < I_IN) { asm volatile("s_waitcnt vmcnt(0)" ::: "memory"); side_finish_tr(p0_reg, DM, DPROJ, WinT, g_mix, g_mix, DM, gw); } }
        else for (int it = gw; it < p0_items; it += NGW) {
            int r = it;
            if (r < I_IN) { p0_transpose_item(w_in, DM, DPROJ, WinT, g_mix, g_mix, DM, scr, r, F.lane); continue; } r -= I_IN;
            if (r < I_OUT) { p0_transpose_item(w_out, DM, DM, WoutT, g_conv, g_attn, 512, scr, r, F.lane); continue; } r -= I_OUT;
            if (r < I_Q) { p0_transpose_item(w_q, DM, 2048, WqT, g_ffn, g_ffn, DM, scr, r, F.lane); continue; } r -= I_Q;
            if (r < I_SK) { p0_cvt_item(sk1, K1b, (size_t)r, F.lane); continue; } r -= I_SK;
            p0_cvt_item(sk2, K2b, (size_t)r, F.lane);
        }
        if (BOTH(0)) GRID_BAR();
    }
    if (IN(1)) for (int rep = 0; rep < NREP(1); ++rep) {
        pg8::Gemm g{XN, WinT, M_TOK, DPROJ, DM, DM, DM}; pg8::StaticOrder S; S.init(M_TOK, DPROJ, F.G, (int)blockIdx.x);
        pg8::EpiProj E{PROJ, KSUM};
        pg8::gemm_phase<pg8::EpiProj, pg8::StaticOrder, true>(F.lds, g, S, E);
        if (BOTH(1)) GRID_BAR();
    }
    if (IN(2)) for (int rep = 0; rep < NREP(2); ++rep) {
        bool conv_done = false;
        constexpr int SJ_OUT = (DM / 64) * (DM / 32), SJ_Q = (DM / 64) * (2048 / 32), SJ_SK = 131072 / 512;
        const bool side_lds = (NGW == SJ_OUT + SJ_Q + 2 * SJ_SK) && F.vcu < 256;
        LAS unsigned char* side_reg = F.lds + 86016 + F.wave * 8192;
        for (int v = F.vcu; v < 256; v += F.G) {
            const int bh = v >> 2, s = v & 3;
            att2::attn_unit<8>(bh >> 3, bh & 7, s, (const att2::bf16*)(PROJ + QOFF), (const att2::bf16*)(PROJ + KOFF), (const att2::bf16*)(PROJ + VOFF), (att2::bf16*)(Yb + 512), KSUM, SSQA, (char*)lds_raw);
            if (!conv_done) { conv_done = true;
                if (NGW * 8 == M_TOK) att::conv_rows8(PROJ, conv_w, Yb, gw * 8, F.lane);
                else for (int r0 = gw * 4; r0 < M_TOK; r0 += NGW * 4) att::conv_rows4(PROJ, conv_w, Yb, r0, F.lane);
                if (side_lds) {
                    const int r = gw;
                    if (r < SJ_OUT) side_issue(side_reg, w_out, DM, r, true);
                    else if (r < SJ_OUT + SJ_Q) side_issue(side_reg, w_q, 2048, r - SJ_OUT, true);
                    else { const int q = r - SJ_OUT - SJ_Q; side_issue(side_reg, q < SJ_SK ? sk1 : sk2, 0, q < SJ_SK ? q : q - SJ_SK, false); } } }
            att2::attn_unit<8>(bh >> 3, bh & 7, 7 - s, (const att2::bf16*)(PROJ + QOFF), (const att2::bf16*)(PROJ + KOFF), (const att2::bf16*)(PROJ + VOFF), (att2::bf16*)(Yb + 512), KSUM, SSQA, (char*)lds_raw);
        }
        if (!conv_done) for (int r0 = gw * 4; r0 < M_TOK; r0 += NGW * 4) att::conv_rows4(PROJ, conv_w, Yb, r0, F.lane);
        __syncthreads();
        { constexpr int J_OUT = (DM / 64) * (DM / 32), J_Q = (DM / 64) * (2048 / 32), J_SK = 131072 / 512;
          if (NGW == J_OUT + J_Q + 2 * J_SK) {
              const int r = gw;
              if (side_lds) {
                  asm volatile("s_waitcnt vmcnt(0)" ::: "memory");
                  if (r < J_OUT) side_finish_tr(side_reg, DM, DM, WoutT, g_conv, g_attn, 512, r);
                  else if (r < J_OUT + J_Q) side_finish_tr(side_reg, DM, 2048, WqT, g_ffn, g_ffn, DM, r - J_OUT);
                  else { const int q = r - J_OUT - J_Q; if (q < J_SK) side_finish_cvt(side_reg, K1b, q); else side_finish_cvt(side_reg, K2b, q - J_SK); }
              } else {
                  LAS float* scr2 = (LAS float*)(F.lds + F.wave * 16384);
                  if (r < J_OUT) p0_transpose_item(w_out, DM, DM, WoutT, g_conv, g_attn, 512, scr2, r, F.lane);
                  else if (r < J_OUT + J_Q) p0_transpose_item(w_q, DM, 2048, WqT, g_ffn, g_ffn, DM, scr2, r - J_OUT, F.lane);
                  else { const int q = r - J_OUT - J_Q; if (q < J_SK) p0_cvt_item(sk1, K1b, (size_t)q, F.lane); else p0_cvt_item(sk2, K2b, (size_t)(q - J_SK), F.lane); }
              }
              __syncthreads(); } }
        if (BOTH(2)) GRID_BAR();
    }
    if (IN(3)) for (int rep = 0; rep < NREP(3); ++rep) {
        pg8::StaticOrder S; S.init(M_TOK, DM, F.G, (int)blockIdx.x);
        pg8::Unit u0;
        if (S.next(0, u0)) {
            if (F.tid < 256) { const f32x4* sp = (const f32x4*)(SSQA + (size_t)(u0.pm * 256 + F.tid) * 8); const f32x4 a = sp[0], b = sp[1];
                const float ms = (((a[0] + a[1]) + (a[2] + a[3])) + ((b[0] + b[1]) + (b[2] + b[3]))) * (1.f / 512.f) + EPS; const float rms = sqrtf(ms);
                LAS float* tab = (LAS float*)(F.lds + TAB_OFF); tab[F.tid] = rms; tab[256 + F.tid] = 1.0f / rms; tab[1536 + F.tid] = RMS0[u0.pm * 256 + F.tid]; }
            else ((LAS f32x4*)(F.lds + TAB_OFF + 2048))[F.tid - 256] = ((const f32x4*)g_ffn)[F.tid - 256];
        }
        __syncthreads();
        pg8::Gemm g{Yb, WoutT, M_TOK, DM, DM, DM, DM, XN, IDM, 4};
        pg8::EpiX1 E{x, out, XN, SSQX, TAB_OFF, ws + WS_XQH, ws + WS_XQL};
        pg8::gemm_phase<pg8::EpiX1, pg8::StaticOrder, false>(F.lds, g, S, E);
        if (BOTH(3)) GRID_BAR();
    }
    if (IN(4)) for (int rep = 0; rep < NREP(4); ++rep) {
        pg8::Gemm g{XN, WqT, M_TOK, 2048, DM, DM, DM}; pg8::HeadOrder S; S.init(M_TOK, 2048, F.G, (int)blockIdx.x);
        pg8::EpiBf16 E{QRY, 2048};
        pg8::gemm_phase<pg8::EpiBf16, pg8::HeadOrder, true>(F.lds, g, S, E);
        asm volatile("s_waitcnt vmcnt(0)" ::: "memory");
        __syncthreads();
    }
    if (IN(5)) for (int rep = 0; rep < NREP(5); ++rep) {
        if (!IN(4)) { }
        pg8::HeadOrder S; S.init(M_TOK, 2048, F.G, (int)blockIdx.x);
        pg8::Unit u5; int cur_h = -1;
        for (int ui = 0; S.next(ui, u5); ++ui) {
            const int h = u5.pn; const int L = ui * F.G + (int)blockIdx.x;
            if (h != cur_h) {
                __syncthreads();
                p5w::keys_to_lds(F.lds, K1b, K2b, h, F.tid);
                __syncthreads();
                cur_h = h;
                if (F.wave >= 4) __builtin_amdgcn_s_sleep(24);
            }
            const int it0 = (L * NWAVES + F.wave) * 16; const bool dn = it0 < (NEXP * DM) / 512;
            p5w::unit_rows32(F.lds, F.lane, F.wave, u5.pm * 256 + 32 * F.wave, h, QRY, SSQX, EIDX, GATE, dn ? e_down : e_up, dn ? ED8 : EU8, (size_t)(dn ? it0 : it0 - (NEXP * DM) / 512), dn ? p6::SC_DOWN : p6::SC_UP, nullptr);
        }
        __syncthreads();
        if (BOTH(5)) GRID_BAR();
    }
    if (IN(6)) {
        bf16_t* DELTA = (bf16_t*)(ws + WS_DELTA); unsigned char* CQ = ws + WS_CQ; const bf16_t* X1S = XN;
        LAS unsigned char* img = F.lds + F.wave * 16384; LAS unsigned char* sm = F.lds + 131072 + F.wave * 1024; LAS unsigned char* rs = F.lds + 139264 + F.wave * 256; LAS unsigned char* idl = F.lds + 141312 + F.wave * 2048;
        for (int g = gw; g < M_TOK / 8; g += NGW) {
            const int t0 = 8 * g;
            float pacc[8][8];
#pragma unroll
            for (int a = 0; a < 8; ++a)
#pragma unroll
                for (int b = 0; b < 8; ++b) pacc[a][b] = 0.f;
            p6::own_down(t0, img, sm, EIDX, ws + WS_XQH, ws + WS_XQL, ED8, pacc, idl);
            p6::own_c2(t0, img, pacc, SSQX, GATE, CQ, idl, EU8);
            p6::own_up<true>(t0, img, sm, rs, EIDX, CQ, EU8, X1S, DELTA, idl);
            asm volatile("s_waitcnt vmcnt(0)" ::: "memory");
            p6::final_tokens_y<8>(t0, p6::opaque_lane(), out, DELTA, g_fin);
        }
    }
#undef IN
#undef BOTH
#undef GRID_BAR
}

extern "C" void kernel_launch(void* const* d_in, const int* in_sizes, int n_in, void* d_out, int out_size, void* d_ws, size_t ws_size, hipStream_t stream) {
    static int grid = 0;
    if (grid == 0) {
        if (n_in != 14 || in_sizes[0] != M_TOK * DM || out_size != M_TOK * DM || ws_size < WS_END) { fprintf(stderr, "kernel_launch: unexpected problem shape (n_in %d, in0 %d, out %d, ws %zu)\n", n_in, n_in > 0 ? in_sizes[0] : -1, out_size, ws_size); grid = -1; return; }
        int dev = 0, cus = 0;
        if (hipGetDevice(&dev) != hipSuccess || hipDeviceGetAttribute(&cus, hipDeviceAttributeMultiprocessorCount, dev) != hipSuccess) { grid = -1; return; }
        if (hipFuncSetAttribute((const void*)hymba_fwd, hipFuncAttributeMaxDynamicSharedMemorySize, LDS_BYTES) != hipSuccess) { fprintf(stderr, "kernel_launch: hipFuncSetAttribute failed\n"); grid = -1; return; }
        (void)hipGetLastError();
        grid = cus;
        if (grid != 256) fprintf(stderr, "kernel_launch: %d CUs (built for 256)\n", grid);
    }
    if (grid < 0) return;
    if (hipMemsetAsync((char*)d_ws + WS_CTL, 0, CTL_ZERO_BYTES, stream) != hipSuccess) return;
    Args a{};
    for (int i = 0; i < 14; ++i) a.in[i] = (const float*)d_in[i];
    a.out = (float*)d_out; a.ws = (unsigned char*)d_ws;
    if (N_LAUNCHES == 1) {
        a.ph_lo = 0; a.ph_hi = N_PHASES; a.li = 0;
        hipLaunchKernelGGL(hymba_fwd, dim3(grid), dim3(NWAVES * 64), LDS_BYTES, stream, a);
    } else {
        for (int li = 0; li < N_PHASES; ++li) { a.ph_lo = li; a.ph_hi = li + 1; a.li = li; hipLaunchKernelGGL(hymba_fwd, dim3(grid), dim3(NWAVES * 64), LDS_BYTES, stream, a); }
    }
}
```
